# Optimizing an MI355X kernel written in HIP

```python
import math
import jax, jax.numpy as jnp
from jax import lax
import numpy as np


D_MODEL = 1024
BATCH = 8
SEQ = 2048
DEPTH = 4

N_MIXERS = 2
N_META = 16
D_FF = 2816
CONV_WIDTH = 3
HEAD_DIM = 64
V_DIM = 2 * HEAD_DIM
N_HEADS = D_MODEL // (2 * HEAD_DIM)
ROT_DIM = HEAD_DIM // 4
ROPE_THETA = 500000.0
Q_BLOCK = 128
FRONT_PAD = Q_BLOCK - N_META
N_CONV_LAYERS = (DEPTH + N_MIXERS - 1) // N_MIXERS
N_ATTN_LAYERS = DEPTH // N_MIXERS
NORM_EPS = 1e-6
SUBLN_EPS = 1e-5
NEG_INF = -1e30

kernel_name = 'hybrid_conv_diffattn_macaron_trunk'


def rms_norm(t, g, eps=NORM_EPS):
    t32 = t.astype(jnp.float32)
    t32 = t32 * lax.rsqrt(jnp.mean(t32 * t32, axis=-1, keepdims=True) + eps)
    return t32.astype(t.dtype) * g.astype(t.dtype)


def swiglu(h, w_gu, w_down):
    g, u = jnp.split(h @ w_gu, 2, axis=-1)
    return (jax.nn.silu(g) * u) @ w_down


def short_conv_mixer(h, w_in, conv_w, w_out):
    b, c, xt = jnp.split(h @ w_in, 3, axis=-1)
    u = c * xt
    u = lax.conv_general_dilated(
        u, conv_w[:, None, :].astype(u.dtype),
        window_strides=(1,), padding=((CONV_WIDTH - 1, 0),),
        dimension_numbers=('NWC', 'WIO', 'NWC'),
        feature_group_count=u.shape[-1])
    return (b * u) @ w_out


def partial_rope(t, cos, sin):
    half = ROT_DIM // 2
    t1 = t[..., :half]
    t2 = t[..., half:ROT_DIM]
    c = cos[None, :, None, None, :]
    s = sin[None, :, None, None, :]
    return jnp.concatenate([t1 * c - t2 * s, t1 * s + t2 * c, t[..., ROT_DIM:]], axis=-1)


def diff_attention_mixer(h, w_qkv, lam_p, subln_g, w_o, lambda_init):
    bsz, seq_len, d = h.shape
    dt = h.dtype
    q, k, v = jnp.split(h @ w_qkv, 3, axis=-1)
    q = q.reshape(bsz, seq_len, N_HEADS, 2, HEAD_DIM)
    k = k.reshape(bsz, seq_len, N_HEADS, 2, HEAD_DIM)
    v = v.reshape(bsz, seq_len, N_HEADS, V_DIM)
    pos = jnp.arange(seq_len, dtype=jnp.float32)
    inv_freq = ROPE_THETA ** (-jnp.arange(0, ROT_DIM, 2, dtype=jnp.float32) / ROT_DIM)
    ang = pos[:, None] * inv_freq[None, :]
    cos = jnp.cos(ang).astype(dt)
    sin = jnp.sin(ang).astype(dt)
    q = partial_rope(q, cos, sin)
    k = partial_rope(k, cos, sin)
    q = jnp.pad(q, ((0, 0), (FRONT_PAD, 0), (0, 0), (0, 0), (0, 0))).transpose(0, 2, 3, 1, 4)
    k = jnp.pad(k, ((0, 0), (FRONT_PAD, 0), (0, 0), (0, 0), (0, 0))).transpose(0, 2, 3, 1, 4)
    v = jnp.pad(v, ((0, 0), (FRONT_PAD, 0), (0, 0), (0, 0))).transpose(0, 2, 1, 3)
    lp = seq_len + FRONT_PAD
    lam32 = lam_p.astype(jnp.float32)
    lam = (jnp.exp(jnp.sum(lam32[0] * lam32[1])) - jnp.exp(jnp.sum(lam32[2] * lam32[3]))
           + lambda_init)
    scale = HEAD_DIM ** -0.5
    outs = []
    for j in range(lp // Q_BLOCK):
        q0, q1 = j * Q_BLOCK, (j + 1) * Q_BLOCK
        qb = q[:, :, :, q0:q1]
        kb = k[:, :, :, :q1]
        vb = v[:, :, :q1]
        s = jnp.einsum('bhcqd,bhckd->bhcqk', qb, kb).astype(jnp.float32) * scale
        qi = jnp.arange(q0, q1)[:, None]
        ki = jnp.arange(q1)[None, :]
        mask = (ki <= qi) & (ki >= FRONT_PAD)
        p = jax.nn.softmax(jnp.where(mask, s, NEG_INF), axis=-1)
        a = p[:, :, 0] - lam * p[:, :, 1]
        outs.append(jnp.einsum('bhqk,bhkv->bhqv', a.astype(dt), vb))
    o = jnp.concatenate(outs, axis=2)[:, :, FRONT_PAD:]
    o = rms_norm(o, subln_g, SUBLN_EPS) * (1.0 - lambda_init)
    o = o.transpose(0, 2, 1, 3).reshape(bsz, seq_len, d)
    return o @ w_o


def setup_inputs(seed: int = 0) -> dict:
    key = jax.random.key(seed)
    ks = jax.random.split(key, 20)

    def nrm(k, shape, scale):
        return jax.random.normal(k, shape, jnp.float32) * scale

    def gains(k, shape):
        return 1.0 + nrm(k, shape, 0.02)

    D = D_MODEL
    return {
        'x': nrm(ks[0], (BATCH, SEQ, D), 1.0),
        'meta_tokens': nrm(ks[1], (N_META, D), 1.0),
        'ln_ffn1': gains(ks[2], (DEPTH, 2, D)),
        'ffn1_w_gu': nrm(ks[3], (DEPTH, D, 2 * D_FF), D ** -0.5),
        'ffn1_w_down': nrm(ks[4], (DEPTH, D_FF, D), D_FF ** -0.5),
        'ln_mix': gains(ks[5], (DEPTH, 2, D)),
        'conv_w_in': nrm(ks[6], (N_CONV_LAYERS, D, 3 * D), D ** -0.5),
        'conv_w': nrm(ks[7], (N_CONV_LAYERS, CONV_WIDTH, D), CONV_WIDTH ** -0.5),
        'conv_w_out': nrm(ks[8], (N_CONV_LAYERS, D, D), D ** -0.5),
        'attn_w_qkv': nrm(ks[9], (N_ATTN_LAYERS, D, 3 * D), D ** -0.5),
        'attn_lambda': nrm(ks[10], (N_ATTN_LAYERS, 4, HEAD_DIM), 0.1),
        'attn_subln_g': gains(ks[11], (N_ATTN_LAYERS, V_DIM)),
        'attn_w_o': nrm(ks[12], (N_ATTN_LAYERS, D, D), D ** -0.5),
        'ln_ffn2': gains(ks[13], (DEPTH, 2, D)),
        'ffn2_w_gu': nrm(ks[14], (DEPTH, D, 2 * D_FF), D ** -0.5),
        'ffn2_w_down': nrm(ks[15], (DEPTH, D_FF, D), D_FF ** -0.5),
    }


def reference(x, meta_tokens, ln_ffn1, ffn1_w_gu, ffn1_w_down, ln_mix,
              conv_w_in, conv_w, conv_w_out, attn_w_qkv, attn_lambda,
              attn_subln_g, attn_w_o, ln_ffn2, ffn2_w_gu, ffn2_w_down):
    bsz = x.shape[0]
    meta = jnp.broadcast_to(meta_tokens.astype(x.dtype)[None], (bsz, N_META, x.shape[-1]))
    h = jnp.concatenate([meta, x], axis=1)
    for i in range(DEPTH):
        f = swiglu(rms_norm(h, ln_ffn1[i, 0]), ffn1_w_gu[i], ffn1_w_down[i])
        h = h + 0.5 * rms_norm(f, ln_ffn1[i, 1])
        hn = rms_norm(h, ln_mix[i, 0])
        j = i // N_MIXERS
        if i % N_MIXERS == 0:
            m = short_conv_mixer(hn, conv_w_in[j], conv_w[j], conv_w_out[j])
        else:
            lambda_init = 0.8 - 0.6 * math.exp(-0.3 * i)
            m = diff_attention_mixer(hn, attn_w_qkv[j], attn_lambda[j],
                                     attn_subln_g[j], attn_w_o[j], lambda_init)
        h = h + rms_norm(m, ln_mix[i, 1])
        f = swiglu(rms_norm(h, ln_ffn2[i, 0]), ffn2_w_gu[i], ffn2_w_down[i])
        h = h + 0.5 * rms_norm(f, ln_ffn2[i, 1])
    return h[:, N_META:]
```

```cpp
#include <hip/hip_runtime.h>
#include <cstdio>
#include <cstdint>
__device__ __forceinline__ int opaque_tid() { int t = threadIdx.x; asm volatile("" : "+v"(t)); return t; }
namespace pg8 {
#define PG8_LAS __attribute__((address_space(3)))
typedef unsigned short bf16_t;
typedef short bf16x8 __attribute__((ext_vector_type(8)));
typedef float f32x4 __attribute__((ext_vector_type(4)));
typedef unsigned u32x4 __attribute__((ext_vector_type(4)));
constexpr int BM = 256, BK = 64, HALF = 128, HTB = HALF * BK * 2  , STAGE_BYTES = 8 * HTB, NXCD = 8, WGM = 8;

__host__ __device__ __forceinline__ int lds_byte(int r, int c) { const int st = (r >> 4) * 2 + (c >> 5), rr = r & 15, cc = c & 31, ob = rr * 64 + cc * 2; return st * 1024 + (ob ^ (((ob >> 9) & 1) << 5)); }
__host__ __device__ __forceinline__ void stage_rc(int b, int& R, int& C) { const int st = b / 1024, sb = b % 1024, swz = sb ^ (((sb >> 9) & 1) << 5); R = (st >> 1) * 16 + swz / 64; C = (st & 1) * 32 + (swz % 64) / 2; }
__host__ __device__ __forceinline__ int perm32(int rho) { const int n = rho >> 4, i = rho & 15; return 8 * (i >> 2) + 4 * n + (i & 3); }

struct Unit { int pm, pn; };
struct Gemm { const bf16_t* A; const bf16_t* Bt; int M, N, K; };

struct StaticOrder {
    int nM, nN, nwg, G, c;
    __host__ __device__ void init(int M, int N, int G_, int c_) { nM = M / BM; nN = N / BM; nwg = nM * nN; G = G_; c = c_; }
    __host__ __device__ bool next(int i, Unit& u) const {
        const long L = (long)i * G + c; if (L >= nwg) return false;
        int wgid = (int)L; { const int q = nwg / NXCD, r = nwg % NXCD, xcd = wgid % NXCD, off = wgid / NXCD; wgid = (xcd < r ? xcd * (q + 1) : r * (q + 1) + (xcd - r) * q) + off; }
        const int nig = WGM * nN, gid = wgid / nig, fm = gid * WGM, gsz = (nM - fm) < WGM ? (nM - fm) : WGM;
        u.pm = fm + ((wgid % nig) % gsz); u.pn = (wgid % nig) / gsz; return true;
    }
    __device__ __forceinline__ void a_ready(const Unit&) const {}
    __device__ __forceinline__ void done(const Unit&) const {}
};

__device__ __forceinline__ unsigned cvt_pk_bf16(float lo, float hi) { unsigned r; asm volatile("v_cvt_pk_bf16_f32 %0, %1, %2" : "=v"(r) : "v"(lo), "v"(hi)); return r; }
typedef float f32x2 __attribute__((ext_vector_type(2)));
__device__ __forceinline__ f32x2 gelu_pk(f32x2 v) {
    const f32x2 av = __builtin_elementwise_abs(v), d = av * 0.2316418882f + 1.0f;
    f32x2 t; t.x = __builtin_amdgcn_rcpf(d.x); t.y = __builtin_amdgcn_rcpf(d.y);
    f32x2 q = t * 0.5307027145f + (-0.7265760135f); q = q * t + 0.7107068705f; q = q * t + (-0.142248368f); q = q * t + 0.127414796f; q = q * t;
    const f32x2 s = (v * v) * (-0.72134752044f);
    f32x2 e; e.x = __builtin_amdgcn_exp2f(s.x); e.y = __builtin_amdgcn_exp2f(s.y);
    const f32x2 m = v * (q * e), r = v - m;
    f32x2 o; o.x = v.x < 0.f ? m.x : r.x; o.y = v.y < 0.f ? m.y : r.y; return o;
}

template <int ACT  > struct EpiBf16 {
    static constexpr bool PERM = true, AFTER_DRAIN = false; static_assert(ACT == 0 || ACT == 1, "EpiBf16: ACT is 0 (none) or 1 (gelu_pk)");
    bf16_t* O; int ldc; const float* bias; int split_cols; size_t split_stride; float scale0;
    __device__ __forceinline__ void operator()(const f32x4 (&acc)[2][2][4][2], const Unit& u, int wr, int wc, int fr, int fq) const {
        const int row0 = u.pm * BM + wr * 64 + fr; int colt = u.pn * BM; bf16_t* base = O;
        float sc = 1.f; if (split_cols) { const int t = colt / split_cols; base += (size_t)t * split_stride; colt -= t * split_cols; if (t == 0) sc = scale0; }
        const int col0 = colt + wc * 32 + 8 * fq, bcol0 = u.pn * BM + wc * 32 + 8 * fq;
        f32x4 bv[2][2];
#pragma unroll
        for (int bj = 0; bj < 2; ++bj)
#pragma unroll
            for (int n = 0; n < 2; ++n) bv[bj][n] = bias ? *(const f32x4*)(bias + bcol0 + bj * HALF + 4 * n) : (f32x4){0.f, 0.f, 0.f, 0.f};
#pragma unroll
        for (int ai = 0; ai < 2; ++ai)
#pragma unroll
            for (int m = 0; m < 4; ++m) { bf16_t* rowp = base + (size_t)(row0 + ai * HALF + m * 16) * ldc + col0;
#pragma unroll
                for (int bj = 0; bj < 2; ++bj) { f32x4 v0 = acc[ai][bj][m][0] + bv[bj][0], v1 = acc[ai][bj][m][1] + bv[bj][1];
                    if (ACT == 1) { f32x2 a = gelu_pk((f32x2){v0[0], v0[1]}), b = gelu_pk((f32x2){v0[2], v0[3]}), c = gelu_pk((f32x2){v1[0], v1[1]}), d = gelu_pk((f32x2){v1[2], v1[3]});
                        v0 = (f32x4){a.x, a.y, b.x, b.y}; v1 = (f32x4){c.x, c.y, d.x, d.y}; }
                    v0 = v0 * sc; v1 = v1 * sc; u32x4 w; w.x = cvt_pk_bf16(v0[0], v0[1]); w.y = cvt_pk_bf16(v0[2], v0[3]); w.z = cvt_pk_bf16(v1[0], v1[1]); w.w = cvt_pk_bf16(v1[2], v1[3]);
                    *(u32x4*)(rowp + bj * HALF) = w; } }
    }
};

struct PanelStats {
    unsigned* xbuf;
    unsigned* cnt;
    unsigned* tmo;
    int ntn; float eps;
    unsigned code;
    __device__ __forceinline__ bool run(const f32x4 (&v)[2][2][4][2], const Unit& u, int wr, int wc, int fr, int fq, PG8_LAS unsigned char* lds, int wid, int lane) const {
        typedef float f32x2v __attribute__((ext_vector_type(2)));
        PG8_LAS f32x2v* P = (PG8_LAS f32x2v*)lds;
        PG8_LAS f32x2v* S = (PG8_LAS f32x2v*)(lds + 8192);
        PG8_LAS unsigned* flag = (PG8_LAS unsigned*)(lds + 8192 + 2048);
#pragma unroll
        for (int ai = 0; ai < 2; ++ai)
#pragma unroll
            for (int m = 0; m < 4; ++m) {
                float s = 0.f;
#pragma unroll
                for (int bj = 0; bj < 2; ++bj)
#pragma unroll
                    for (int n = 0; n < 2; ++n) { const f32x4 x = v[ai][bj][m][n]; s += (x[0] + x[1]) + (x[2] + x[3]); }
                s += __shfl_xor(s, 16); s += __shfl_xor(s, 32);
                const float mw = s * (1.0f / 64.0f); float q = 0.f;
#pragma unroll
                for (int bj = 0; bj < 2; ++bj)
#pragma unroll
                    for (int n = 0; n < 2; ++n) { const f32x4 d = v[ai][bj][m][n] - mw; q += (d[0] * d[0] + d[1] * d[1]) + (d[2] * d[2] + d[3] * d[3]); }
                q += __shfl_xor(q, 16); q += __shfl_xor(q, 32);
                if (fq == 0) P[(ai * HALF + wr * 64 + m * 16 + fr) * 4 + wc] = (f32x2v){mw, q};
            }
        asm volatile("s_waitcnt lgkmcnt(0)" ::: "memory"); __builtin_amdgcn_s_barrier(); asm volatile("" ::: "memory");
#if defined(BROKEN_EXCHANGE_NO_WAIT)
#warning BROKEN CONTROL BUILD: the row-statistics exchange does not wait; results are wrong by design
        if (blockIdx.x >= 64) { const long long t0_ = clock64(); while (clock64() - t0_ < 60000) __builtin_amdgcn_s_sleep(8); }
#endif
        const int row = wid * 32 + (lane & 31);
        if (lane < 32) {
            const f32x2v a = P[row * 4 + 0], b = P[row * 4 + 1], c = P[row * 4 + 2], d = P[row * 4 + 3];
            const float mt = (a.x + b.x + c.x + d.x) * 0.25f;
            const float da = a.x - mt, db = b.x - mt, dc = c.x - mt, dd = d.x - mt;
            const float m2 = (a.y + b.y) + (c.y + d.y) + 64.0f * ((da * da + db * db) + (dc * dc + dd * dd));
            unsigned long long* slot = (unsigned long long*)xbuf + ((size_t)(u.pm * BM + row) * 4 + u.pn);
            __hip_atomic_store(slot, ((unsigned long long)__float_as_uint(m2) << 32) | __float_as_uint(mt), __ATOMIC_RELAXED, __HIP_MEMORY_SCOPE_AGENT);
        }
        asm volatile("s_waitcnt vmcnt(0)" ::: "memory");
        if (lane == 0) __hip_atomic_fetch_add(cnt + 64 * u.pm, 1u, __ATOMIC_RELAXED, __HIP_MEMORY_SCOPE_AGENT);
        if (wid == 0) {
            bool dead = false; const unsigned long long t0 = __builtin_amdgcn_s_memrealtime(); const unsigned want = 8u * (unsigned)ntn;
            for (;;) {
#if defined(BROKEN_EXCHANGE_NO_WAIT)
                break;
#endif
                if ((unsigned)__builtin_amdgcn_readfirstlane(__hip_atomic_load(cnt + 64 * u.pm, __ATOMIC_RELAXED, __HIP_MEMORY_SCOPE_AGENT)) >= want) break;
                if (__builtin_amdgcn_s_memrealtime() - t0 > 2000000ull) {
                    if (lane == 0) { unsigned expect = 0u; __hip_atomic_compare_exchange_strong(tmo + 1, &expect, code | (unsigned)(u.pm & 0xff), __ATOMIC_RELAXED, __ATOMIC_RELAXED, __HIP_MEMORY_SCOPE_AGENT);
                                     __hip_atomic_store(tmo, 1u, __ATOMIC_RELAXED, __HIP_MEMORY_SCOPE_AGENT); }
                    dead = true; break; }
                __builtin_amdgcn_s_sleep(2);
            }
            __builtin_amdgcn_fence(__ATOMIC_ACQUIRE, "agent");
            if (lane == 0) flag[0] = dead ? 1u : 0u;
        }
        asm volatile("s_waitcnt vmcnt(0) lgkmcnt(0)" ::: "memory"); __builtin_amdgcn_s_barrier(); asm volatile("" ::: "memory");
        const bool bad = flag[0] != 0u;
        if (lane < 32) {
            const unsigned long long* slot = (const unsigned long long*)xbuf + (size_t)(u.pm * BM + row) * 4; float mt[4], m2[4]; float ms = 0.f;
#pragma unroll
            for (int t = 0; t < 4; ++t) { if (t < ntn) { const unsigned long long w = __hip_atomic_load(slot + t, __ATOMIC_RELAXED, __HIP_MEMORY_SCOPE_AGENT); mt[t] = __uint_as_float((unsigned)w); m2[t] = __uint_as_float((unsigned)(w >> 32)); } else { mt[t] = 0.f; m2[t] = 0.f; } ms += mt[t]; }
            const float mean = ms / (float)ntn; float q = 0.f;
#pragma unroll
            for (int t = 0; t < 4; ++t) if (t < ntn) { const float dm = mt[t] - mean; q += m2[t] + 256.0f * dm * dm; }
            S[row] = (f32x2v){mean, 1.0f / sqrtf(q / (256.0f * (float)ntn) + eps)};
        }
        asm volatile("s_waitcnt lgkmcnt(0)" ::: "memory"); __builtin_amdgcn_s_barrier(); asm volatile("" ::: "memory");
        return bad;
    }
};
struct EpiLnRes {
    static constexpr bool PERM = false, AFTER_DRAIN = true;
    const float* base; float* out; int ldc; const float* bias; PanelStats st; unsigned poison;
    __device__ __forceinline__ void fused(f32x4 (&acc)[2][2][4][2], const Unit& u, int wr, int wc, int fr, int fq, PG8_LAS unsigned char* lds, int wid, int lane) const {
        typedef float f32x2v __attribute__((ext_vector_type(2)));
        const PG8_LAS f32x2v* S = (const PG8_LAS f32x2v*)(lds + 8192);
        const int col0 = u.pn * BM + wc * 32 + 4 * fq;
#pragma unroll
        for (int bj = 0; bj < 2; ++bj)
#pragma unroll
            for (int n = 0; n < 2; ++n) { const f32x4 bv = bias ? *(const f32x4*)(bias + col0 + bj * HALF + n * 16) : (f32x4){0.f, 0.f, 0.f, 0.f};
#pragma unroll
                for (int ai = 0; ai < 2; ++ai)
#pragma unroll
                    for (int m = 0; m < 4; ++m) acc[ai][bj][m][n] += bv; }
        f32x4 pre[4][2][2];
#pragma unroll
        for (int m = 0; m < 4; ++m) { const size_t off = (size_t)(u.pm * BM + wr * 64 + m * 16 + fr) * ldc + col0;
#pragma unroll
            for (int bj = 0; bj < 2; ++bj)
#pragma unroll
                for (int n = 0; n < 2; ++n) pre[m][bj][n] = *(const f32x4*)(base + off + bj * HALF + n * 16); }
        const bool bad = st.run(acc, u, wr, wc, fr, fq, lds, wid, lane) || poison != 0u;
        const float qnan = __builtin_nanf("");
#pragma unroll
        for (int ai = 0; ai < 2; ++ai)
#pragma unroll
            for (int m = 0; m < 4; ++m) { const int r = ai * HALF + wr * 64 + m * 16 + fr; const f32x2v sr = S[r]; const size_t off = (size_t)(u.pm * BM + r) * ldc + col0;
#pragma unroll
                for (int bj = 0; bj < 2; ++bj)
#pragma unroll
                    for (int n = 0; n < 2; ++n) { const f32x4 bs = ai == 0 ? pre[m][bj][n] : *(const f32x4*)(base + off + bj * HALF + n * 16); f32x4 o = bs + (acc[ai][bj][m][n] - sr.x) * sr.y;
                        if (bad) o = (f32x4){qnan, qnan, qnan, qnan}; *(f32x4*)(out + off + bj * HALF + n * 16) = o; }
                if (m & 1) asm volatile("" ::: "memory"); }
    }
};
struct EpiLnResLn {
    static constexpr bool PERM = false, AFTER_DRAIN = true;
    const float* base; float* out; bf16_t* xn; int ldc; const float* bias; PanelStats st1, st2; unsigned poison;
    __device__ __forceinline__ void fused(f32x4 (&acc)[2][2][4][2], const Unit& u, int wr, int wc, int fr, int fq, PG8_LAS unsigned char* lds, int wid, int lane) const {
        typedef float f32x2v __attribute__((ext_vector_type(2))); typedef unsigned u32x2v __attribute__((ext_vector_type(2)));
        const PG8_LAS f32x2v* S = (const PG8_LAS f32x2v*)(lds + 8192);
        const int col0 = u.pn * BM + wc * 32 + 4 * fq;
#pragma unroll
        for (int bj = 0; bj < 2; ++bj)
#pragma unroll
            for (int n = 0; n < 2; ++n) { const f32x4 bv = bias ? *(const f32x4*)(bias + col0 + bj * HALF + n * 16) : (f32x4){0.f, 0.f, 0.f, 0.f};
#pragma unroll
                for (int ai = 0; ai < 2; ++ai)
#pragma unroll
                    for (int m = 0; m < 4; ++m) acc[ai][bj][m][n] += bv; }
        bool bad = st1.run(acc, u, wr, wc, fr, fq, lds, wid, lane) || poison != 0u;
        const float qnan = __builtin_nanf("");
#pragma unroll
        for (int ai = 0; ai < 2; ++ai)
#pragma unroll
            for (int m = 0; m < 4; ++m) { const int r = ai * HALF + wr * 64 + m * 16 + fr; const f32x2v sr = S[r]; const size_t off = (size_t)(u.pm * BM + r) * ldc + col0;
#pragma unroll
                for (int bj = 0; bj < 2; ++bj)
#pragma unroll
                    for (int n = 0; n < 2; ++n) { const f32x4 bs = *(const f32x4*)(base + off + bj * HALF + n * 16); acc[ai][bj][m][n] = bs + (acc[ai][bj][m][n] - sr.x) * sr.y; }
                asm volatile("" : "+v"(acc[ai][0][m][0]), "+v"(acc[ai][0][m][1]), "+v"(acc[ai][1][m][0]), "+v"(acc[ai][1][m][1]));
                if (m & 1) asm volatile("" ::: "memory"); }
        const bool bad1 = bad;
        bad = st2.run(acc, u, wr, wc, fr, fq, lds, wid, lane) || bad;
#pragma unroll
        for (int ai = 0; ai < 2; ++ai)
#pragma unroll
            for (int m = 0; m < 4; ++m) { const int r = ai * HALF + wr * 64 + m * 16 + fr; const f32x2v sr = S[r]; const size_t off = (size_t)(u.pm * BM + r) * ldc + col0;
#pragma unroll
                for (int bj = 0; bj < 2; ++bj)
#pragma unroll
                    for (int n = 0; n < 2; ++n) { const f32x4 x1 = acc[ai][bj][m][n]; *(f32x4*)(out + off + bj * HALF + n * 16) = bad1 ? (f32x4){qnan, qnan, qnan, qnan} : x1;
                        const f32x4 o = (x1 - sr.x) * sr.y; u32x2v w; w.x = cvt_pk_bf16(o[0], o[1]); w.y = cvt_pk_bf16(o[2], o[3]);
                        if (bad) { w.x = 0x7fc07fc0u; w.y = 0x7fc07fc0u; } *(u32x2v*)(xn + off + bj * HALF + n * 16) = w; }
                asm volatile("" ::: "memory"); }
    }
};

template <class Epi, class Sched, bool ALIGN_EPI = false, bool SP2 = false>
__device__ __forceinline__ void gemm_phase(PG8_LAS unsigned char* lds, const Gemm g, const Sched& S, const Epi& E) {
    const int tid = opaque_tid(), wid = __builtin_amdgcn_readfirstlane(tid >> 6), lane = tid & 63, wr = wid >> 2, wc = wid & 3, fr = lane & 15, fq = lane >> 4;
    const int K = g.K, nt = K / BK;
    unsigned voffA[2], voffB[2];
#pragma unroll
    for (int i = 0; i < 2; ++i) { int R, C; stage_rc(tid * 16 + i * 8192, R, C); const int Rb = Epi::PERM ? ((R & ~31) + perm32(R & 31)) : R;
        voffA[i] = (unsigned)(R * K + C) * 2u; voffB[i] = (unsigned)(Rb * K + C) * 2u; }
    const size_t kstep = (size_t)(BK * 2);
    const size_t hstep = (size_t)HALF * K * 2;
    const size_t tstep = 2 * hstep;
    const unsigned ldsw = (unsigned)wid * 1024u;
    const int aoff = lds_byte(wr * 64 + fr, fq * 8), boff = lds_byte(wc * 32 + fr, fq * 8);
#define PG8_SA(b, h) (((b) * 2 + (h)) * HTB)
#define PG8_SB(b, h) ((4 + (b) * 2 + (h)) * HTB)
#define PG8_STAGE(bufoff, gbase, voff) do { _Pragma("unroll") for (int _i = 0; _i < 2; ++_i) \
        __builtin_amdgcn_global_load_lds((const unsigned*)((const char*)(gbase) + (voff)[_i]), (PG8_LAS unsigned*)(lds + (bufoff) + ldsw + _i * 8192), 16, 0, 0); } while (0)
#define PG8_LDA(dst, b, h) do { _Pragma("unroll") for (int m = 0; m < 4; ++m) _Pragma("unroll") for (int k = 0; k < 2; ++k) dst[m][k] = *(const PG8_LAS bf16x8*)(lds + PG8_SA(b, h) + aoff + m * 2048 + k * 1024); } while (0)
#define PG8_LDB(dst, b, h) do { _Pragma("unroll") for (int n = 0; n < 2; ++n) _Pragma("unroll") for (int k = 0; k < 2; ++k) dst[n][k] = *(const PG8_LAS bf16x8*)(lds + PG8_SB(b, h) + boff + n * 2048 + k * 1024); } while (0)
#define PG8_MMA(ai, bj, At, Bt) do { __builtin_amdgcn_s_setprio(1); _Pragma("unroll") for (int m = 0; m < 4; ++m) _Pragma("unroll") for (int n = 0; n < 2; ++n) _Pragma("unroll") for (int k = 0; k < 2; ++k) \
        acc[ai][bj][m][n] = __builtin_amdgcn_mfma_f32_16x16x32_bf16(Bt[n][k], At[m][k], acc[ai][bj][m][n], 0, 0, 0); __builtin_amdgcn_s_setprio(0); } while (0)
#define PG8_WAIT_V(n) asm volatile("s_waitcnt vmcnt(" #n ")" ::: "memory")
#define PG8_WAIT_L(n) asm volatile("s_waitcnt lgkmcnt(" #n ")" ::: "memory")
#define PG8_BAR __builtin_amdgcn_s_barrier()
#define PG8_SCHED __builtin_amdgcn_sched_barrier(0)
    Unit cur, nxt; int ui = 0;
    if (!S.next(0, cur)) return;
    f32x4 acc[2][2][4][2];
#pragma unroll
    for (int a = 0; a < 2; ++a)
#pragma unroll
        for (int b = 0; b < 2; ++b)
#pragma unroll
            for (int m = 0; m < 4; ++m)
#pragma unroll
                for (int n = 0; n < 2; ++n) acc[a][b][m][n] = (f32x4){0.f, 0.f, 0.f, 0.f};
    bf16x8 At[4][2], B0[2][2], B1[2][2];
    const char* cA = (const char*)g.A + (size_t)cur.pm * tstep; const char* cB = (const char*)g.Bt + (size_t)cur.pn * tstep;
    S.a_ready(cur);
    if constexpr (SP2) {
        PG8_STAGE(PG8_SB(0, 0), cB, voffB); PG8_STAGE(PG8_SB(0, 1), cB + hstep, voffB); PG8_STAGE(PG8_SA(0, 0), cA, voffA); PG8_STAGE(PG8_SA(0, 1), cA + hstep, voffA);
        if (wr == 1) PG8_BAR;
        PG8_WAIT_V(2); PG8_BAR;
        PG8_STAGE(PG8_SB(1, 0), cB + kstep, voffB); PG8_STAGE(PG8_SA(1, 0), cA + kstep, voffA); PG8_STAGE(PG8_SB(1, 1), cB + hstep + kstep, voffB);
        PG8_WAIT_V(6); PG8_BAR;
    } else {
        PG8_STAGE(PG8_SB(0, 0), cB, voffB); PG8_STAGE(PG8_SA(0, 0), cA, voffA); PG8_STAGE(PG8_SB(0, 1), cB + hstep, voffB); PG8_STAGE(PG8_SA(0, 1), cA + hstep, voffA);
        if (wr == 1) PG8_BAR;
        PG8_WAIT_V(4); PG8_BAR;
        PG8_STAGE(PG8_SB(1, 0), cB + kstep, voffB); PG8_STAGE(PG8_SA(1, 0), cA + kstep, voffA); PG8_STAGE(PG8_SB(1, 1), cB + hstep + kstep, voffB);
        PG8_WAIT_V(6); PG8_BAR;
    }
    for (;;) {
        const bool has_next = S.next(ui + 1, nxt);
        const char* nA = has_next ? (const char*)g.A + (size_t)nxt.pm * tstep : cA; const char* nB = has_next ? (const char*)g.Bt + (size_t)nxt.pn * tstep : cB;
        for (int t = 0; t < nt; t += 2) {
            const bool last = (t == nt - 2);
            const char* a1 = cA + (size_t)(t + 1) * kstep;
            const char* a2 = last ? nA : cA + (size_t)(t + 2) * kstep; const char* b2 = last ? nB : cB + (size_t)(t + 2) * kstep;
            const char* a3 = a2 + kstep; const char* b3 = b2 + kstep;
            if (last && has_next) S.a_ready(nxt);
            if constexpr (SP2) {
            PG8_LDB(B0, 0, 0); PG8_LDB(B1, 0, 1); PG8_SCHED; PG8_LDA(At, 0, 0); PG8_STAGE(PG8_SA(1, 1), a1 + hstep, voffA);
            PG8_WAIT_V(8); PG8_WAIT_L(0); PG8_BAR; PG8_MMA(0, 0, At, B0); PG8_MMA(0, 1, At, B1); PG8_BAR; PG8_SCHED;
            PG8_LDA(At, 0, 1); PG8_STAGE(PG8_SB(0, 0), b2, voffB); PG8_STAGE(PG8_SB(0, 1), b2 + hstep, voffB); PG8_STAGE(PG8_SA(0, 0), a2, voffA);
            PG8_WAIT_V(8); PG8_WAIT_L(0); PG8_BAR; PG8_MMA(1, 0, At, B0); PG8_MMA(1, 1, At, B1); PG8_BAR; PG8_SCHED;
            PG8_LDB(B0, 1, 0); PG8_LDB(B1, 1, 1); PG8_SCHED; PG8_LDA(At, 1, 0); PG8_STAGE(PG8_SA(0, 1), a2 + hstep, voffA);
            PG8_WAIT_V(8); PG8_WAIT_L(0); PG8_BAR; PG8_MMA(0, 0, At, B0); PG8_MMA(0, 1, At, B1); PG8_BAR; PG8_SCHED;
            PG8_LDA(At, 1, 1); PG8_STAGE(PG8_SB(1, 0), b3, voffB); PG8_STAGE(PG8_SB(1, 1), b3 + hstep, voffB); PG8_STAGE(PG8_SA(1, 0), a3, voffA);
            PG8_WAIT_V(8); PG8_WAIT_L(0); PG8_BAR; PG8_MMA(1, 0, At, B0); PG8_MMA(1, 1, At, B1); PG8_BAR; PG8_SCHED;
            } else {
            PG8_LDB(B0, 0, 0); PG8_SCHED; PG8_LDA(At, 0, 0); PG8_STAGE(PG8_SA(1, 1), a1 + hstep, voffA);
            PG8_WAIT_L(8); PG8_BAR; PG8_WAIT_L(0); PG8_MMA(0, 0, At, B0); PG8_BAR; PG8_SCHED;
            PG8_LDB(B1, 0, 1); PG8_STAGE(PG8_SB(0, 0), b2, voffB);
            PG8_BAR; PG8_WAIT_L(0); PG8_MMA(0, 1, At, B1); PG8_BAR;
            PG8_LDA(At, 0, 1); PG8_STAGE(PG8_SA(0, 0), a2, voffA);
            PG8_BAR; PG8_WAIT_L(0); PG8_MMA(1, 0, At, B0); PG8_BAR; PG8_SCHED;
            PG8_STAGE(PG8_SB(0, 1), b2 + hstep, voffB);
            PG8_WAIT_V(6); PG8_BAR; PG8_MMA(1, 1, At, B1); PG8_BAR;
            PG8_LDB(B0, 1, 0); PG8_SCHED; PG8_LDA(At, 1, 0); PG8_STAGE(PG8_SA(0, 1), a2 + hstep, voffA);
            PG8_WAIT_L(8); PG8_BAR; PG8_WAIT_L(0); PG8_MMA(0, 0, At, B0); PG8_BAR; PG8_SCHED;
            PG8_LDB(B1, 1, 1); PG8_STAGE(PG8_SB(1, 0), b3, voffB);
            PG8_BAR; PG8_WAIT_L(0); PG8_MMA(0, 1, At, B1); PG8_BAR;
            PG8_LDA(At, 1, 1); PG8_STAGE(PG8_SA(1, 0), a3, voffA);
            PG8_BAR; PG8_WAIT_L(0); PG8_MMA(1, 0, At, B0); PG8_BAR; PG8_SCHED;
            PG8_STAGE(PG8_SB(1, 1), b3 + hstep, voffB);
            PG8_WAIT_V(6); PG8_BAR; PG8_MMA(1, 1, At, B1); PG8_BAR;
            }
        }
        if constexpr (ALIGN_EPI) { if (wr == 0) PG8_BAR; }
        if constexpr (!Epi::AFTER_DRAIN) { E(acc, cur, wr, wc, fr, fq); S.done(cur); }
        if (!has_next) break;
#pragma unroll
        for (int a = 0; a < 2; ++a)
#pragma unroll
            for (int b = 0; b < 2; ++b)
#pragma unroll
                for (int m = 0; m < 4; ++m)
#pragma unroll
                    for (int n = 0; n < 2; ++n) acc[a][b][m][n] = (f32x4){0.f, 0.f, 0.f, 0.f};
        cur = nxt; cA = nA; cB = nB; ++ui;
        if constexpr (ALIGN_EPI) { if (wr == 1) PG8_BAR; }
    }
    PG8_WAIT_V(0);
    if constexpr (!ALIGN_EPI) { if (wr == 0) PG8_BAR; }
    PG8_BAR;
    if constexpr (Epi::AFTER_DRAIN) { E.fused(acc, cur, wr, wc, fr, fq, lds, wid, lane); S.done(cur); }
#undef PG8_SA
#undef PG8_SB
#undef PG8_STAGE
#undef PG8_LDA
#undef PG8_LDB
#undef PG8_MMA
#undef PG8_WAIT_V
#undef PG8_WAIT_L
#undef PG8_BAR
#undef PG8_SCHED
}
}
namespace pg8 {
struct EpiSwiGLU {
    static constexpr bool PERM = true, AFTER_DRAIN = false;
    bf16_t* O; int ldc;
    static __device__ __forceinline__ float silu_mul(float g, float u) { const float e = __builtin_amdgcn_exp2f(-1.4426950408889634f * g); return g * __builtin_amdgcn_rcpf(1.0f + e) * u; }
    __device__ __forceinline__ void operator()(const f32x4 (&acc)[2][2][4][2], const Unit& u, int wr, int wc, int fr, int fq) const {
        const int row0 = u.pm * BM + wr * 64 + fr, col0 = u.pn * HALF + wc * 32 + 8 * fq;
#pragma unroll
        for (int ai = 0; ai < 2; ++ai)
#pragma unroll
            for (int m = 0; m < 4; ++m) { bf16_t* rowp = O + (size_t)(row0 + ai * HALF + m * 16) * ldc + col0;
                const f32x4 g0 = acc[ai][0][m][0], g1 = acc[ai][0][m][1], u0 = acc[ai][1][m][0], u1 = acc[ai][1][m][1];
                u32x4 w; w.x = cvt_pk_bf16(silu_mul(g0[0], u0[0]), silu_mul(g0[1], u0[1])); w.y = cvt_pk_bf16(silu_mul(g0[2], u0[2]), silu_mul(g0[3], u0[3]));
                w.z = cvt_pk_bf16(silu_mul(g1[0], u1[0]), silu_mul(g1[1], u1[1])); w.w = cvt_pk_bf16(silu_mul(g1[2], u1[2]), silu_mul(g1[3], u1[3]));
                *(u32x4*)rowp = w; }
    }
};
struct EpiQKV {
    static constexpr bool PERM = true, AFTER_DRAIN = false;
    bf16_t* Q; size_t buf_stride; const float* rope; float scale0;
    __device__ __forceinline__ void operator()(const f32x4 (&acc)[2][2][4][2], const Unit& u, int wr, int wc, int fr, int fq) const {
        const int t = u.pn >> 2; bf16_t* base = Q + (size_t)t * buf_stride; const float sc = (t == 0) ? scale0 : 1.f;
        const int col0 = (u.pn & 3) * BM + wc * 32 + 8 * fq;
        const bool rot = (t < 2) && ((wc & 1) == 0);
        const float sgn = (fq == 0) ? -1.f : 1.f;
#pragma unroll
        for (int ai = 0; ai < 2; ++ai)
#pragma unroll
            for (int m = 0; m < 4; ++m) { const int r = ai * HALF + wr * 64 + m * 16 + fr; int orow, pos; bool valid = true;
                if (u.pm < 64) { orow = (u.pm >> 3) * 2112 + 64 + (u.pm & 7) * 256 + r; pos = 16 + (u.pm & 7) * 256 + r; }
                else { valid = r < 128; orow = (r >> 4) * 2112 + 48 + (r & 15); pos = r & 15; }
                f32x4 cs0 = {1.f, 1.f, 1.f, 1.f}, cs1 = cs0, sn0 = {0.f, 0.f, 0.f, 0.f}, sn1 = sn0;
                if (rot && fq < 2) { const f32x4* rp = (const f32x4*)(rope + (size_t)pos * 16); cs0 = rp[0]; cs1 = rp[1]; sn0 = rp[2]; sn1 = rp[3]; }
#pragma unroll
                for (int bj = 0; bj < 2; ++bj) { f32x4 v0 = acc[ai][bj][m][0], v1 = acc[ai][bj][m][1];
                    if (rot) { f32x4 o0, o1;
#pragma unroll
                        for (int i = 0; i < 4; ++i) { o0[i] = __shfl_xor(v0[i], 16); o1[i] = __shfl_xor(v1[i], 16); }
                        v0 = v0 * cs0 + (o0 * sn0) * sgn; v1 = v1 * cs1 + (o1 * sn1) * sgn; }
                    v0 = v0 * sc; v1 = v1 * sc; u32x4 w; w.x = cvt_pk_bf16(v0[0], v0[1]); w.y = cvt_pk_bf16(v0[2], v0[3]); w.z = cvt_pk_bf16(v1[0], v1[1]); w.w = cvt_pk_bf16(v1[2], v1[3]);
                    if (valid) *(u32x4*)(base + (size_t)orow * 1024 + col0 + bj * HALF) = w; } }
    }
};
}
#include <hip/hip_bf16.h>
#include <cmath>
namespace attn_body {
using bf16=__hip_bfloat16;
using bf16x8=__attribute__((ext_vector_type(8)))short;
using s16x4=__attribute__((ext_vector_type(4)))short;
using f32x16=__attribute__((ext_vector_type(16)))float;
using u32x4=__attribute__((ext_vector_type(4)))unsigned;
constexpr int D=64,DM=1024,OPITCH=2048,BSTRIDE=2112,FRONT=48,RVEND=2112;
constexpr int NW=8,QBLK=32,QB=QBLK*NW,KVBLK=64,NQB=9;
constexpr int ATTN_PITCH=DM, ATTN_UNIT_ROWS=QB;
__device__ __forceinline__ int crow(int r,int hi){return (r&3)+8*(r>>2)+4*hi;}
#define SBAR() __builtin_amdgcn_sched_barrier(0)
__device__ __forceinline__ void cmask(f32x16&p0,f32x16&p1,int jb,int qrel,int hi){
  const float NEG=-INFINITY; int kb=64*jb+4*hi;
  #pragma unroll
  for(int r=0;r<16;++r){int kv=kb+(r&3)+8*(r>>2); if(kv>qrel)p0[r]=NEG; if(kv+32>qrel)p1[r]=NEG;}
}

constexpr int NSLOT=3, SLOTB=8192;
constexpr int LDS_K=0, LDS_V=NSLOT*SLOTB, LDS_WS=2*NSLOT*SLOTB, LDS_OST=LDS_WS+NW*64*4, LDS_BYTES=LDS_OST+NW*4096;
constexpr float C2=0.125f*1.4426950408889634f;
__device__ __forceinline__ void glds16(const void*gsrc,unsigned lds_dst){unsigned keep;
  asm volatile("s_mov_b32 %0, m0\n\ts_mov_b32 m0, %2\n\ts_nop 0\n\tglobal_load_lds_dwordx4 %1, off\n\ts_mov_b32 m0, %0":"=&s"(keep):"v"(gsrc),"s"(lds_dst):"memory");}
__device__ __forceinline__ float max3f(float a,float b,float c){float r;asm("v_max3_f32 %0, %1, %2, %3":"=v"(r):"v"(a),"v"(b),"v"(c));return r;}
__device__ __forceinline__ float max2f(float a,float b){float r;asm("v_max_f32_e32 %0, %1, %2":"=v"(r):"v"(a),"v"(b));return r;}
__device__ __forceinline__ float fadd_s(float a,float b){float r;asm("v_add_f32_e32 %0, %1, %2":"=v"(r):"v"(a),"v"(b));return r;}
__device__ __forceinline__ float fsub_s(float a,float b){float r;asm("v_sub_f32_e32 %0, %1, %2":"=v"(r):"v"(a),"v"(b));return r;}
typedef float f32x2_t __attribute__((ext_vector_type(2))); typedef __bf16 bf16x2_t __attribute__((ext_vector_type(2)));
__device__ __forceinline__ unsigned cvtpk_s(float lo,float hi){f32x2_t v={lo,hi};bf16x2_t b=__builtin_convertvector(v,bf16x2_t);return __builtin_bit_cast(unsigned,b);}
#define WAIT_BAR(N) asm volatile("s_waitcnt vmcnt(" #N ") lgkmcnt(0)\n\ts_barrier":::"memory")

__device__ __forceinline__ void qkt(f32x16&p0,f32x16&p1,const char*Kslot,const bf16x8*qr,const f32x16&negm,int r32,int hi){
  const char*kb=Kslot+hi*1024+r32*16;
  #pragma unroll
  for(int d0=0;d0<4;++d0){
    const bf16x8 b0=*reinterpret_cast<const bf16x8*>(kb+d0*2048);
    const bf16x8 b1=*reinterpret_cast<const bf16x8*>(kb+d0*2048+512);
    if(d0==0){p0=__builtin_amdgcn_mfma_f32_32x32x16_bf16(b0,qr[0],negm,0,0,0);p1=__builtin_amdgcn_mfma_f32_32x32x16_bf16(b1,qr[0],negm,0,0,0);}
    else{p0=__builtin_amdgcn_mfma_f32_32x32x16_bf16(b0,qr[d0],p0,0,0,0);p1=__builtin_amdgcn_mfma_f32_32x32x16_bf16(b1,qr[d0],p1,0,0,0);}}
}
typedef __attribute__((address_space(3))) const char* lds_cptr;
typedef short v4i16_t __attribute__((ext_vector_type(4)));
__device__ __forceinline__ void kload8(bf16x8*kf,lds_cptr kp){
  kf[0]=*(const __attribute__((address_space(3))) bf16x8*)(kp);      kf[1]=*(const __attribute__((address_space(3))) bf16x8*)(kp+512);
  kf[2]=*(const __attribute__((address_space(3))) bf16x8*)(kp+2048); kf[3]=*(const __attribute__((address_space(3))) bf16x8*)(kp+2560);
  kf[4]=*(const __attribute__((address_space(3))) bf16x8*)(kp+4096); kf[5]=*(const __attribute__((address_space(3))) bf16x8*)(kp+4608);
  kf[6]=*(const __attribute__((address_space(3))) bf16x8*)(kp+6144); kf[7]=*(const __attribute__((address_space(3))) bf16x8*)(kp+6656);
}
__device__ __forceinline__ void kload2(bf16x8*kf,lds_cptr kp,int j){ kf[2*j]=*(const __attribute__((address_space(3))) bf16x8*)(kp+j*2048); kf[2*j+1]=*(const __attribute__((address_space(3))) bf16x8*)(kp+j*2048+512); }
__device__ __forceinline__ s16x4 vtr(lds_cptr p){ return __builtin_bit_cast(s16x4,__builtin_amdgcn_ds_read_tr16_b64_v4i16((__attribute__((address_space(3))) v4i16_t*)p)); }
__device__ __forceinline__ float rowmax(const f32x16&p0,const f32x16&p1){
  float a=max3f(p0[0],p0[1],p1[0]),b=max3f(p0[2],p0[3],p1[1]);a=max3f(a,p1[2],p1[3]);
  #pragma unroll
  for(int r=4;r<16;r+=4){a=max3f(a,p0[r],p0[r+1]);b=max3f(b,p0[r+2],p0[r+3]);a=max3f(a,p1[r],p1[r+1]);b=max3f(b,p1[r+2],p1[r+3]);}
  const float m=max2f(a,b);
  auto rr=__builtin_amdgcn_permlane32_swap(__float_as_uint(m),__float_as_uint(m),false,false);
  return max2f(__uint_as_float(rr[0]),__uint_as_float(rr[1]));
}
__device__ __forceinline__ void pv(f32x16*o,int vb,bf16x8 pa0,bf16x8 pa1,bf16x8 pa2,bf16x8 pa3){
  #pragma unroll
  for(int d0=0;d0<2;++d0){s16x4 lo[4],hi[4];
    #pragma unroll
    for(int ks=0;ks<4;++ks){
      asm volatile("ds_read_b64_tr_b16 %0,%1 offset:%c2":"=&v"(lo[ks]):"v"(vb),"i"(d0*4096+ks*1024):"memory");
      asm volatile("ds_read_b64_tr_b16 %0,%1 offset:%c2":"=&v"(hi[ks]):"v"(vb),"i"(d0*4096+ks*1024+512):"memory");}
    asm volatile("s_waitcnt lgkmcnt(0)":::"memory");SBAR();
    #define PK(k) (bf16x8){lo[k][0],lo[k][1],lo[k][2],lo[k][3],hi[k][0],hi[k][1],hi[k][2],hi[k][3]}
    o[d0]=__builtin_amdgcn_mfma_f32_32x32x16_bf16(pa0,PK(0),o[d0],0,0,0);
    o[d0]=__builtin_amdgcn_mfma_f32_32x32x16_bf16(pa1,PK(1),o[d0],0,0,0);
    o[d0]=__builtin_amdgcn_mfma_f32_32x32x16_bf16(pa2,PK(2),o[d0],0,0,0);
    o[d0]=__builtin_amdgcn_mfma_f32_32x32x16_bf16(pa3,PK(3),o[d0],0,0,0);
    #undef PK
  }
}

#ifndef ATTN_STORE16
#define ATTN_STORE16(p,v) (*(u32x4*)(p)=(v))
#endif
template<int THRL> __device__ __forceinline__ void attn_unit(int b,int cq,int cv,int co,int qb,const bf16*Q,const bf16*__restrict__ K,const bf16*__restrict__ V,bf16*O,char*shm){
  const int tid=opaque_tid(),lane=tid&63,r32=lane&31,hi=lane>>5; const int wid=__builtin_amdgcn_readfirstlane(tid>>6);
  const long rowbase=(long)b*BSTRIDE; const int q0=qb*QB;
  const bf16*Qw=Q+(rowbase+q0+wid*QBLK)*DM+cq;
  const bf16*Kh=K+rowbase*DM+cq,*Vh=V+rowbase*DM+cv;
  const unsigned lds0=(unsigned)(uintptr_t)shm;
  float*wsf=(float*)(shm+LDS_WS)+wid*64;
  const bf16*ksrc=Kh+(long)lane*DM+wid*8;
  const bf16*vsrc=Vh+(long)(16*(wid&3)+(lane>>2))*DM+(wid>>2)*32+(lane&3)*8;
  const unsigned kdst=lds0+LDS_K+wid*1024, vdst=lds0+LDS_V+wid*1024;
  #define DMA_K(t,slot) glds16(ksrc+(long)(t)*KVBLK*DM,(unsigned)__builtin_amdgcn_readfirstlane(kdst+(slot)))
  #define DMA_V(t,slot) glds16(vsrc+(long)(t)*KVBLK*DM,(unsigned)__builtin_amdgcn_readfirstlane(vdst+(slot)))
  const int vb0=(int)(lds0+LDS_V)+((lane>>4)&1)*32+(lane&3)*8+(4*hi+((lane&15)>>2))*64;
  const char*Kbase=shm+LDS_K; bf16x8 kf[8];
  const lds_cptr shm3=(lds_cptr)shm; const lds_cptr kp0=shm3+LDS_K+hi*1024+r32*16; const lds_cptr vp0=shm3+LDS_V+((lane>>4)&1)*32+(lane&3)*8+(4*hi+((lane&15)>>2))*64;
  const int NT=(q0+QB)/KVBLK;
  DMA_K(0,0);DMA_V(0,0);DMA_K(1,SLOTB);
  bf16x8 qr[4];
  #pragma unroll
  for(int d0=0;d0<4;++d0)qr[d0]=*reinterpret_cast<const bf16x8*>(&Qw[(long)r32*DM+d0*16+hi*8]);
  float mhat=0.f,l_reg=0.f;f32x16 o[2];o[0]=f32x16{};o[1]=f32x16{};f32x16 negm=f32x16{};asm volatile("":"+v"(negm));
  const int qrel=wid*QBLK+r32;
  #define CMASK(P0,P1,t) do{int jb_=(t)-(NT-4); if(jb_>=0)cmask(P0,P1,jb_,qrel,hi);}while(0)
  bool resc=false;
  #define START(P0,P1) do{ const float rm=rowmax(P0,P1); resc=false; \
    { const float dl=rm; mhat=fadd_s(mhat,dl); \
      _Pragma("unroll") for(int r=0;r<16;++r){P0[r]=fsub_s(P0[r],dl);P1[r]=fsub_s(P1[r],dl);} \
      _Pragma("unroll") for(int r=0;r<16;++r)negm[r]=-mhat; asm volatile("":"+v"(negm)); } \
    _Pragma("unroll") for(int r=0;r<16;++r)P0[r]=__builtin_amdgcn_exp2f(P0[r]); }while(0)
  #define RESC() do{ if(resc){ asm volatile("s_waitcnt lgkmcnt(0)":::"memory"); \
      _Pragma("unroll") for(int d_=0;d_<2;++d_) _Pragma("unroll") for(int r=0;r<16;++r)o[d_][r]*=wsf[crow(r,hi)]; } }while(0)
  f32x16 pA0,pA1,pB0,pB1;
  int sl_prev=0,sl_cur=0,sl_next=SLOTB;
  #define ROT() do{sl_prev=sl_cur;sl_cur=sl_next;sl_next=(sl_next==(NSLOT-1)*SLOTB)?0:sl_next+SLOTB;}while(0)
  DMA_K(2,2*SLOTB);
  WAIT_BAR(3);
  qkt(pA0,pA1,Kbase,qr,negm,r32,hi);asm volatile("s_nop 15\n\ts_nop 7":"+v"(pA0),"+v"(pA1));CMASK(pA0,pA1,0);
  if(q0+qrel>=FRONT){ _Pragma("unroll") for(int r=0;r<16;++r)pA0[r]=-INFINITY; _Pragma("unroll") for(int r=0;r<8;++r)pA1[r]=-INFINITY; }
  START(pA0,pA1);
  _Pragma("unroll") for(int r=0;r<16;++r)pA1[r]=__builtin_amdgcn_exp2f(pA1[r]);
  WAIT_BAR(0);
  DMA_K(3,0);DMA_V(1,SLOTB);
  ROT();
  kload8(kf,kp0+sl_cur);
  WAIT_BAR(2);
  s16x4 vlo[8],vhi[8]; u32x4 pw0,pw1,pw2,pw3;
  #define PKW(P,B) cvtpk_s(P[B],P[B+1])
  #define PAF(k) __builtin_bit_cast(bf16x8,pw##k)
  #define VFR(i) (bf16x8){vlo[i][0],vlo[i][1],vlo[i][2],vlo[i][3],vhi[i][0],vhi[i][1],vhi[i][2],vhi[i][3]}
  #define PIN(x) asm volatile("":"+v"(x))
  #define MX3(a,b,c) __builtin_fmaxf(__builtin_fmaxf((a),(b)),(c))
  #define GAPA(MF,A0,A1,A2,A3,W0,W1,PW) do{ MF; sacc+=A0; sacc+=A1; sacc+=A2; sacc+=A3; PIN(sacc); W0; W1; PIN(PW); SBAR(); }while(0)
  #define EX(v) __builtin_amdgcn_exp2f(v)
  #define GAPB(MF,X,B) do{ MF; X[B]=EX(X[B]); X[B+1]=EX(X[B+1]); X[B+2]=EX(X[B+2]); X[B+3]=EX(X[B+3]); PIN(X); SBAR(); }while(0)
  #define VRD(i) do{ vlo[i]=vtr(vp_+(((i)>>2)*4096+((i)&3)*1024)); vhi[i]=vtr(vp_+(((i)>>2)*4096+((i)&3)*1024+512)); }while(0)
  #define KRD(G,j) do{ if(G){ kload2(kf,kp0+sl_next,j); SBAR(); } }while(0)
  #define STEP(C0,C1,P0,P1,t,GK,GV,GL) do{ SBAR(); \
    const lds_cptr vp_=vp0+sl_prev; \
    VRD(0); SBAR(); float sacc=(P0[0]+P0[1]); \
    GAPA(C0=__builtin_amdgcn_mfma_f32_32x32x16_bf16(kf[0],qr[0],negm,0,0,0), P0[2],P0[3],P0[4],P0[5],     pw0[0]=PKW(P0,0), pw0[1]=PKW(P0,2), pw0); \
    VRD(4); SBAR(); GAPA(C1=__builtin_amdgcn_mfma_f32_32x32x16_bf16(kf[1],qr[0],negm,0,0,0), P0[6],P0[7],P0[8],P0[9],     pw0[2]=PKW(P0,4), pw0[3]=PKW(P0,6), pw0); \
    VRD(1); SBAR(); GAPA(C0=__builtin_amdgcn_mfma_f32_32x32x16_bf16(kf[2],qr[1],C0,0,0,0),   P0[10],P0[11],P0[12],P0[13], pw1[0]=PKW(P0,8), pw1[1]=PKW(P0,10), pw1); \
    VRD(5); SBAR(); GAPA(C1=__builtin_amdgcn_mfma_f32_32x32x16_bf16(kf[3],qr[1],C1,0,0,0),   P0[14],P0[15],P1[0],P1[1],   pw1[2]=PKW(P0,12),pw1[3]=PKW(P0,14), pw1); \
    VRD(2); SBAR(); GAPA(C0=__builtin_amdgcn_mfma_f32_32x32x16_bf16(kf[4],qr[2],C0,0,0,0),   P1[2],P1[3],P1[4],P1[5],     pw2[0]=PKW(P1,0), pw2[1]=PKW(P1,2), pw2); \
    VRD(6); SBAR(); GAPA(C1=__builtin_amdgcn_mfma_f32_32x32x16_bf16(kf[5],qr[2],C1,0,0,0),   P1[6],P1[7],P1[8],P1[9],     pw2[2]=PKW(P1,4), pw2[3]=PKW(P1,6), pw2); \
    VRD(3); SBAR(); GAPA(C0=__builtin_amdgcn_mfma_f32_32x32x16_bf16(kf[6],qr[3],C0,0,0,0),   P1[10],P1[11],P1[12],P1[13], pw3[0]=PKW(P1,8), pw3[1]=PKW(P1,10), pw3); \
    VRD(7); SBAR(); GAPA(C1=__builtin_amdgcn_mfma_f32_32x32x16_bf16(kf[7],qr[3],C1,0,0,0),   P1[14],P1[15],0.f,0.f,       pw3[2]=PKW(P1,12),pw3[3]=PKW(P1,14), pw3); \
    l_reg+=sacc; \
    if(GK){DMA_K((t)+3,sl_cur);} if(GV){DMA_V((t)+1,sl_next);} \
    CMASK(C0,C1,t); \
    { float a=MX3(C0[0],C0[1],C1[0]),b=MX3(C0[2],C0[3],C1[1]); a=MX3(a,C1[2],C1[3]); \
      _Pragma("unroll") for(int r=4;r<16;r+=4){a=MX3(a,C0[r],C0[r+1]);b=MX3(b,C0[r+2],C0[r+3]);a=MX3(a,C1[r],C1[r+1]);b=MX3(b,C1[r+2],C1[r+3]);} \
      float rm=__builtin_fmaxf(a,b); { auto rr=__builtin_amdgcn_permlane32_swap(__float_as_uint(rm),__float_as_uint(rm),false,false); rm=__builtin_fmaxf(__uint_as_float(rr[0]),__uint_as_float(rr[1])); } \
      resc=false; \
      if(__builtin_expect(__any(rm>(float)THRL),0)){ const float dl=__builtin_fmaxf(rm,0.f); mhat+=dl; \
        _Pragma("unroll") for(int r=0;r<16;++r){C0[r]-=dl;C1[r]-=dl;} \
        _Pragma("unroll") for(int r=0;r<16;++r)negm[r]=-mhat; asm volatile("":"+v"(negm)); \
        const float f=__builtin_amdgcn_exp2f(-dl); l_reg*=f; if(hi==0)wsf[r32]=f; resc=true; } } \
    SBAR(); \
    GAPB(o[0]=__builtin_amdgcn_mfma_f32_32x32x16_bf16(PAF(0),VFR(0),o[0],0,0,0), C0,0); \
    GAPB(o[1]=__builtin_amdgcn_mfma_f32_32x32x16_bf16(PAF(0),VFR(4),o[1],0,0,0), C0,4); \
    KRD(GL,0); GAPB(o[0]=__builtin_amdgcn_mfma_f32_32x32x16_bf16(PAF(1),VFR(1),o[0],0,0,0), C0,8); \
    KRD(GL,1); GAPB(o[1]=__builtin_amdgcn_mfma_f32_32x32x16_bf16(PAF(1),VFR(5),o[1],0,0,0), C0,12); \
    KRD(GL,2); GAPB(o[0]=__builtin_amdgcn_mfma_f32_32x32x16_bf16(PAF(2),VFR(2),o[0],0,0,0), C1,0); \
    KRD(GL,3); GAPB(o[1]=__builtin_amdgcn_mfma_f32_32x32x16_bf16(PAF(2),VFR(6),o[1],0,0,0), C1,4); \
    GAPB(o[0]=__builtin_amdgcn_mfma_f32_32x32x16_bf16(PAF(3),VFR(3),o[0],0,0,0), C1,8); \
    GAPB(o[1]=__builtin_amdgcn_mfma_f32_32x32x16_bf16(PAF(3),VFR(7),o[1],0,0,0), C1,12); \
    }while(0)
  int t=1;
  #undef CMASK
  #define CMASK(P0,P1,t) do{}while(0)
  for(;t+5<NT;t+=2){
    STEP(pB0,pB1,pA0,pA1,t,true,true,true);     WAIT_BAR(2); RESC(); ROT();
    STEP(pA0,pA1,pB0,pB1,t+1,true,true,true);   WAIT_BAR(2); RESC(); ROT();
  }
  #undef CMASK
  #define CMASK(P0,P1,t) do{int jb_=(t)-(NT-4); if(jb_>=0)cmask(P0,P1,jb_,qrel,hi);}while(0)
  #define ENDW(tt) do{ if((tt)+3<NT){WAIT_BAR(2);} else if((tt)+2<NT){WAIT_BAR(1);} else {WAIT_BAR(0);} }while(0)
  for(;t+1<NT;t+=2){
    STEP(pB0,pB1,pA0,pA1,t,(t+3<NT),(t+1<NT),(t+1<NT));       ENDW(t);   RESC(); ROT();
    STEP(pA0,pA1,pB0,pB1,t+1,(t+4<NT),(t+2<NT),(t+2<NT));     ENDW(t+1); RESC(); ROT();
  }
  STEP(pB0,pB1,pA0,pA1,NT-1,false,false,false); RESC();
  { float sacc=pB0[0]+pB0[1]; _Pragma("unroll") for(int r=2;r<16;++r)sacc+=pB0[r]; _Pragma("unroll") for(int r=0;r<16;++r)sacc+=pB1[r]; l_reg+=sacc;
    pw0=(u32x4){PKW(pB0,0),PKW(pB0,2),PKW(pB0,4),PKW(pB0,6)};pw1=(u32x4){PKW(pB0,8),PKW(pB0,10),PKW(pB0,12),PKW(pB0,14)};pw2=(u32x4){PKW(pB1,0),PKW(pB1,2),PKW(pB1,4),PKW(pB1,6)};pw3=(u32x4){PKW(pB1,8),PKW(pB1,10),PKW(pB1,12),PKW(pB1,14)};
    SBAR(); pv(o,vb0+sl_cur,PAF(0),PAF(1),PAF(2),PAF(3)); }
  #undef PKW
  #undef PAF
  #undef VFR
  #undef PIN
  #undef MX3
  #undef GAPA
  #undef GAPB
  #undef EX
  #undef VRD
  #undef KRD
  #undef STEP
  #undef ENDW
  {auto rr=__builtin_amdgcn_permlane32_swap(__float_as_uint(l_reg),__float_as_uint(l_reg),false,false);l_reg=__uint_as_float(rr[0])+__uint_as_float(rr[1]);}
  if(hi==0)wsf[32+r32]=l_reg;asm volatile("s_waitcnt lgkmcnt(0)":::"memory");
  float rli[16];
  #pragma unroll
  for(int r=0;r<16;++r)rli[r]=__builtin_amdgcn_rcpf(wsf[32+crow(r,hi)]);
  bf16*Ow=O+(rowbase+q0+wid*QBLK)*OPITCH+co;
  { bf16*stg=(bf16*)(shm+LDS_OST)+wid*2048;
    #pragma unroll
    for(int r=0;r<16;++r){const int orow=crow(r,hi);
      #pragma unroll
      for(int d0=0;d0<2;++d0)stg[orow*64+d0*32+r32]=__float2bfloat16(o[d0][r]*rli[r]);}
    asm volatile("s_waitcnt lgkmcnt(0)":::"memory");
    #pragma unroll
    for(int i=0;i<4;++i){const int row=i*8+(lane>>3),ch=lane&7; const u32x4 v=*(const u32x4*)(stg+row*64+ch*8); const int rel=q0+wid*QBLK+row; if(rel>=FRONT&&rel<RVEND)ATTN_STORE16(Ow+(long)row*OPITCH+ch*8,v);} }
  asm volatile("s_waitcnt lgkmcnt(0)\n\ts_barrier":::"memory");
  #undef DMA_K
  #undef DMA_V
  #undef CMASK
  #undef START
  #undef RESC
  #undef ROT
}
constexpr int ATTN_LDS_BYTES=LDS_BYTES;
struct AttnTensors { const bf16* Q; const bf16* K; const bf16* V; bf16* O; };
template<int THRL=8> __device__ __forceinline__ void attn_phase(char*lds,const AttnTensors&T,int vcu,int G){
  for(int item=vcu;item<256;item+=G){ const int b=item>>5,vh=item&31,h=vh>>2,c=(vh>>1)&1,vf=vh&1;
    for(int qb=NQB-1;qb>=0;--qb) attn_unit<THRL>(b,(2*h+c)*64,(2*h+vf)*64,vh*64,qb,T.Q,T.K,T.V,T.O,lds); }
}
#undef SBAR
#undef WAIT_BAR
}
#include <hip/hip_cooperative_groups.h>
namespace cg = cooperative_groups;
constexpr int NWAVES = 8;
constexpr int DM_ = 1024, DFF = 2816, NGU = 2 * DFF, NB = 8, SEQL = 2048, NMETA = 16, DEPTH_ = 4;
constexpr int MREAL = NB * SEQL;
constexpr int MVALID = MREAL + NB * NMETA;
constexpr int MPAD = 16640;
constexpr int QROWS = NB * 2112 + 256;
constexpr size_t MiB = 1u << 20;
constexpr size_t WS_ROPE = 1 * MiB;
constexpr size_t WS_HMETA = 1 * MiB + 512 * 1024;
constexpr size_t WS_W = 2 * MiB;
constexpr size_t W_GU_E = (size_t)NGU * DM_, W_DN_E = (size_t)DM_ * DFF, W_FFN_E = W_GU_E + W_DN_E;
constexpr size_t W_IN_E = (size_t)3 * DM_ * DM_, W_OUT_E = (size_t)DM_ * DM_, W_MIX_E = W_IN_E + W_OUT_E;
constexpr size_t W_TOTAL_E = 8 * W_FFN_E + 4 * W_MIX_E;
constexpr size_t WS_XN = 168 * MiB;
constexpr size_t WS_F = 201 * MiB;
constexpr size_t WS_BIG = 236 * MiB;
constexpr size_t WS_END = 338 * MiB;
static_assert(WS_W + W_TOTAL_E * 2 <= WS_XN && WS_XN + (size_t)MPAD * 1024 * 2 <= WS_F && WS_F + (size_t)MPAD * 1024 * 2 <= WS_BIG, "ws map");
static_assert(WS_XN + (size_t)QROWS * 2048 * 2 <= WS_BIG && WS_BIG + (size_t)MPAD * 3072 * 2 <= WS_END && WS_BIG + (size_t)3 * QROWS * 1024 * 2 <= WS_END, "ws map 2");
constexpr int RING_BYTES = 131072, LDS_BYTES = 147456;

#define GAS __attribute__((address_space(1)))
#define LAS __attribute__((address_space(3)))
typedef unsigned short bf16;
typedef unsigned v4u __attribute__((ext_vector_type(4)));
typedef float f32x4 __attribute__((ext_vector_type(4)));
#define LDS_WAIT() asm volatile("s_waitcnt lgkmcnt(0)" ::: "memory")
__device__ __forceinline__ unsigned f2bf(float f) { unsigned u = __builtin_bit_cast(unsigned, f); return (u + 0x7fffu + ((u >> 16) & 1u)) >> 16; }
__device__ __forceinline__ unsigned pk2(float lo, float hi) { return f2bf(lo) | (f2bf(hi) << 16); }
__device__ __forceinline__ float bflo(unsigned w) { return __builtin_bit_cast(float, w << 16); }
__device__ __forceinline__ float bfhi(unsigned w) { return __builtin_bit_cast(float, w & 0xffff0000u); }
__device__ __forceinline__ float wave_sum(float v) {
#pragma unroll
    for (int o = 1; o < 64; o <<= 1) v += __shfl_xor(v, o);
    return v;
}
struct Args { const float* in[16]; float* out; unsigned char* ws; };
__device__ __forceinline__ const float* in_ptr(int i) { const char __attribute__((address_space(4)))* ka = (const char __attribute__((address_space(4)))*)__builtin_amdgcn_kernarg_segment_ptr(); int off = i * 8; asm volatile("" : "+s"(off)); return *(const float* const __attribute__((address_space(4)))*)(ka + off); }
__device__ __forceinline__ float* out_ptr() { return (float*)in_ptr(16); }
__device__ __forceinline__ unsigned char* ws_ptr() { return (unsigned char*)in_ptr(17); }

__device__ __forceinline__ void p0_transpose_item(const float* W, int K, int N, bf16* WT, int k0, int n0, int drow0, LAS float* scr, int lane) {
#pragma unroll 8
    for (int i = 0; i < 32; ++i) { const int kk = 2 * i + (lane >> 5); scr[kk * 33 + (lane & 31)] = W[(size_t)(k0 + kk) * N + n0 + (lane & 31)]; }
    LDS_WAIT(); asm volatile("" ::: "memory");
    const int c = lane & 7;
#pragma unroll
    for (int j = 0; j < 4; ++j) { const int n = (lane >> 3) + 8 * j; const LAS float* s = scr + (8 * c) * 33 + n;
        v4u o; o.x = pk2(s[0 * 33], s[1 * 33]); o.y = pk2(s[2 * 33], s[3 * 33]); o.z = pk2(s[4 * 33], s[5 * 33]); o.w = pk2(s[6 * 33], s[7 * 33]);
        *(GAS v4u*)(WT + (size_t)(drow0 + n) * K + k0 + 8 * c) = o; }
    LDS_WAIT(); asm volatile("" ::: "memory");
}
__device__ __forceinline__ float* hrow_ptr(float* out, float* hmeta, int m) { return m < MREAL ? out + (size_t)m * DM_ : hmeta + (size_t)(m - MREAL) * DM_; }
__device__ __forceinline__ int qkv_row(int m) { return m < MREAL ? (m >> 11) * 2112 + 64 + (m & 2047) : ((m - MREAL) >> 4) * 2112 + 48 + ((m - MREAL) & 15); }
__device__ __forceinline__ int prev_row(int m, int k) {
    if (m < MREAL) { const int t = m & 2047, b = m >> 11; return (t >= k) ? m - k : MREAL + b * 16 + (16 + t - k); }
    const int i = (m - MREAL) & 15; return (i >= k) ? m - k : -1;
}

__global__ void __launch_bounds__(NWAVES * 64, 2) trunk_fwd(Args args) {
    extern __shared__ __attribute__((aligned(16))) unsigned char lds[];
    cg::grid_group grid = cg::this_grid();
    const int tid = threadIdx.x, lane = tid & 63, wave = __builtin_amdgcn_readfirstlane(tid >> 6);
    const int G = gridDim.x; const int bx = blockIdx.x; const int vcu = (G % 8 == 0) ? (bx % 8) * (G / 8) + bx / 8 : bx;
    const int gw = vcu * NWAVES + wave, NGW = G * NWAVES;
    LAS unsigned char* ldsl = (LAS unsigned char*)lds;
#define WSB(off) (ws_ptr() + (off))
#define P_HMETA ((float*)WSB(WS_HMETA))
#define P_ROPE ((float*)WSB(WS_ROPE))
#define P_WB ((bf16*)WSB(WS_W))
#define P_XN ((bf16*)WSB(WS_XN))
#define P_FB ((bf16*)WSB(WS_F))
#define P_BIG ((bf16*)WSB(WS_BIG))
#define GSYNC() do { asm volatile("s_waitcnt vmcnt(0) lgkmcnt(0)" ::: "memory"); __builtin_amdgcn_fence(__ATOMIC_RELEASE, "agent"); grid.sync(); __builtin_amdgcn_fence(__ATOMIC_ACQUIRE, "agent"); } while (0)

    {
        LAS float* scr = (LAS float*)(ldsl + wave * 16384); bf16* const Wb0 = P_WB;
        constexpr int I_GU = (DM_ / 64) * (NGU / 32), I_DN = (DFF / 64) * (DM_ / 32), I_FFN = I_GU + I_DN;
        constexpr int I_IN = (DM_ / 64) * (3 * DM_ / 32), I_OUT = (DM_ / 64) * (DM_ / 32), I_MIX = I_IN + I_OUT;
        constexpr int NITEMS = 8 * I_FFN + 4 * I_MIX;
        for (int it = gw; it < NITEMS; it += NGW) {
            if (it < 8 * I_FFN) { const int fi = it / I_FFN, r = it % I_FFN, l = fi >> 1, which = fi & 1; bf16* dst = Wb0 + (size_t)fi * W_FFN_E;
                if (r < I_GU) { const float* W = (which ? in_ptr(14) : in_ptr(3)) + (size_t)l * DM_ * NGU; const int nblk = NGU / 32, kb = r / nblk, nb = r % nblk, n0 = 32 * nb;
                    const int half = n0 / DFF, within = n0 % DFF, drow0 = 256 * (within / 128) + 128 * half + (within % 128);
                    p0_transpose_item(W, DM_, NGU, dst, 64 * kb, n0, drow0, scr, lane); }
                else { const int r2 = r - I_GU; const float* W = (which ? in_ptr(15) : in_ptr(4)) + (size_t)l * DFF * DM_; const int nblk = DM_ / 32, kb = r2 / nblk, nb = r2 % nblk;
                    p0_transpose_item(W, DFF, DM_, dst + W_GU_E, 64 * kb, 32 * nb, 32 * nb, scr, lane); }
            } else { const int it2 = it - 8 * I_FFN, l = it2 / I_MIX, r = it2 % I_MIX, j = l >> 1, isattn = l & 1; bf16* dst = Wb0 + 8 * W_FFN_E + (size_t)l * W_MIX_E;
                if (r < I_IN) { const float* W = (isattn ? in_ptr(9) : in_ptr(6)) + (size_t)j * DM_ * 3 * DM_; const int nblk = 3 * DM_ / 32, kb = r / nblk, nb = r % nblk;
                    p0_transpose_item(W, DM_, 3 * DM_, dst, 64 * kb, 32 * nb, 32 * nb, scr, lane); }
                else { const int r2 = r - I_IN; const float* W = (isattn ? in_ptr(12) : in_ptr(8)) + (size_t)j * DM_ * DM_; const int nblk = DM_ / 32, kb = r2 / nblk, nb = r2 % nblk;
                    p0_transpose_item(W, DM_, DM_, dst + W_IN_E, 64 * kb, 32 * nb, 32 * nb, scr, lane); }
            }
        }
        float* const rope0 = P_ROPE;
        for (int e = gw * 64 + lane; e < 2064 * 8; e += NGW * 64) { const int pos = e >> 3, j = e & 7;
            const float inv = (float)exp2(-(double)j * (18.931568569324174 / 8.0));
            const float ang = (float)pos * inv; const double rev = (double)ang * 0.15915494309189535; const float fr = (float)(rev - floor(rev));
            rope0[pos * 16 + j] = __builtin_amdgcn_cosf(fr); rope0[pos * 16 + 8 + j] = __builtin_amdgcn_sinf(fr); }
        { const v4u z = {0u, 0u, 0u, 0u}; bf16* const xn0 = P_XN; bf16* const big0 = P_BIG;
          for (int e = gw * 64 + lane; e < (MPAD - MVALID) * 128; e += NGW * 64) *(v4u*)(xn0 + (size_t)MVALID * 1024 + (size_t)e * 8) = z;
          for (int e = gw * 64 + lane; e < 3 * (8 * 48 + 256) * 128; e += NGW * 64) { const int bufi = e / ((8 * 48 + 256) * 128), r = (e / 128) % (8 * 48 + 256), c = e % 128;
              const int row = r < 384 ? (r / 48) * 2112 + (r % 48) : 8 * 2112 + (r - 384);
              *(v4u*)(big0 + (size_t)bufi * QROWS * 1024 + (size_t)row * 1024 + c * 8) = z; } }
    }
    { float* const hp_out = out_ptr(); float* const hp_meta = P_HMETA; const float* const xin = in_ptr(0); const float* const min_ = in_ptr(1); const float* const g = in_ptr(2); bf16* const xn0 = P_XN;
    for (int m = gw; m < MVALID; m += NGW) {
        const float* src = m < MREAL ? xin + (size_t)m * DM_ : min_ + (size_t)((m - MREAL) & 15) * DM_;
        float* hr = hrow_ptr(hp_out, hp_meta, m);
        f32x4 v[4]; float s = 0.f;
#pragma unroll
        for (int q = 0; q < 4; ++q) { v[q] = *(const f32x4*)(src + (q >> 1) * 512 + lane * 8 + (q & 1) * 4); s += (v[q][0] * v[q][0] + v[q][1] * v[q][1]) + (v[q][2] * v[q][2] + v[q][3] * v[q][3]); }
        const float r2 = 1.0f / sqrtf(wave_sum(s) * (1.f / DM_) + 1e-6f);
#pragma unroll
        for (int q = 0; q < 4; ++q) *(f32x4*)(hr + (q >> 1) * 512 + lane * 8 + (q & 1) * 4) = v[q];
#pragma unroll
        for (int hh = 0; hh < 2; ++hh) { const f32x4 g0 = *(const f32x4*)(g + hh * 512 + lane * 8), g1 = *(const f32x4*)(g + hh * 512 + lane * 8 + 4); const f32x4 a = v[2 * hh] * r2 * g0, b = v[2 * hh + 1] * r2 * g1;
            v4u o; o.x = pk2(a[0], a[1]); o.y = pk2(a[2], a[3]); o.z = pk2(b[0], b[1]); o.w = pk2(b[2], b[3]); *(v4u*)(xn0 + (size_t)m * 1024 + hh * 512 + lane * 8) = o; }
    } }
    GSYNC();

    enum { K_GU = 0, K_PLAIN = 1, K_NORM = 2, K_CONV = 3, K_QKV = 4, K_ATTN = 5, K_COMB = 6 };
    for (int l = 0; l < DEPTH_; ++l) {
        const int nsteps = (l & 1) ? 11 : 10;
        for (int s = 0; s < nsteps; ++s) {
            int lq = l; asm volatile("" : "+s"(lq));
            const int isattn = lq & 1, jm = lq >> 1;
            const bf16* Wmix = P_WB + 8 * W_FFN_E + (size_t)lq * W_MIX_E;
            int kind; const bf16* gA = P_XN; const bf16* gB = P_WB; int gN = 1024, gK = 1024; bf16* gO = P_FB;
            float coef = 0.5f; const float* gpost = in_ptr(2); const float* gnext = in_ptr(2); int wnext = 1;
            int ffn_i = 0;
            const int sm = (isattn && s >= 5) ? s - 1 : s;
            if (s == 0 || sm == 7) { kind = K_GU; ffn_i = (s == 0) ? 0 : 1; }
            else if (s == 1 || sm == 8) { kind = K_PLAIN; ffn_i = (s == 1) ? 0 : 1; gA = P_BIG; gB = P_WB + (size_t)(2 * lq + ffn_i) * W_FFN_E + W_GU_E; gN = 1024; gK = DFF; gO = P_FB; }
            else if (s == 2) { kind = K_NORM; coef = 0.5f; gpost = in_ptr(2) + (size_t)(lq * 2 + 1) * DM_; gnext = in_ptr(5) + (size_t)(lq * 2) * DM_; }
            else if (s == 3) { if (isattn) kind = K_QKV; else { kind = K_PLAIN; gA = P_XN; gB = Wmix; gN = 3 * DM_; gK = DM_; gO = P_BIG; } }
            else if (s == 4) { kind = isattn ? K_ATTN : K_CONV; }
            else if (isattn && s == 5) { kind = K_COMB; }
            else if (sm == 5) { kind = K_PLAIN; gA = isattn ? P_BIG : P_XN; gB = Wmix + W_IN_E; gN = 1024; gK = 1024; gO = P_FB; }
            else if (sm == 6) { kind = K_NORM; coef = 1.0f; gpost = in_ptr(5) + (size_t)(lq * 2 + 1) * DM_; gnext = in_ptr(13) + (size_t)(lq * 2) * DM_; }
            else { kind = K_NORM; coef = 0.5f; gpost = in_ptr(13) + (size_t)(lq * 2 + 1) * DM_; wnext = (lq < DEPTH_ - 1); gnext = in_ptr(2) + (size_t)((lq < DEPTH_ - 1 ? lq + 1 : lq) * 2) * DM_; }

            const int lane = opaque_tid() & 63;
            if (kind == K_GU) {
                pg8::Gemm g{P_XN, P_WB + (size_t)(2 * lq + ffn_i) * W_FFN_E, MPAD, NGU, DM_}; pg8::StaticOrder S; S.init(MPAD, NGU, G, bx);
                pg8::EpiSwiGLU E{P_BIG, DFF};
                pg8::gemm_phase<pg8::EpiSwiGLU, pg8::StaticOrder, true, true>(ldsl, g, S, E);
            } else if (kind == K_PLAIN) {
                pg8::Gemm g{gA, gB, MPAD, gN, gK}; pg8::StaticOrder S; S.init(MPAD, gN, G, bx);
                pg8::EpiBf16<0> E{gO, gN, nullptr, 0, 0, 1.f};
                pg8::gemm_phase<pg8::EpiBf16<0>, pg8::StaticOrder, true, true>(ldsl, g, S, E);
            } else if (kind == K_QKV) {
                pg8::Gemm g{P_XN, Wmix, MPAD, 3 * DM_, DM_}; pg8::StaticOrder S; S.init(MPAD, 3 * DM_, G, bx);
                pg8::EpiQKV E{P_BIG, (size_t)QROWS * 1024, P_ROPE, attn_body::C2};
                pg8::gemm_phase<pg8::EpiQKV, pg8::StaticOrder, true, true>(ldsl, g, S, E);
            } else if (kind == K_NORM) {
                float* const hp_out = out_ptr(); float* const hp_meta = P_HMETA; const bf16* const fb0 = P_FB; bf16* const xn0 = P_XN;
                for (int m = gw; m < MVALID; m += NGW) {
                    float* hr = hrow_ptr(hp_out, hp_meta, m); const bf16* fr_ = fb0 + (size_t)m * 1024;
                    f32x4 v[4]; float fv[16]; float s1 = 0.f;
#pragma unroll
                    for (int hh = 0; hh < 2; ++hh) { const v4u w = *(const v4u*)(fr_ + hh * 512 + lane * 8);
                        fv[hh * 8 + 0] = bflo(w.x); fv[hh * 8 + 1] = bfhi(w.x); fv[hh * 8 + 2] = bflo(w.y); fv[hh * 8 + 3] = bfhi(w.y); fv[hh * 8 + 4] = bflo(w.z); fv[hh * 8 + 5] = bfhi(w.z); fv[hh * 8 + 6] = bflo(w.w); fv[hh * 8 + 7] = bfhi(w.w); }
#pragma unroll
                    for (int q = 0; q < 4; ++q) v[q] = *(const f32x4*)(hr + (q >> 1) * 512 + lane * 8 + (q & 1) * 4);
#pragma unroll
                    for (int e = 0; e < 16; ++e) s1 += fv[e] * fv[e];
                    const float r1 = coef / sqrtf(wave_sum(s1) * (1.f / DM_) + 1e-6f); float s2 = 0.f;
#pragma unroll
                    for (int q = 0; q < 4; ++q) { const f32x4 gp = *(const f32x4*)(gpost + (q >> 1) * 512 + lane * 8 + (q & 1) * 4);
#pragma unroll
                        for (int i = 0; i < 4; ++i) { v[q][i] += fv[q * 4 + i] * r1 * gp[i]; s2 += v[q][i] * v[q][i]; } }
                    const float r2 = 1.0f / sqrtf(wave_sum(s2) * (1.f / DM_) + 1e-6f);
#pragma unroll
                    for (int q = 0; q < 4; ++q) *(f32x4*)(hr + (q >> 1) * 512 + lane * 8 + (q & 1) * 4) = v[q];
                    if (wnext) {
#pragma unroll
                        for (int hh = 0; hh < 2; ++hh) { const f32x4 g0 = *(const f32x4*)(gnext + hh * 512 + lane * 8), g1 = *(const f32x4*)(gnext + hh * 512 + lane * 8 + 4); const f32x4 a = v[2 * hh] * r2 * g0, b = v[2 * hh + 1] * r2 * g1;
                            v4u o; o.x = pk2(a[0], a[1]); o.y = pk2(a[2], a[3]); o.z = pk2(b[0], b[1]); o.w = pk2(b[2], b[3]); *(v4u*)(xn0 + (size_t)m * 1024 + hh * 512 + lane * 8) = o; }
                    }
                }
            } else if (kind == K_CONV) {
                const float* cw = in_ptr(7) + (size_t)jm * 3 * DM_; const bf16* const big0 = P_BIG; bf16* const xn0 = P_XN;
                for (int m = gw; m < MVALID; m += NGW) {
                    const int m1 = prev_row(m, 1), m2 = prev_row(m, 2);
#pragma unroll
                    for (int hh = 0; hh < 2; ++hh) { const int d0 = hh * 512 + lane * 8; float acc8[8];
#pragma unroll
                        for (int k = 0; k < 3; ++k) { const int mr = (k == 2) ? m : (k == 1 ? m1 : m2); v4u cc = {0u, 0u, 0u, 0u}, xx = cc;
                            if (mr >= 0) { cc = *(const v4u*)(big0 + (size_t)mr * 3072 + 1024 + d0); xx = *(const v4u*)(big0 + (size_t)mr * 3072 + 2048 + d0); }
                            const f32x4 w0 = *(const f32x4*)(cw + k * DM_ + d0), w1 = *(const f32x4*)(cw + k * DM_ + d0 + 4);
                            const float u0 = bflo(cc.x) * bflo(xx.x), u1 = bfhi(cc.x) * bfhi(xx.x), u2 = bflo(cc.y) * bflo(xx.y), u3 = bfhi(cc.y) * bfhi(xx.y);
                            const float u4 = bflo(cc.z) * bflo(xx.z), u5 = bfhi(cc.z) * bfhi(xx.z), u6 = bflo(cc.w) * bflo(xx.w), u7 = bfhi(cc.w) * bfhi(xx.w);
                            if (k == 0) { acc8[0] = w0[0] * u0; acc8[1] = w0[1] * u1; acc8[2] = w0[2] * u2; acc8[3] = w0[3] * u3; acc8[4] = w1[0] * u4; acc8[5] = w1[1] * u5; acc8[6] = w1[2] * u6; acc8[7] = w1[3] * u7; }
                            else { acc8[0] += w0[0] * u0; acc8[1] += w0[1] * u1; acc8[2] += w0[2] * u2; acc8[3] += w0[3] * u3; acc8[4] += w1[0] * u4; acc8[5] += w1[1] * u5; acc8[6] += w1[2] * u6; acc8[7] += w1[3] * u7; } }
                        const v4u bb = *(const v4u*)(big0 + (size_t)m * 3072 + d0);
                        v4u o; o.x = pk2(bflo(bb.x) * acc8[0], bfhi(bb.x) * acc8[1]); o.y = pk2(bflo(bb.y) * acc8[2], bfhi(bb.y) * acc8[3]); o.z = pk2(bflo(bb.z) * acc8[4], bfhi(bb.z) * acc8[5]); o.w = pk2(bflo(bb.w) * acc8[6], bfhi(bb.w) * acc8[7]);
                        *(v4u*)(xn0 + (size_t)m * 1024 + d0) = o; }
                }
            } else if (kind == K_ATTN) {
                bf16* const big0 = P_BIG; const attn_body::AttnTensors AT{(const attn_body::bf16*)big0, (const attn_body::bf16*)(big0 + (size_t)QROWS * 1024), (const attn_body::bf16*)(big0 + (size_t)2 * QROWS * 1024), (attn_body::bf16*)P_XN};
                attn_body::attn_phase<8>((char*)lds, AT, vcu, G);
            } else {
                const float linit = 0.8f - 0.6f * expf(-0.3f * (float)lq);
                const float* lp = in_ptr(10) + (size_t)jm * 4 * 64;
                const float lam = expf(wave_sum(lp[lane] * lp[64 + lane])) - expf(wave_sum(lp[128 + lane] * lp[192 + lane])) + linit;
                const float* sg = in_ptr(11) + (size_t)jm * 128; const int hd = lane >> 3, dv0 = (lane & 7) * 16;
                float gs[16];
#pragma unroll
                for (int q = 0; q < 4; ++q) { const f32x4 t4 = *(const f32x4*)(sg + dv0 + q * 4); gs[q * 4 + 0] = t4[0] * (1.f - linit); gs[q * 4 + 1] = t4[1] * (1.f - linit); gs[q * 4 + 2] = t4[2] * (1.f - linit); gs[q * 4 + 3] = t4[3] * (1.f - linit); }
                const bf16* const ob0 = P_XN; bf16* const big0 = P_BIG;
                for (int m = gw; m < MVALID; m += NGW) {
                    const bf16* orow = ob0 + (size_t)qkv_row(m) * 2048 + hd * 256 + dv0;
                    const v4u a0 = *(const v4u*)(orow), a1 = *(const v4u*)(orow + 8), b0 = *(const v4u*)(orow + 128), b1 = *(const v4u*)(orow + 136);
                    float d[16];
                    d[0] = bflo(a0.x) - lam * bflo(b0.x); d[1] = bfhi(a0.x) - lam * bfhi(b0.x); d[2] = bflo(a0.y) - lam * bflo(b0.y); d[3] = bfhi(a0.y) - lam * bfhi(b0.y);
                    d[4] = bflo(a0.z) - lam * bflo(b0.z); d[5] = bfhi(a0.z) - lam * bfhi(b0.z); d[6] = bflo(a0.w) - lam * bflo(b0.w); d[7] = bfhi(a0.w) - lam * bfhi(b0.w);
                    d[8] = bflo(a1.x) - lam * bflo(b1.x); d[9] = bfhi(a1.x) - lam * bfhi(b1.x); d[10] = bflo(a1.y) - lam * bflo(b1.y); d[11] = bfhi(a1.y) - lam * bfhi(b1.y);
                    d[12] = bflo(a1.z) - lam * bflo(b1.z); d[13] = bfhi(a1.z) - lam * bfhi(b1.z); d[14] = bflo(a1.w) - lam * bflo(b1.w); d[15] = bfhi(a1.w) - lam * bfhi(b1.w);
                    float ss = 0.f;
#pragma unroll
                    for (int e = 0; e < 16; ++e) ss += d[e] * d[e];
                    ss += __shfl_xor(ss, 1); ss += __shfl_xor(ss, 2); ss += __shfl_xor(ss, 4);
                    const float rr = 1.0f / sqrtf(ss * (1.f / 128.f) + 1e-5f);
                    v4u o0, o1;
                    o0.x = pk2(d[0] * rr * gs[0], d[1] * rr * gs[1]); o0.y = pk2(d[2] * rr * gs[2], d[3] * rr * gs[3]); o0.z = pk2(d[4] * rr * gs[4], d[5] * rr * gs[5]); o0.w = pk2(d[6] * rr * gs[6], d[7] * rr * gs[7]);
                    o1.x = pk2(d[8] * rr * gs[8], d[9] * rr * gs[9]); o1.y = pk2(d[10] * rr * gs[10], d[11] * rr * gs[11]); o1.z = pk2(d[12] * rr * gs[12], d[13] * rr * gs[13]); o1.w = pk2(d[14] * rr * gs[14], d[15] * rr * gs[15]);
                    bf16* yr = big0 + (size_t)m * 1024 + hd * 128 + dv0; *(v4u*)yr = o0; *(v4u*)(yr + 8) = o1;
                }
            }
            GSYNC();
        }
    }
}

extern "C" void kernel_launch(void* const* d_in, const int* in_sizes, int n_in, void* d_out, int out_size, void* d_ws, size_t ws_size, hipStream_t stream) {
    static int grid = 0;
    if (grid == 0) {
        if (n_in != 16 || out_size != MREAL * DM_ || ws_size < WS_END) { fprintf(stderr, "kernel_launch: unexpected shapes: n_in %d out %d ws %zu (need %zu)\n", n_in, out_size, ws_size, (size_t)WS_END); grid = -1; return; }
        int dev = 0, cus = 0, per_cu = 0;
        if (hipGetDevice(&dev) != hipSuccess || hipDeviceGetAttribute(&cus, hipDeviceAttributeMultiprocessorCount, dev) != hipSuccess) { grid = -1; return; }
        if (hipFuncSetAttribute((const void*)trunk_fwd, hipFuncAttributeMaxDynamicSharedMemorySize, LDS_BYTES) != hipSuccess) { fprintf(stderr, "kernel_launch: hipFuncSetAttribute failed\n"); grid = -1; return; }
        if (hipOccupancyMaxActiveBlocksPerMultiprocessor(&per_cu, (const void*)trunk_fwd, NWAVES * 64, LDS_BYTES) != hipSuccess || per_cu < 1) { fprintf(stderr, "kernel_launch: occupancy query says %d\n", per_cu); per_cu = 1; }
        (void)hipGetLastError();
        grid = cus * per_cu;
    }
    if (grid < 0) return;
    Args a{};
    for (int i = 0; i < 16; ++i) a.in[i] = (const float*)d_in[i];
    a.out = (float*)d_out; a.ws = (unsigned char*)d_ws;
    void* kargs[] = {&a};
    hipError_t e = hipLaunchCooperativeKernel((const void*)trunk_fwd, dim3(grid), dim3(NWAVES * 64), kargs, LDS_BYTES, stream);
    if (e != hipSuccess) fprintf(stderr, "kernel_launch: cooperative launch failed: %s (grid %d)\n", hipGetErrorString(e), grid);
}
```

```cpp
#include <hip/hip_runtime.h>
#include <cstdio>
#include <cstdint>
__device__ __forceinline__ int opaque_tid() { int t = threadIdx.x; asm volatile("" : "+v"(t)); return t; }
namespace pg8 {
#define PG8_LAS __attribute__((address_space(3)))
typedef unsigned short bf16_t;
typedef short bf16x8 __attribute__((ext_vector_type(8)));
typedef float f32x4 __attribute__((ext_vector_type(4)));
typedef unsigned u32x4 __attribute__((ext_vector_type(4)));
constexpr int BM = 256, BK = 64, HALF = 128, HTB = HALF * BK * 2  , STAGE_BYTES = 8 * HTB, NXCD = 8, WGM = 4;

__host__ __device__ __forceinline__ int lds_byte(int r, int c) { const int st = (r >> 4) * 2 + (c >> 5), rr = r & 15, cc = c & 31, ob = rr * 64 + cc * 2; return st * 1024 + (ob ^ (((ob >> 9) & 1) << 5)); }
__host__ __device__ __forceinline__ void stage_rc(int b, int& R, int& C) { const int st = b / 1024, sb = b % 1024, swz = sb ^ (((sb >> 9) & 1) << 5); R = (st >> 1) * 16 + swz / 64; C = (st & 1) * 32 + (swz % 64) / 2; }
__host__ __device__ __forceinline__ int perm32(int rho) { const int n = rho >> 4, i = rho & 15; return 8 * (i >> 2) + 4 * n + (i & 3); }

struct Unit { int pm, pn; };
struct Gemm { const bf16_t* A; const bf16_t* Bt; int M, N, K; };

struct StaticOrder {
    int nM, nN, nwg, G, c;
    __host__ __device__ void init(int M, int N, int G_, int c_) { nM = M / BM; nN = N / BM; nwg = nM * nN; G = G_; c = c_; }
    __host__ __device__ bool next(int i, Unit& u) const {
        const long L = (long)i * G + c; if (L >= nwg) return false;
        int wgid = (int)L; { const int q = nwg / NXCD, r = nwg % NXCD, xcd = wgid % NXCD, off = wgid / NXCD; wgid = (xcd < r ? xcd * (q + 1) : r * (q + 1) + (xcd - r) * q) + off; }
        const int nig = WGM * nN, gid = wgid / nig, fm = gid * WGM, gsz = (nM - fm) < WGM ? (nM - fm) : WGM;
        u.pm = fm + ((wgid % nig) % gsz); u.pn = (wgid % nig) / gsz; return true;
    }
    __device__ __forceinline__ void a_ready(const Unit&) const {}
    __device__ __forceinline__ void done(const Unit&) const {}
};

__device__ __forceinline__ unsigned cvt_pk_bf16(float lo, float hi) { unsigned r; asm volatile("v_cvt_pk_bf16_f32 %0, %1, %2" : "=v"(r) : "v"(lo), "v"(hi)); return r; }
typedef float f32x2 __attribute__((ext_vector_type(2)));
__device__ __forceinline__ f32x2 gelu_pk(f32x2 v) {
    const f32x2 av = __builtin_elementwise_abs(v), d = av * 0.2316418882f + 1.0f;
    f32x2 t; t.x = __builtin_amdgcn_rcpf(d.x); t.y = __builtin_amdgcn_rcpf(d.y);
    f32x2 q = t * 0.5307027145f + (-0.7265760135f); q = q * t + 0.7107068705f; q = q * t + (-0.142248368f); q = q * t + 0.127414796f; q = q * t;
    const f32x2 s = (v * v) * (-0.72134752044f);
    f32x2 e; e.x = __builtin_amdgcn_exp2f(s.x); e.y = __builtin_amdgcn_exp2f(s.y);
    const f32x2 m = v * (q * e), r = v - m;
    f32x2 o; o.x = v.x < 0.f ? m.x : r.x; o.y = v.y < 0.f ? m.y : r.y; return o;
}

template <int ACT  > struct EpiBf16 {
    static constexpr bool PERM = true, AFTER_DRAIN = false; static_assert(ACT == 0 || ACT == 1, "EpiBf16: ACT is 0 (none) or 1 (gelu_pk)");
    bf16_t* O; int ldc; const float* bias; int split_cols; size_t split_stride; float scale0;
    __device__ __forceinline__ void operator()(const f32x4 (&acc)[2][2][4][2], const Unit& u, int wr, int wc, int fr, int fq) const {
        const int row0 = u.pm * BM + wr * 64 + fr; int colt = u.pn * BM; bf16_t* base = O;
        float sc = 1.f; if (split_cols) { const int t = colt / split_cols; base += (size_t)t * split_stride; colt -= t * split_cols; if (t == 0) sc = scale0; }
        const int col0 = colt + wc * 32 + 8 * fq, bcol0 = u.pn * BM + wc * 32 + 8 * fq;
        f32x4 bv[2][2];
#pragma unroll
        for (int bj = 0; bj < 2; ++bj)
#pragma unroll
            for (int n = 0; n < 2; ++n) bv[bj][n] = bias ? *(const f32x4*)(bias + bcol0 + bj * HALF + 4 * n) : (f32x4){0.f, 0.f, 0.f, 0.f};
#pragma unroll
        for (int ai = 0; ai < 2; ++ai)
#pragma unroll
            for (int m = 0; m < 4; ++m) { bf16_t* rowp = base + (size_t)(row0 + ai * HALF + m * 16) * ldc + col0;
#pragma unroll
                for (int bj = 0; bj < 2; ++bj) { f32x4 v0 = acc[ai][bj][m][0] + bv[bj][0], v1 = acc[ai][bj][m][1] + bv[bj][1];
                    if (ACT == 1) { f32x2 a = gelu_pk((f32x2){v0[0], v0[1]}), b = gelu_pk((f32x2){v0[2], v0[3]}), c = gelu_pk((f32x2){v1[0], v1[1]}), d = gelu_pk((f32x2){v1[2], v1[3]});
                        v0 = (f32x4){a.x, a.y, b.x, b.y}; v1 = (f32x4){c.x, c.y, d.x, d.y}; }
                    v0 = v0 * sc; v1 = v1 * sc; u32x4 w; w.x = cvt_pk_bf16(v0[0], v0[1]); w.y = cvt_pk_bf16(v0[2], v0[3]); w.z = cvt_pk_bf16(v1[0], v1[1]); w.w = cvt_pk_bf16(v1[2], v1[3]);
                    *(u32x4*)(rowp + bj * HALF) = w; } }
    }
};

struct PanelStats {
    unsigned* xbuf;
    unsigned* cnt;
    unsigned* tmo;
    int ntn; float eps;
    unsigned code;
    __device__ __forceinline__ bool run(const f32x4 (&v)[2][2][4][2], const Unit& u, int wr, int wc, int fr, int fq, PG8_LAS unsigned char* lds, int wid, int lane) const {
        typedef float f32x2v __attribute__((ext_vector_type(2)));
        PG8_LAS f32x2v* P = (PG8_LAS f32x2v*)lds;
        PG8_LAS f32x2v* S = (PG8_LAS f32x2v*)(lds + 8192);
        PG8_LAS unsigned* flag = (PG8_LAS unsigned*)(lds + 8192 + 2048);
#pragma unroll
        for (int ai = 0; ai < 2; ++ai)
#pragma unroll
            for (int m = 0; m < 4; ++m) {
                float s = 0.f;
#pragma unroll
                for (int bj = 0; bj < 2; ++bj)
#pragma unroll
                    for (int n = 0; n < 2; ++n) { const f32x4 x = v[ai][bj][m][n]; s += (x[0] + x[1]) + (x[2] + x[3]); }
                s += __shfl_xor(s, 16); s += __shfl_xor(s, 32);
                const float mw = s * (1.0f / 64.0f); float q = 0.f;
#pragma unroll
                for (int bj = 0; bj < 2; ++bj)
#pragma unroll
                    for (int n = 0; n < 2; ++n) { const f32x4 d = v[ai][bj][m][n] - mw; q += (d[0] * d[0] + d[1] * d[1]) + (d[2] * d[2] + d[3] * d[3]); }
                q += __shfl_xor(q, 16); q += __shfl_xor(q, 32);
                if (fq == 0) P[(ai * HALF + wr * 64 + m * 16 + fr) * 4 + wc] = (f32x2v){mw, q};
            }
        asm volatile("s_waitcnt lgkmcnt(0)" ::: "memory"); __builtin_amdgcn_s_barrier(); asm volatile("" ::: "memory");
#if defined(BROKEN_EXCHANGE_NO_WAIT)
#warning BROKEN CONTROL BUILD: the row-statistics exchange does not wait; results are wrong by design
        if (blockIdx.x >= 64) { const long long t0_ = clock64(); while (clock64() - t0_ < 60000) __builtin_amdgcn_s_sleep(8); }
#endif
        const int row = wid * 32 + (lane & 31);
        if (lane < 32) {
            const f32x2v a = P[row * 4 + 0], b = P[row * 4 + 1], c = P[row * 4 + 2], d = P[row * 4 + 3];
            const float mt = (a.x + b.x + c.x + d.x) * 0.25f;
            const float da = a.x - mt, db = b.x - mt, dc = c.x - mt, dd = d.x - mt;
            const float m2 = (a.y + b.y) + (c.y + d.y) + 64.0f * ((da * da + db * db) + (dc * dc + dd * dd));
            unsigned long long* slot = (unsigned long long*)xbuf + ((size_t)(u.pm * BM + row) * 4 + u.pn);
            __hip_atomic_store(slot, ((unsigned long long)__float_as_uint(m2) << 32) | __float_as_uint(mt), __ATOMIC_RELAXED, __HIP_MEMORY_SCOPE_AGENT);
        }
        asm volatile("s_waitcnt vmcnt(0)" ::: "memory");
        if (lane == 0) __hip_atomic_fetch_add(cnt + 64 * u.pm, 1u, __ATOMIC_RELAXED, __HIP_MEMORY_SCOPE_AGENT);
        if (wid == 0) {
            bool dead = false; const unsigned long long t0 = __builtin_amdgcn_s_memrealtime(); const unsigned want = 8u * (unsigned)ntn;
            for (;;) {
#if defined(BROKEN_EXCHANGE_NO_WAIT)
                break;
#endif
                if ((unsigned)__builtin_amdgcn_readfirstlane(__hip_atomic_load(cnt + 64 * u.pm, __ATOMIC_RELAXED, __HIP_MEMORY_SCOPE_AGENT)) >= want) break;
                if (__builtin_amdgcn_s_memrealtime() - t0 > 2000000ull) {
                    if (lane == 0) { unsigned expect = 0u; __hip_atomic_compare_exchange_strong(tmo + 1, &expect, code | (unsigned)(u.pm & 0xff), __ATOMIC_RELAXED, __ATOMIC_RELAXED, __HIP_MEMORY_SCOPE_AGENT);
                                     __hip_atomic_store(tmo, 1u, __ATOMIC_RELAXED, __HIP_MEMORY_SCOPE_AGENT); }
                    dead = true; break; }
                __builtin_amdgcn_s_sleep(2);
            }
            __builtin_amdgcn_fence(__ATOMIC_ACQUIRE, "agent");
            if (lane == 0) flag[0] = dead ? 1u : 0u;
        }
        asm volatile("s_waitcnt vmcnt(0) lgkmcnt(0)" ::: "memory"); __builtin_amdgcn_s_barrier(); asm volatile("" ::: "memory");
        const bool bad = flag[0] != 0u;
        if (lane < 32) {
            const unsigned long long* slot = (const unsigned long long*)xbuf + (size_t)(u.pm * BM + row) * 4; float mt[4], m2[4]; float ms = 0.f;
#pragma unroll
            for (int t = 0; t < 4; ++t) { if (t < ntn) { const unsigned long long w = __hip_atomic_load(slot + t, __ATOMIC_RELAXED, __HIP_MEMORY_SCOPE_AGENT); mt[t] = __uint_as_float((unsigned)w); m2[t] = __uint_as_float((unsigned)(w >> 32)); } else { mt[t] = 0.f; m2[t] = 0.f; } ms += mt[t]; }
            const float mean = ms / (float)ntn; float q = 0.f;
#pragma unroll
            for (int t = 0; t < 4; ++t) if (t < ntn) { const float dm = mt[t] - mean; q += m2[t] + 256.0f * dm * dm; }
            S[row] = (f32x2v){mean, 1.0f / sqrtf(q / (256.0f * (float)ntn) + eps)};
        }
        asm volatile("s_waitcnt lgkmcnt(0)" ::: "memory"); __builtin_amdgcn_s_barrier(); asm volatile("" ::: "memory");
        return bad;
    }
};
struct EpiLnRes {
    static constexpr bool PERM = false, AFTER_DRAIN = true;
    const float* base; float* out; int ldc; const float* bias; PanelStats st; unsigned poison;
    __device__ __forceinline__ void fused(f32x4 (&acc)[2][2][4][2], const Unit& u, int wr, int wc, int fr, int fq, PG8_LAS unsigned char* lds, int wid, int lane) const {
        typedef float f32x2v __attribute__((ext_vector_type(2)));
        const PG8_LAS f32x2v* S = (const PG8_LAS f32x2v*)(lds + 8192);
        const int col0 = u.pn * BM + wc * 32 + 4 * fq;
#pragma unroll
        for (int bj = 0; bj < 2; ++bj)
#pragma unroll
            for (int n = 0; n < 2; ++n) { const f32x4 bv = bias ? *(const f32x4*)(bias + col0 + bj * HALF + n * 16) : (f32x4){0.f, 0.f, 0.f, 0.f};
#pragma unroll
                for (int ai = 0; ai < 2; ++ai)
#pragma unroll
                    for (int m = 0; m < 4; ++m) acc[ai][bj][m][n] += bv; }
        f32x4 pre[4][2][2];
#pragma unroll
        for (int m = 0; m < 4; ++m) { const size_t off = (size_t)(u.pm * BM + wr * 64 + m * 16 + fr) * ldc + col0;
#pragma unroll
            for (int bj = 0; bj < 2; ++bj)
#pragma unroll
                for (int n = 0; n < 2; ++n) pre[m][bj][n] = *(const f32x4*)(base + off + bj * HALF + n * 16); }
        const bool bad = st.run(acc, u, wr, wc, fr, fq, lds, wid, lane) || poison != 0u;
        const float qnan = __builtin_nanf("");
#pragma unroll
        for (int ai = 0; ai < 2; ++ai)
#pragma unroll
            for (int m = 0; m < 4; ++m) { const int r = ai * HALF + wr * 64 + m * 16 + fr; const f32x2v sr = S[r]; const size_t off = (size_t)(u.pm * BM + r) * ldc + col0;
#pragma unroll
                for (int bj = 0; bj < 2; ++bj)
#pragma unroll
                    for (int n = 0; n < 2; ++n) { const f32x4 bs = ai == 0 ? pre[m][bj][n] : *(const f32x4*)(base + off + bj * HALF + n * 16); f32x4 o = bs + (acc[ai][bj][m][n] - sr.x) * sr.y;
                        if (bad) o = (f32x4){qnan, qnan, qnan, qnan}; *(f32x4*)(out + off + bj * HALF + n * 16) = o; }
                if (m & 1) asm volatile("" ::: "memory"); }
    }
};
struct EpiLnResLn {
    static constexpr bool PERM = false, AFTER_DRAIN = true;
    const float* base; float* out; bf16_t* xn; int ldc; const float* bias; PanelStats st1, st2; unsigned poison;
    __device__ __forceinline__ void fused(f32x4 (&acc)[2][2][4][2], const Unit& u, int wr, int wc, int fr, int fq, PG8_LAS unsigned char* lds, int wid, int lane) const {
        typedef float f32x2v __attribute__((ext_vector_type(2))); typedef unsigned u32x2v __attribute__((ext_vector_type(2)));
        const PG8_LAS f32x2v* S = (const PG8_LAS f32x2v*)(lds + 8192);
        const int col0 = u.pn * BM + wc * 32 + 4 * fq;
#pragma unroll
        for (int bj = 0; bj < 2; ++bj)
#pragma unroll
            for (int n = 0; n < 2; ++n) { const f32x4 bv = bias ? *(const f32x4*)(bias + col0 + bj * HALF + n * 16) : (f32x4){0.f, 0.f, 0.f, 0.f};
#pragma unroll
                for (int ai = 0; ai < 2; ++ai)
#pragma unroll
                    for (int m = 0; m < 4; ++m) acc[ai][bj][m][n] += bv; }
        bool bad = st1.run(acc, u, wr, wc, fr, fq, lds, wid, lane) || poison != 0u;
        const float qnan = __builtin_nanf("");
#pragma unroll
        for (int ai = 0; ai < 2; ++ai)
#pragma unroll
            for (int m = 0; m < 4; ++m) { const int r = ai * HALF + wr * 64 + m * 16 + fr; const f32x2v sr = S[r]; const size_t off = (size_t)(u.pm * BM + r) * ldc + col0;
#pragma unroll
                for (int bj = 0; bj < 2; ++bj)
#pragma unroll
                    for (int n = 0; n < 2; ++n) { const f32x4 bs = *(const f32x4*)(base + off + bj * HALF + n * 16); acc[ai][bj][m][n] = bs + (acc[ai][bj][m][n] - sr.x) * sr.y; }
                asm volatile("" : "+v"(acc[ai][0][m][0]), "+v"(acc[ai][0][m][1]), "+v"(acc[ai][1][m][0]), "+v"(acc[ai][1][m][1]));
                if (m & 1) asm volatile("" ::: "memory"); }
        const bool bad1 = bad;
        bad = st2.run(acc, u, wr, wc, fr, fq, lds, wid, lane) || bad;
#pragma unroll
        for (int ai = 0; ai < 2; ++ai)
#pragma unroll
            for (int m = 0; m < 4; ++m) { const int r = ai * HALF + wr * 64 + m * 16 + fr; const f32x2v sr = S[r]; const size_t off = (size_t)(u.pm * BM + r) * ldc + col0;
#pragma unroll
                for (int bj = 0; bj < 2; ++bj)
#pragma unroll
                    for (int n = 0; n < 2; ++n) { const f32x4 x1 = acc[ai][bj][m][n]; *(f32x4*)(out + off + bj * HALF + n * 16) = bad1 ? (f32x4){qnan, qnan, qnan, qnan} : x1;
                        const f32x4 o = (x1 - sr.x) * sr.y; u32x2v w; w.x = cvt_pk_bf16(o[0], o[1]); w.y = cvt_pk_bf16(o[2], o[3]);
                        if (bad) { w.x = 0x7fc07fc0u; w.y = 0x7fc07fc0u; } *(u32x2v*)(xn + off + bj * HALF + n * 16) = w; }
                asm volatile("" ::: "memory"); }
    }
};

template <class Epi, class Sched, bool ALIGN_EPI = false, bool SP2 = false>
__device__ __forceinline__ void gemm_phase(PG8_LAS unsigned char* lds, const Gemm g, const Sched& S, const Epi& E) {
    const int tid = opaque_tid(), wid = __builtin_amdgcn_readfirstlane(tid >> 6), lane = tid & 63, wr = wid >> 2, wc = wid & 3, fr = lane & 15, fq = lane >> 4;
    const int K = g.K, nt = K / BK;
    unsigned voffA[2], voffB[2];
#pragma unroll
    for (int i = 0; i < 2; ++i) { int R, C; stage_rc(tid * 16 + i * 8192, R, C); const int Rb = Epi::PERM ? ((R & ~31) + perm32(R & 31)) : R;
        voffA[i] = (unsigned)(R * K + C) * 2u; voffB[i] = (unsigned)(Rb * K + C) * 2u; }
    const size_t kstep = (size_t)(BK * 2);
    const size_t hstep = (size_t)HALF * K * 2;
    const size_t tstep = 2 * hstep;
    const unsigned ldsw = (unsigned)wid * 1024u;
    const int aoff = lds_byte(wr * 64 + fr, fq * 8), boff = lds_byte(wc * 32 + fr, fq * 8);
#define PG8_SA(b, h) (((b) * 2 + (h)) * HTB)
#define PG8_SB(b, h) ((4 + (b) * 2 + (h)) * HTB)
#define PG8_STAGE(bufoff, gbase, voff) do { _Pragma("unroll") for (int _i = 0; _i < 2; ++_i) \
        __builtin_amdgcn_global_load_lds((const unsigned*)((const char*)(gbase) + (voff)[_i]), (PG8_LAS unsigned*)(lds + (bufoff) + ldsw + _i * 8192), 16, 0, 0); } while (0)
#define PG8_LDA(dst, b, h) do { _Pragma("unroll") for (int m = 0; m < 4; ++m) _Pragma("unroll") for (int k = 0; k < 2; ++k) dst[m][k] = *(const PG8_LAS bf16x8*)(lds + PG8_SA(b, h) + aoff + m * 2048 + k * 1024); } while (0)
#define PG8_LDB(dst, b, h) do { _Pragma("unroll") for (int n = 0; n < 2; ++n) _Pragma("unroll") for (int k = 0; k < 2; ++k) dst[n][k] = *(const PG8_LAS bf16x8*)(lds + PG8_SB(b, h) + boff + n * 2048 + k * 1024); } while (0)
#define PG8_MMA(ai, bj, At, Bt) do { __builtin_amdgcn_s_setprio(1); _Pragma("unroll") for (int m = 0; m < 4; ++m) _Pragma("unroll") for (int n = 0; n < 2; ++n) _Pragma("unroll") for (int k = 0; k < 2; ++k) \
        acc[ai][bj][m][n] = __builtin_amdgcn_mfma_f32_16x16x32_bf16(Bt[n][k], At[m][k], acc[ai][bj][m][n], 0, 0, 0); __builtin_amdgcn_s_setprio(0); } while (0)
#define PG8_WAIT_V(n) asm volatile("s_waitcnt vmcnt(" #n ")" ::: "memory")
#define PG8_WAIT_L(n) asm volatile("s_waitcnt lgkmcnt(" #n ")" ::: "memory")
#define PG8_BAR __builtin_amdgcn_s_barrier()
#define PG8_SCHED __builtin_amdgcn_sched_barrier(0)
    Unit cur, nxt; int ui = 0;
    if (!S.next(0, cur)) return;
    f32x4 acc[2][2][4][2];
#pragma unroll
    for (int a = 0; a < 2; ++a)
#pragma unroll
        for (int b = 0; b < 2; ++b)
#pragma unroll
            for (int m = 0; m < 4; ++m)
#pragma unroll
                for (int n = 0; n < 2; ++n) acc[a][b][m][n] = (f32x4){0.f, 0.f, 0.f, 0.f};
    bf16x8 At[4][2], B0[2][2], B1[2][2];
    const char* cA = (const char*)g.A + (size_t)cur.pm * tstep; const char* cB = (const char*)g.Bt + (size_t)cur.pn * tstep;
    S.a_ready(cur);
    if constexpr (SP2) {
        PG8_STAGE(PG8_SB(0, 0), cB, voffB); PG8_STAGE(PG8_SB(0, 1), cB + hstep, voffB); PG8_STAGE(PG8_SA(0, 0), cA, voffA); PG8_STAGE(PG8_SA(0, 1), cA + hstep, voffA);
        if (wr == 1) PG8_BAR;
        PG8_WAIT_V(2); PG8_BAR;
        PG8_STAGE(PG8_SB(1, 0), cB + kstep, voffB); PG8_STAGE(PG8_SA(1, 0), cA + kstep, voffA); PG8_STAGE(PG8_SB(1, 1), cB + hstep + kstep, voffB);
        PG8_WAIT_V(6); PG8_BAR;
    } else {
        PG8_STAGE(PG8_SB(0, 0), cB, voffB); PG8_STAGE(PG8_SA(0, 0), cA, voffA); PG8_STAGE(PG8_SB(0, 1), cB + hstep, voffB); PG8_STAGE(PG8_SA(0, 1), cA + hstep, voffA);
        if (wr == 1) PG8_BAR;
        PG8_WAIT_V(4); PG8_BAR;
        PG8_STAGE(PG8_SB(1, 0), cB + kstep, voffB); PG8_STAGE(PG8_SA(1, 0), cA + kstep, voffA); PG8_STAGE(PG8_SB(1, 1), cB + hstep + kstep, voffB);
        PG8_WAIT_V(6); PG8_BAR;
    }
    for (;;) {
        const bool has_next = S.next(ui + 1, nxt);
        const char* nA = has_next ? (const char*)g.A + (size_t)nxt.pm * tstep : cA; const char* nB = has_next ? (const char*)g.Bt + (size_t)nxt.pn * tstep : cB;
        for (int t = 0; t < nt; t += 2) {
            const bool last = (t == nt - 2);
            const char* a1 = cA + (size_t)(t + 1) * kstep;
            const char* a2 = last ? nA : cA + (size_t)(t + 2) * kstep; const char* b2 = last ? nB : cB + (size_t)(t + 2) * kstep;
            const char* a3 = a2 + kstep; const char* b3 = b2 + kstep;
            if (last && has_next) S.a_ready(nxt);
            if constexpr (SP2) {
            PG8_LDB(B0, 0, 0); PG8_LDB(B1, 0, 1); PG8_SCHED; PG8_LDA(At, 0, 0); PG8_STAGE(PG8_SA(1, 1), a1 + hstep, voffA);
            PG8_WAIT_V(8); PG8_WAIT_L(0); PG8_BAR; PG8_MMA(0, 0, At, B0); PG8_MMA(0, 1, At, B1); PG8_BAR; PG8_SCHED;
            PG8_LDA(At, 0, 1); PG8_STAGE(PG8_SB(0, 0), b2, voffB); PG8_STAGE(PG8_SB(0, 1), b2 + hstep, voffB); PG8_STAGE(PG8_SA(0, 0), a2, voffA);
            PG8_WAIT_V(8); PG8_WAIT_L(0); PG8_BAR; PG8_MMA(1, 0, At, B0); PG8_MMA(1, 1, At, B1); PG8_BAR; PG8_SCHED;
            PG8_LDB(B0, 1, 0); PG8_LDB(B1, 1, 1); PG8_SCHED; PG8_LDA(At, 1, 0); PG8_STAGE(PG8_SA(0, 1), a2 + hstep, voffA);
            PG8_WAIT_V(8); PG8_WAIT_L(0); PG8_BAR; PG8_MMA(0, 0, At, B0); PG8_MMA(0, 1, At, B1); PG8_BAR; PG8_SCHED;
            PG8_LDA(At, 1, 1); PG8_STAGE(PG8_SB(1, 0), b3, voffB); PG8_STAGE(PG8_SB(1, 1), b3 + hstep, voffB); PG8_STAGE(PG8_SA(1, 0), a3, voffA);
            PG8_WAIT_V(8); PG8_WAIT_L(0); PG8_BAR; PG8_MMA(1, 0, At, B0); PG8_MMA(1, 1, At, B1); PG8_BAR; PG8_SCHED;
            } else {
            PG8_LDB(B0, 0, 0); PG8_SCHED; PG8_LDA(At, 0, 0); PG8_STAGE(PG8_SA(1, 1), a1 + hstep, voffA);
            PG8_WAIT_L(8); PG8_BAR; PG8_WAIT_L(0); PG8_MMA(0, 0, At, B0); PG8_BAR; PG8_SCHED;
            PG8_LDB(B1, 0, 1); PG8_STAGE(PG8_SB(0, 0), b2, voffB);
            PG8_BAR; PG8_WAIT_L(0); PG8_MMA(0, 1, At, B1); PG8_BAR;
            PG8_LDA(At, 0, 1); PG8_STAGE(PG8_SA(0, 0), a2, voffA);
            PG8_BAR; PG8_WAIT_L(0); PG8_MMA(1, 0, At, B0); PG8_BAR; PG8_SCHED;
            PG8_STAGE(PG8_SB(0, 1), b2 + hstep, voffB);
            PG8_WAIT_V(6); PG8_BAR; PG8_MMA(1, 1, At, B1); PG8_BAR;
            PG8_LDB(B0, 1, 0); PG8_SCHED; PG8_LDA(At, 1, 0); PG8_STAGE(PG8_SA(0, 1), a2 + hstep, voffA);
            PG8_WAIT_L(8); PG8_BAR; PG8_WAIT_L(0); PG8_MMA(0, 0, At, B0); PG8_BAR; PG8_SCHED;
            PG8_LDB(B1, 1, 1); PG8_STAGE(PG8_SB(1, 0), b3, voffB);
            PG8_BAR; PG8_WAIT_L(0); PG8_MMA(0, 1, At, B1); PG8_BAR;
            PG8_LDA(At, 1, 1); PG8_STAGE(PG8_SA(1, 0), a3, voffA);
            PG8_BAR; PG8_WAIT_L(0); PG8_MMA(1, 0, At, B0); PG8_BAR; PG8_SCHED;
            PG8_STAGE(PG8_SB(1, 1), b3 + hstep, voffB);
            PG8_WAIT_V(6); PG8_BAR; PG8_MMA(1, 1, At, B1); PG8_BAR;
            }
        }
        if constexpr (ALIGN_EPI) { if (wr == 0) PG8_BAR; }
        if constexpr (!Epi::AFTER_DRAIN) { E(acc, cur, wr, wc, fr, fq); S.done(cur); }
        if (!has_next) break;
#pragma unroll
        for (int a = 0; a < 2; ++a)
#pragma unroll
            for (int b = 0; b < 2; ++b)
#pragma unroll
                for (int m = 0; m < 4; ++m)
#pragma unroll
                    for (int n = 0; n < 2; ++n) acc[a][b][m][n] = (f32x4){0.f, 0.f, 0.f, 0.f};
        cur = nxt; cA = nA; cB = nB; ++ui;
        if constexpr (ALIGN_EPI) { if (wr == 1) PG8_BAR; }
    }
    PG8_WAIT_V(0);
    if constexpr (!ALIGN_EPI) { if (wr == 0) PG8_BAR; }
    PG8_BAR;
    if constexpr (Epi::AFTER_DRAIN) { E.fused(acc, cur, wr, wc, fr, fq, lds, wid, lane); S.done(cur); }
#undef PG8_SA
#undef PG8_SB
#undef PG8_STAGE
#undef PG8_LDA
#undef PG8_LDB
#undef PG8_MMA
#undef PG8_WAIT_V
#undef PG8_WAIT_L
#undef PG8_BAR
#undef PG8_SCHED
}
}
namespace pg8 {
struct EpiSwiGLU {
    static constexpr bool PERM = true, AFTER_DRAIN = false;
    bf16_t* O; int ldc;
    static __device__ __forceinline__ float silu_mul(float g, float u) { const float e = __builtin_amdgcn_exp2f(-1.4426950408889634f * g); return g * __builtin_amdgcn_rcpf(1.0f + e) * u; }
    __device__ __forceinline__ void operator()(const f32x4 (&acc)[2][2][4][2], const Unit& u, int wr, int wc, int fr, int fq) const {
        const int row0 = u.pm * BM + wr * 64 + fr, col0 = u.pn * HALF + wc * 32 + 8 * fq;
#pragma unroll
        for (int ai = 0; ai < 2; ++ai)
#pragma unroll
            for (int m = 0; m < 4; ++m) { bf16_t* rowp = O + (size_t)(row0 + ai * HALF + m * 16) * ldc + col0;
                const f32x4 g0 = acc[ai][0][m][0], g1 = acc[ai][0][m][1], u0 = acc[ai][1][m][0], u1 = acc[ai][1][m][1];
                u32x4 w; w.x = cvt_pk_bf16(silu_mul(g0[0], u0[0]), silu_mul(g0[1], u0[1])); w.y = cvt_pk_bf16(silu_mul(g0[2], u0[2]), silu_mul(g0[3], u0[3]));
                w.z = cvt_pk_bf16(silu_mul(g1[0], u1[0]), silu_mul(g1[1], u1[1])); w.w = cvt_pk_bf16(silu_mul(g1[2], u1[2]), silu_mul(g1[3], u1[3]));
                *(u32x4*)rowp = w; }
    }
};
struct EpiQKV {
    static constexpr bool PERM = true, AFTER_DRAIN = false;
    bf16_t* Q; size_t buf_stride; const float* rope; float scale0;
    __device__ __forceinline__ void operator()(const f32x4 (&acc)[2][2][4][2], const Unit& u, int wr, int wc, int fr, int fq) const {
        const int t = u.pn >> 2; bf16_t* base = Q + (size_t)t * buf_stride; const float sc = (t == 0) ? scale0 : 1.f;
        const int col0 = (u.pn & 3) * BM + wc * 32 + 8 * fq;
        const bool rot = (t < 2) && ((wc & 1) == 0);
        const float sgn = (fq == 0) ? -1.f : 1.f;
#pragma unroll
        for (int ai = 0; ai < 2; ++ai)
#pragma unroll
            for (int m = 0; m < 4; ++m) { const int r = ai * HALF + wr * 64 + m * 16 + fr; int orow, pos; bool valid = true;
                if (u.pm < 64) { orow = (u.pm >> 3) * 2112 + 64 + (u.pm & 7) * 256 + r; pos = 16 + (u.pm & 7) * 256 + r; }
                else { valid = r < 128; orow = (r >> 4) * 2112 + 48 + (r & 15); pos = r & 15; }
                f32x4 cs0 = {1.f, 1.f, 1.f, 1.f}, cs1 = cs0, sn0 = {0.f, 0.f, 0.f, 0.f}, sn1 = sn0;
                if (rot && fq < 2) { const f32x4* rp = (const f32x4*)(rope + (size_t)pos * 16); cs0 = rp[0]; cs1 = rp[1]; sn0 = rp[2]; sn1 = rp[3]; }
#pragma unroll
                for (int bj = 0; bj < 2; ++bj) { f32x4 v0 = acc[ai][bj][m][0], v1 = acc[ai][bj][m][1];
                    if (rot) { f32x4 o0, o1;
#pragma unroll
                        for (int i = 0; i < 4; ++i) { o0[i] = __shfl_xor(v0[i], 16); o1[i] = __shfl_xor(v1[i], 16); }
                        v0 = v0 * cs0 + (o0 * sn0) * sgn; v1 = v1 * cs1 + (o1 * sn1) * sgn; }
                    v0 = v0 * sc; v1 = v1 * sc; u32x4 w; w.x = cvt_pk_bf16(v0[0], v0[1]); w.y = cvt_pk_bf16(v0[2], v0[3]); w.z = cvt_pk_bf16(v1[0], v1[1]); w.w = cvt_pk_bf16(v1[2], v1[3]);
                    if (valid) *(u32x4*)(base + (size_t)orow * 1024 + col0 + bj * HALF) = w; } }
    }
};
}
#include <hip/hip_bf16.h>
#include <cmath>
namespace attn_body {
using bf16=__hip_bfloat16;
using bf16x8=__attribute__((ext_vector_type(8)))short;
using s16x4=__attribute__((ext_vector_type(4)))short;
using f32x16=__attribute__((ext_vector_type(16)))float;
using u32x4=__attribute__((ext_vector_type(4)))unsigned;
constexpr int D=64,DM=1024,OPITCH=2048,BSTRIDE=2112,FRONT=48,RVEND=2112;
constexpr int NW=8,QBLK=32,QB=QBLK*NW,KVBLK=64,NQB=9;
constexpr int ATTN_PITCH=DM, ATTN_UNIT_ROWS=QB;
__device__ __forceinline__ int crow(int r,int hi){return (r&3)+8*(r>>2)+4*hi;}
#define SBAR() __builtin_amdgcn_sched_barrier(0)
__device__ __forceinline__ void cmask(f32x16&p0,f32x16&p1,int jb,int qrel,int hi){
  const float NEG=-INFINITY; int kb=64*jb+4*hi;
  #pragma unroll
  for(int r=0;r<16;++r){int kv=kb+(r&3)+8*(r>>2); if(kv>qrel)p0[r]=NEG; if(kv+32>qrel)p1[r]=NEG;}
}

constexpr int NSLOT=3, SLOTB=8192;
constexpr int LDS_K=0, LDS_V=NSLOT*SLOTB, LDS_WS=3*NSLOT*SLOTB, LDS_OST=LDS_WS+NW*64*4, LDS_BYTES=LDS_OST+NW*4096;
constexpr float C2=0.125f*1.4426950408889634f;
__device__ __forceinline__ void glds16(const void*gsrc,unsigned lds_dst){unsigned keep;
  asm volatile("s_mov_b32 %0, m0\n\ts_mov_b32 m0, %2\n\ts_nop 0\n\tglobal_load_lds_dwordx4 %1, off\n\ts_mov_b32 m0, %0":"=&s"(keep):"v"(gsrc),"s"(lds_dst):"memory");}
__device__ __forceinline__ float max3f(float a,float b,float c){float r;asm("v_max3_f32 %0, %1, %2, %3":"=v"(r):"v"(a),"v"(b),"v"(c));return r;}
__device__ __forceinline__ float max2f(float a,float b){float r;asm("v_max_f32_e32 %0, %1, %2":"=v"(r):"v"(a),"v"(b));return r;}
__device__ __forceinline__ float fadd_s(float a,float b){float r;asm("v_add_f32_e32 %0, %1, %2":"=v"(r):"v"(a),"v"(b));return r;}
__device__ __forceinline__ float fsub_s(float a,float b){float r;asm("v_sub_f32_e32 %0, %1, %2":"=v"(r):"v"(a),"v"(b));return r;}
typedef float f32x2_t __attribute__((ext_vector_type(2))); typedef __bf16 bf16x2_t __attribute__((ext_vector_type(2)));
__device__ __forceinline__ unsigned cvtpk_s(float lo,float hi){f32x2_t v={lo,hi};bf16x2_t b=__builtin_convertvector(v,bf16x2_t);return __builtin_bit_cast(unsigned,b);}
#define WAIT_BAR(N) asm volatile("s_waitcnt vmcnt(" #N ") lgkmcnt(0)\n\ts_barrier":::"memory")

__device__ __forceinline__ void qkt(f32x16&p0,f32x16&p1,const char*Kslot,const bf16x8*qr,const f32x16&negm,int r32,int hi){
  const char*kb=Kslot+hi*1024+r32*16;
  #pragma unroll
  for(int d0=0;d0<4;++d0){
    const bf16x8 b0=*reinterpret_cast<const bf16x8*>(kb+d0*2048);
    const bf16x8 b1=*reinterpret_cast<const bf16x8*>(kb+d0*2048+512);
    if(d0==0){p0=__builtin_amdgcn_mfma_f32_32x32x16_bf16(b0,qr[0],negm,0,0,0);p1=__builtin_amdgcn_mfma_f32_32x32x16_bf16(b1,qr[0],negm,0,0,0);}
    else{p0=__builtin_amdgcn_mfma_f32_32x32x16_bf16(b0,qr[d0],p0,0,0,0);p1=__builtin_amdgcn_mfma_f32_32x32x16_bf16(b1,qr[d0],p1,0,0,0);}}
}
typedef __attribute__((address_space(3))) const char* lds_cptr;
typedef short v4i16_t __attribute__((ext_vector_type(4)));
__device__ __forceinline__ void kload8(bf16x8*kf,lds_cptr kp){
  kf[0]=*(const __attribute__((address_space(3))) bf16x8*)(kp);      kf[1]=*(const __attribute__((address_space(3))) bf16x8*)(kp+512);
  kf[2]=*(const __attribute__((address_space(3))) bf16x8*)(kp+2048); kf[3]=*(const __attribute__((address_space(3))) bf16x8*)(kp+2560);
  kf[4]=*(const __attribute__((address_space(3))) bf16x8*)(kp+4096); kf[5]=*(const __attribute__((address_space(3))) bf16x8*)(kp+4608);
  kf[6]=*(const __attribute__((address_space(3))) bf16x8*)(kp+6144); kf[7]=*(const __attribute__((address_space(3))) bf16x8*)(kp+6656);
}
__device__ __forceinline__ void kload2(bf16x8*kf,lds_cptr kp,int j){ kf[2*j]=*(const __attribute__((address_space(3))) bf16x8*)(kp+j*2048); kf[2*j+1]=*(const __attribute__((address_space(3))) bf16x8*)(kp+j*2048+512); }
__device__ __forceinline__ s16x4 vtr(lds_cptr p){ return __builtin_bit_cast(s16x4,__builtin_amdgcn_ds_read_tr16_b64_v4i16((__attribute__((address_space(3))) v4i16_t*)p)); }
__device__ __forceinline__ float rowmax(const f32x16&p0,const f32x16&p1){
  float a=max3f(p0[0],p0[1],p1[0]),b=max3f(p0[2],p0[3],p1[1]);a=max3f(a,p1[2],p1[3]);
  #pragma unroll
  for(int r=4;r<16;r+=4){a=max3f(a,p0[r],p0[r+1]);b=max3f(b,p0[r+2],p0[r+3]);a=max3f(a,p1[r],p1[r+1]);b=max3f(b,p1[r+2],p1[r+3]);}
  const float m=max2f(a,b);
  auto rr=__builtin_amdgcn_permlane32_swap(__float_as_uint(m),__float_as_uint(m),false,false);
  return max2f(__uint_as_float(rr[0]),__uint_as_float(rr[1]));
}
__device__ __forceinline__ void pv(f32x16*o,int vb,bf16x8 pa0,bf16x8 pa1,bf16x8 pa2,bf16x8 pa3){
  #pragma unroll
  for(int d0=0;d0<2;++d0){s16x4 lo[4],hi[4];
    #pragma unroll
    for(int ks=0;ks<4;++ks){
      asm volatile("ds_read_b64_tr_b16 %0,%1 offset:%c2":"=&v"(lo[ks]):"v"(vb),"i"(d0*4096+ks*1024):"memory");
      asm volatile("ds_read_b64_tr_b16 %0,%1 offset:%c2":"=&v"(hi[ks]):"v"(vb),"i"(d0*4096+ks*1024+512):"memory");}
    asm volatile("s_waitcnt lgkmcnt(0)":::"memory");SBAR();
    #define PK(k) (bf16x8){lo[k][0],lo[k][1],lo[k][2],lo[k][3],hi[k][0],hi[k][1],hi[k][2],hi[k][3]}
    o[d0]=__builtin_amdgcn_mfma_f32_32x32x16_bf16(pa0,PK(0),o[d0],0,0,0);
    o[d0]=__builtin_amdgcn_mfma_f32_32x32x16_bf16(pa1,PK(1),o[d0],0,0,0);
    o[d0]=__builtin_amdgcn_mfma_f32_32x32x16_bf16(pa2,PK(2),o[d0],0,0,0);
    o[d0]=__builtin_amdgcn_mfma_f32_32x32x16_bf16(pa3,PK(3),o[d0],0,0,0);
    #undef PK
  }
}

#ifndef ATTN_STORE16
#define ATTN_STORE16(p,v) (*(u32x4*)(p)=(v))
#endif
template<int THRL,bool ODD> __device__ __forceinline__ void attn_unit(int b,int cq,int cv,int co,int q0,const bf16*Q,const bf16*__restrict__ K,const bf16*__restrict__ V,bf16*O,char*shm){
  const int tid=opaque_tid(),lane=tid&63,r32=lane&31,hi=lane>>5; const int wid=__builtin_amdgcn_readfirstlane(tid>>6);
  const long rowbase=(long)b*BSTRIDE;
  const bf16*Qw=Q+(rowbase+q0+wid*QBLK)*DM+cq;
  const bf16*Kh=K+rowbase*DM+cq,*Vh=V+rowbase*DM+cv;
  const unsigned lds0=(unsigned)(uintptr_t)shm;
  float*wsf=(float*)(shm+LDS_WS)+wid*64;
  const bf16*ksrc=Kh+(long)lane*DM+wid*8;
  const bf16*vsrc=Vh+(long)(16*(wid&3)+(lane>>2))*DM+(wid>>2)*32+(lane&3)*8;
  const unsigned kdst=lds0+LDS_K+wid*1024, vdst=lds0+LDS_V+wid*1024;
  #define DMA_K(t,slot) glds16(ksrc+(long)(t)*KVBLK*DM,(unsigned)__builtin_amdgcn_readfirstlane(kdst+(slot)))
  #define DMA_V(t,slot) do{ glds16(vsrc+(long)(t)*KVBLK*DM,(unsigned)__builtin_amdgcn_readfirstlane(vdst+2*(slot))); glds16(vsrc+(long)(t)*KVBLK*DM+64,(unsigned)__builtin_amdgcn_readfirstlane(vdst+2*(slot)+SLOTB)); }while(0)
  const int vb0=(int)(lds0+LDS_V)+((lane>>4)&1)*32+(lane&3)*8+(4*hi+((lane&15)>>2))*64;
  const char*Kbase=shm+LDS_K; bf16x8 kf[8];
  const lds_cptr shm3=(lds_cptr)shm; const lds_cptr kp0=shm3+LDS_K+hi*1024+r32*16; const lds_cptr vp0=shm3+LDS_V+((lane>>4)&1)*32+(lane&3)*8+(4*hi+((lane&15)>>2))*64;
  const int NT=(q0+QB)/KVBLK;
  DMA_K(0,0);DMA_V(0,0);DMA_K(1,SLOTB);
  bf16x8 qr[4];
  #pragma unroll
  for(int d0=0;d0<4;++d0)qr[d0]=*reinterpret_cast<const bf16x8*>(&Qw[(long)r32*DM+d0*16+hi*8]);
  float mhat=0.f,l_reg=0.f;f32x16 o[4];o[0]=f32x16{};o[1]=f32x16{};o[2]=f32x16{};o[3]=f32x16{};const f32x16 zero16=f32x16{};
  const int qrel=wid*QBLK+r32;
  #define CMASK(P0,P1,t) do{int jb_=(t)-(NT-4); if(jb_>=0)cmask(P0,P1,jb_,qrel,hi);}while(0)
  #define CM1(P0,P1,t,r) do{int jb_=(t)-(NT-4); if(jb_>=0){ const int kv_=64*jb_+4*hi+((r)&3)+8*((r)>>2); if(kv_>qrel)P0[r]=-INFINITY; if(kv_+32>qrel)P1[r]=-INFINITY; } }while(0)
  bool resc=false;
  #define START(P0,P1) do{ const float rm=rowmax(P0,P1); resc=false; \
    { const float dl=rm; mhat=fadd_s(mhat,dl); \
      _Pragma("unroll") for(int r=0;r<16;++r){P0[r]=fsub_s(P0[r],dl);P1[r]=fsub_s(P1[r],dl);} \
      } \
    _Pragma("unroll") for(int r=0;r<16;++r)P0[r]=__builtin_amdgcn_exp2f(P0[r]); }while(0)
  #define RESC() do{ if(resc){ asm volatile("s_waitcnt lgkmcnt(0)":::"memory"); \
      _Pragma("unroll") for(int d_=0;d_<4;++d_) _Pragma("unroll") for(int r=0;r<16;++r)o[d_][r]*=wsf[crow(r,hi)]; } }while(0)
  f32x16 pA0,pA1,pB0,pB1;
  int sl_prev=0,sl_cur=0,sl_next=SLOTB;
  #define ROT() do{sl_prev=sl_cur;sl_cur=sl_next;sl_next=(sl_next==(NSLOT-1)*SLOTB)?0:sl_next+SLOTB;}while(0)
  DMA_K(2,2*SLOTB);
  WAIT_BAR(3);
  qkt(pA0,pA1,Kbase,qr,zero16,r32,hi);asm volatile("s_nop 15\n\ts_nop 7":"+v"(pA0),"+v"(pA1));CMASK(pA0,pA1,0);
  if(q0+qrel>=FRONT){ _Pragma("unroll") for(int r=0;r<16;++r)pA0[r]=-INFINITY; _Pragma("unroll") for(int r=0;r<8;++r)pA1[r]=-INFINITY; }
  START(pA0,pA1);
  _Pragma("unroll") for(int r=0;r<16;++r)pA1[r]=__builtin_amdgcn_exp2f(pA1[r]);
  WAIT_BAR(0);
  DMA_K(3,0);DMA_V(1,SLOTB);
  ROT();
  kload8(kf,kp0+sl_cur);
  WAIT_BAR(3);
  s16x4 vlo[8],vhi[8]; u32x4 pw0,pw1,pw2,pw3;
  #define PKW(P,B) cvtpk_s(P[B],P[B+1])
  #define PAF(k) __builtin_bit_cast(bf16x8,pw##k)
  #define PIN(x) asm volatile("":"+v"(x))
  #define MX3(a,b,c) __builtin_fmaxf(__builtin_fmaxf((a),(b)),(c))
  #define GAPA(MF,A0,A1,A2,A3,W0,W1,PW) do{ MF; sacc+=A0; sacc+=A1; sacc+=A2; sacc+=A3; PIN(sacc); W0; W1; PIN(PW); SBAR(); }while(0)
  #define EX(v) __builtin_amdgcn_exp2f(v)
  #define GAPS(MF,X0,X1,t,R) do{ MF; X0[R]-=mhat; X0[(R)+1]-=mhat; X1[R]-=mhat; X1[(R)+1]-=mhat; CM1(X0,X1,t,R); CM1(X0,X1,t,(R)+1); mxa=MX3(mxa,X0[R],X0[(R)+1]); mxb=MX3(mxb,X1[R],X1[(R)+1]); PIN(mxa); PIN(mxb); SBAR(); }while(0)
  #define GAPB(MF,X,B) do{ MF; X[B]=EX(X[B]); X[B+1]=EX(X[B+1]); X[B+2]=EX(X[B+2]); X[B+3]=EX(X[B+3]); PIN(X); SBAR(); }while(0)
  #define VRD(i,hf) do{ vlo[(i)&7]=vtr(vp_+((hf)*8192+((i)>>2)*4096+((i)&3)*1024)); vhi[(i)&7]=vtr(vp_+((hf)*8192+((i)>>2)*4096+((i)&3)*1024+512)); }while(0)
  #define KRD(G,j) do{ if(G){ kload2(kf,kp0+sl_next,j); SBAR(); } }while(0)
  #define VF4(i) (bf16x8){vlo[i][0],vlo[i][1],vlo[i][2],vlo[i][3],vhi[i][0],vhi[i][1],vhi[i][2],vhi[i][3]}
  #define STEP(C0,C1,P0,P1,t,GK,GV,GL) do{ SBAR(); \
      \
    if(GV){DMA_V((t)+1,sl_next);} if(GK){DMA_K((t)+3,sl_cur);} \
    const lds_cptr vp_=vp0+2*sl_prev; \
    float sacc=(P0[0]+P0[1]); \
    GAPA(C0=__builtin_amdgcn_mfma_f32_32x32x16_bf16(kf[0],qr[0],zero16,0,0,0), P0[2],P0[3],P0[4],P0[5],     pw0[0]=PKW(P0,0), pw0[1]=PKW(P0,2), pw0); \
    GAPA(C1=__builtin_amdgcn_mfma_f32_32x32x16_bf16(kf[1],qr[0],zero16,0,0,0), P0[6],P0[7],P0[8],P0[9],     pw0[2]=PKW(P0,4), pw0[3]=PKW(P0,6), pw0); \
    GAPA(C0=__builtin_amdgcn_mfma_f32_32x32x16_bf16(kf[2],qr[1],C0,0,0,0),   P0[10],P0[11],P0[12],P0[13], pw1[0]=PKW(P0,8), pw1[1]=PKW(P0,10), pw1); \
    GAPA(C1=__builtin_amdgcn_mfma_f32_32x32x16_bf16(kf[3],qr[1],C1,0,0,0),   P0[14],P0[15],P1[0],P1[1],   pw1[2]=PKW(P0,12),pw1[3]=PKW(P0,14), pw1); \
    GAPA(C0=__builtin_amdgcn_mfma_f32_32x32x16_bf16(kf[4],qr[2],C0,0,0,0),   P1[2],P1[3],P1[4],P1[5],     pw2[0]=PKW(P1,0), pw2[1]=PKW(P1,2), pw2); \
    GAPA(C1=__builtin_amdgcn_mfma_f32_32x32x16_bf16(kf[5],qr[2],C1,0,0,0),   P1[6],P1[7],P1[8],P1[9],     pw2[2]=PKW(P1,4), pw2[3]=PKW(P1,6), pw2); \
    GAPA(C0=__builtin_amdgcn_mfma_f32_32x32x16_bf16(kf[6],qr[3],C0,0,0,0),   P1[10],P1[11],P1[12],P1[13], pw3[0]=PKW(P1,8), pw3[1]=PKW(P1,10), pw3); \
    VRD(0,0); VRD(1,0); VRD(2,0); VRD(3,0); SBAR(); \
    GAPA(C1=__builtin_amdgcn_mfma_f32_32x32x16_bf16(kf[7],qr[3],C1,0,0,0),   P1[14],P1[15],0.f,0.f,       pw3[2]=PKW(P1,12),pw3[3]=PKW(P1,14), pw3); \
    l_reg+=sacc; \
      \
      \
    VRD(4,0); VRD(5,0); VRD(6,0); VRD(7,0); SBAR(); \
    float mxa=-INFINITY,mxb=-INFINITY; \
    GAPS(o[0]=__builtin_amdgcn_mfma_f32_32x32x16_bf16(PAF(0),VF4(0),o[0],0,0,0), C0,C1,t,0); \
    GAPS(o[0]=__builtin_amdgcn_mfma_f32_32x32x16_bf16(PAF(1),VF4(1),o[0],0,0,0), C0,C1,t,2); \
    GAPS(o[0]=__builtin_amdgcn_mfma_f32_32x32x16_bf16(PAF(2),VF4(2),o[0],0,0,0), C0,C1,t,4); \
    GAPS(o[0]=__builtin_amdgcn_mfma_f32_32x32x16_bf16(PAF(3),VF4(3),o[0],0,0,0), C0,C1,t,6); \
    VRD(0,1); VRD(1,1); VRD(2,1); VRD(3,1); KRD(GL,0); SBAR(); \
    GAPS(o[1]=__builtin_amdgcn_mfma_f32_32x32x16_bf16(PAF(0),VF4(4),o[1],0,0,0), C0,C1,t,8); \
    GAPS(o[1]=__builtin_amdgcn_mfma_f32_32x32x16_bf16(PAF(1),VF4(5),o[1],0,0,0), C0,C1,t,10); \
    GAPS(o[1]=__builtin_amdgcn_mfma_f32_32x32x16_bf16(PAF(2),VF4(6),o[1],0,0,0), C0,C1,t,12); \
    GAPS(o[1]=__builtin_amdgcn_mfma_f32_32x32x16_bf16(PAF(3),VF4(7),o[1],0,0,0), C0,C1,t,14); \
    { float rm=__builtin_fmaxf(mxa,mxb); { auto rr=__builtin_amdgcn_permlane32_swap(__float_as_uint(rm),__float_as_uint(rm),false,false); rm=__builtin_fmaxf(__uint_as_float(rr[0]),__uint_as_float(rr[1])); } \
      resc=false; \
      if(__builtin_expect(__any(rm>(float)THRL),0)){ const float dl=__builtin_fmaxf(rm,0.f); mhat+=dl; \
        _Pragma("unroll") for(int r=0;r<16;++r){C0[r]-=dl;C1[r]-=dl;} \
        const float f=__builtin_amdgcn_exp2f(-dl); l_reg*=f; if(hi==0)wsf[r32]=f; resc=true; } } \
    SBAR(); \
    VRD(4,1); VRD(5,1); VRD(6,1); VRD(7,1); KRD(GL,1); SBAR(); \
    GAPB(o[2]=__builtin_amdgcn_mfma_f32_32x32x16_bf16(PAF(0),VF4(0),o[2],0,0,0), C0,0); \
    GAPB(o[2]=__builtin_amdgcn_mfma_f32_32x32x16_bf16(PAF(1),VF4(1),o[2],0,0,0), C0,4); \
    GAPB(o[2]=__builtin_amdgcn_mfma_f32_32x32x16_bf16(PAF(2),VF4(2),o[2],0,0,0), C0,8); \
    GAPB(o[2]=__builtin_amdgcn_mfma_f32_32x32x16_bf16(PAF(3),VF4(3),o[2],0,0,0), C0,12); \
    KRD(GL,2); \
    GAPB(o[3]=__builtin_amdgcn_mfma_f32_32x32x16_bf16(PAF(0),VF4(4),o[3],0,0,0), C1,0); \
    GAPB(o[3]=__builtin_amdgcn_mfma_f32_32x32x16_bf16(PAF(1),VF4(5),o[3],0,0,0), C1,4); \
    KRD(GL,3); \
    GAPB(o[3]=__builtin_amdgcn_mfma_f32_32x32x16_bf16(PAF(2),VF4(6),o[3],0,0,0), C1,8); \
    GAPB(o[3]=__builtin_amdgcn_mfma_f32_32x32x16_bf16(PAF(3),VF4(7),o[3],0,0,0), C1,12); \
    }while(0)
  int t=1;
  #undef CMASK
  #define CMASK(P0,P1,t) do{}while(0)
  #undef CM1
  #define CM1(P0,P1,t,r) do{}while(0)
  for(;t+5<NT;t+=2){
    STEP(pB0,pB1,pA0,pA1,t,true,true,true);     WAIT_BAR(3); RESC(); ROT();
    STEP(pA0,pA1,pB0,pB1,t+1,true,true,true);   WAIT_BAR(3); RESC(); ROT();
  }
  #undef CMASK
  #define CMASK(P0,P1,t) do{int jb_=(t)-(NT-4); if(jb_>=0)cmask(P0,P1,jb_,qrel,hi);}while(0)
  #undef CM1
  #define CM1(P0,P1,t,r) do{int jb_=(t)-(NT-4); if(jb_>=0){ const int kv_=64*jb_+4*hi+((r)&3)+8*((r)>>2); if(kv_>qrel)P0[r]=-INFINITY; if(kv_+32>qrel)P1[r]=-INFINITY; } }while(0)
  #define ENDW(tt) do{ if((tt)+3<NT){WAIT_BAR(3);} else if((tt)+2<NT){WAIT_BAR(2);} else {WAIT_BAR(0);} }while(0)
  for(;t+1<NT;t+=2){
    STEP(pB0,pB1,pA0,pA1,t,(t+3<NT),(t+1<NT),(t+1<NT));       ENDW(t);   RESC(); ROT();
    STEP(pA0,pA1,pB0,pB1,t+1,(t+4<NT),(t+2<NT),(t+2<NT));     ENDW(t+1); RESC(); ROT();
  }
  #define DRAIN(Q0,Q1,SL) do{ float sacc=Q0[0]+Q0[1]; _Pragma("unroll") for(int r=2;r<16;++r)sacc+=Q0[r]; _Pragma("unroll") for(int r=0;r<16;++r)sacc+=Q1[r]; l_reg+=sacc; \
    pw0=(u32x4){PKW(Q0,0),PKW(Q0,2),PKW(Q0,4),PKW(Q0,6)};pw1=(u32x4){PKW(Q0,8),PKW(Q0,10),PKW(Q0,12),PKW(Q0,14)};pw2=(u32x4){PKW(Q1,0),PKW(Q1,2),PKW(Q1,4),PKW(Q1,6)};pw3=(u32x4){PKW(Q1,8),PKW(Q1,10),PKW(Q1,12),PKW(Q1,14)}; \
    SBAR(); pv(o,vb0+2*(SL),PAF(0),PAF(1),PAF(2),PAF(3)); pv(o+2,vb0+2*(SL)+SLOTB,PAF(0),PAF(1),PAF(2),PAF(3)); }while(0)
  if constexpr(ODD){ DRAIN(pA0,pA1,sl_prev); }
  else{ STEP(pB0,pB1,pA0,pA1,NT-1,false,false,false); RESC(); DRAIN(pB0,pB1,sl_cur); }
  #undef DRAIN
  #undef PKW
  #undef PAF
  #undef VF4
  #undef PIN
  #undef MX3
  #undef GAPA
  #undef GAPB
  #undef GAPS
  #undef EX
  #undef VRD
  #undef KRD
  #undef STEP
  #undef ENDW
  {auto rr=__builtin_amdgcn_permlane32_swap(__float_as_uint(l_reg),__float_as_uint(l_reg),false,false);l_reg=__uint_as_float(rr[0])+__uint_as_float(rr[1]);}
  if(hi==0)wsf[32+r32]=l_reg;asm volatile("s_waitcnt lgkmcnt(0)":::"memory");
  float rli[16];
  #pragma unroll
  for(int r=0;r<16;++r)rli[r]=__builtin_amdgcn_rcpf(wsf[32+crow(r,hi)]);
  bf16*Ow=O+co;
  { bf16*stg=(bf16*)(shm+LDS_OST)+wid*2048;
    #pragma unroll
    for(int hf=0;hf<2;++hf){
    #pragma unroll
    for(int r=0;r<16;++r){const int orow=crow(r,hi);
      #pragma unroll
      for(int d0=0;d0<2;++d0)stg[orow*64+d0*32+r32]=__float2bfloat16(o[2*hf+d0][r]*rli[r]);}
    asm volatile("s_waitcnt lgkmcnt(0)":::"memory");
    #pragma unroll
    for(int i=0;i<4;++i){const int row=i*8+(lane>>3),ch=lane&7; const u32x4 v=*(const u32x4*)(stg+row*64+ch*8); const int rel=q0+wid*QBLK+row; const long m=(rel>=64)?(long)b*2048+(rel-64):16384L+16*b+(rel-FRONT); if(rel>=FRONT&&rel<RVEND&&(q0!=0||rel<64))ATTN_STORE16(Ow+m*DM+hf*64+ch*8,v);}
    asm volatile("s_waitcnt lgkmcnt(0)":::"memory"); } }
  asm volatile("s_waitcnt lgkmcnt(0)\n\ts_barrier":::"memory");
  #undef DMA_K
  #undef DMA_V
  #undef CMASK
  #undef CM1
  #undef START
  #undef RESC
  #undef ROT
}
constexpr int ATTN_LDS_BYTES=LDS_BYTES;
struct AttnTensors { const bf16* Q; const bf16* K; const bf16* V; bf16* O; bf16* O1; };
template<int THRL=8> __device__ __forceinline__ void attn_phase(char*lds,const AttnTensors&T,int vcu,int G){
  for(int w=vcu;w<256;w+=G){ const int item=w>>1,half=w&1,b=item>>4,hc=item&15,h=hc>>1,c=hc&1;
    const int n=half?4:5;
    for(int i=0;i<n;++i){ const int j=half?((i==0)?6:(i==1)?5:(i==2)?3:1):((i==0)?7:(i==1)?4:(i==2)?2:(i==3)?0:-1);
      if(j<0) attn_unit<THRL,false>(b,(2*h+c)*64,h*128,h*128,0,T.Q,T.K,T.V,c?T.O1:T.O,lds);
      else attn_unit<THRL,true>(b,(2*h+c)*64,h*128,h*128,64+256*j,T.Q,T.K,T.V,c?T.O1:T.O,lds); } }
}
#undef SBAR
#undef WAIT_BAR
}
#include <hip/hip_cooperative_groups.h>
namespace cg = cooperative_groups;
constexpr int NWAVES = 8;
constexpr int DM_ = 1024, DFF = 2816, NGU = 2 * DFF, NB = 8, SEQL = 2048, NMETA = 16, DEPTH_ = 4;
constexpr int MREAL = NB * SEQL;
constexpr int MVALID = MREAL + NB * NMETA;
constexpr int MPAD = 16640;
constexpr int QROWS = NB * 2112 + 256;
constexpr size_t MiB = 1u << 20;
constexpr size_t WS_ROPE = 1 * MiB;
constexpr size_t WS_HMETA = 1 * MiB + 512 * 1024;
constexpr size_t WS_W = 2 * MiB;
constexpr size_t W_GU_E = (size_t)NGU * DM_, W_DN_E = (size_t)DM_ * DFF, W_FFN_E = W_GU_E + W_DN_E;
constexpr size_t W_IN_E = (size_t)3 * DM_ * DM_, W_OUT_E = (size_t)DM_ * DM_, W_MIX_E = W_IN_E + W_OUT_E;
constexpr size_t W_TOTAL_E = 8 * W_FFN_E + 4 * W_MIX_E;
constexpr size_t WS_XN = 168 * MiB;
constexpr size_t WS_F = 201 * MiB;
constexpr size_t WS_BIG = 236 * MiB;
constexpr size_t WS_END = 338 * MiB;
static_assert(WS_W + W_TOTAL_E * 2 <= WS_XN && WS_XN + (size_t)MPAD * 1024 * 2 <= WS_F && WS_F + (size_t)MPAD * 1024 * 2 <= WS_BIG, "ws map");
static_assert(WS_XN + (size_t)QROWS * 2048 * 2 <= WS_BIG && WS_BIG + (size_t)MPAD * 3072 * 2 <= WS_END && WS_BIG + (size_t)3 * QROWS * 1024 * 2 <= WS_END, "ws map 2");
constexpr int RING_BYTES = 131072, LDS_BYTES = 147456;

#define GAS __attribute__((address_space(1)))
#define LAS __attribute__((address_space(3)))
typedef unsigned short bf16;
typedef unsigned v4u __attribute__((ext_vector_type(4)));
typedef float f32x4 __attribute__((ext_vector_type(4)));
#define LDS_WAIT() asm volatile("s_waitcnt lgkmcnt(0)" ::: "memory")
__device__ __forceinline__ unsigned f2bf(float f) { unsigned u = __builtin_bit_cast(unsigned, f); return (u + 0x7fffu + ((u >> 16) & 1u)) >> 16; }
__device__ __forceinline__ unsigned pk2(float lo, float hi) { typedef float f32x2p __attribute__((ext_vector_type(2))); typedef __bf16 bf16x2p __attribute__((ext_vector_type(2))); f32x2p v = {lo, hi}; bf16x2p b = __builtin_convertvector(v, bf16x2p); return __builtin_bit_cast(unsigned, b); }
__device__ __forceinline__ float bflo(unsigned w) { return __builtin_bit_cast(float, w << 16); }
__device__ __forceinline__ float bfhi(unsigned w) { return __builtin_bit_cast(float, w & 0xffff0000u); }
__device__ __forceinline__ float wave_sum(float v) {
#pragma unroll
    for (int o = 1; o < 64; o <<= 1) v += __shfl_xor(v, o);
    return v;
}
#define RLX_AGENT __ATOMIC_RELAXED, __HIP_MEMORY_SCOPE_AGENT
#define XB_TMO      128
#define XB_XCNT(j)  (256  + 64 * (j))
#define XB_XSUB(j)  (1280 + 64 * (j))
#define XB_XGEN(j)  (2304 + 64 * (j))
#define XB_TOP      3328
#define XB_TOPGEN   3392
#define XCD_BAR_WORDS 3456
#define XB_SPIN_CAP (1u << 18)

__device__ __forceinline__ unsigned xb_ld(unsigned* p)              { return __hip_atomic_load(p, __ATOMIC_RELAXED, __HIP_MEMORY_SCOPE_AGENT); }
__device__ __forceinline__ unsigned xb_add(unsigned* p, unsigned v) { return __hip_atomic_fetch_add(p, v, __ATOMIC_RELAXED, __HIP_MEMORY_SCOPE_AGENT); }
__device__ __forceinline__ unsigned xb_xcc_id() { return (unsigned)__builtin_amdgcn_s_getreg((3 << 11) | 20) & 0xFu; }
#define XB_SPIN(cond, bar) do { unsigned _sp = 0; while (cond) { __builtin_amdgcn_s_sleep(1); \
    if ((++_sp & 255u) == 0u) { if (xb_ld(&(bar)[XB_TMO])) break; if (_sp > XB_SPIN_CAP) { atomicAdd(&(bar)[XB_TMO], 1u); break; } } } } while (0)

struct XcdBarrier {
    unsigned* bar; unsigned x;
    volatile LAS unsigned* st;
};

__device__ __forceinline__ XcdBarrier xcd_barrier_post(unsigned* bar, volatile LAS unsigned* st) {
    XcdBarrier b; b.bar = bar; b.x = xb_xcc_id(); b.st = st;
    if (threadIdx.x == 0) (void)xb_add(&bar[XB_XCNT(b.x)], 1u);
    return b;
}
__device__ __forceinline__ void xcd_barrier_complete(unsigned* bar, unsigned x, unsigned& nloc, unsigned& nx) {
    const unsigned G = gridDim.x * gridDim.y * gridDim.z;
    unsigned sum, cnt, mine, sp = 0u;
    for (;;) {
        sum = 0u; cnt = 0u; mine = 0u;
#pragma unroll
        for (unsigned j = 0; j < 16; ++j) { const unsigned c = xb_ld(&bar[XB_XCNT(j)]); sum += c; cnt += (c > 0u) ? 1u : 0u; mine = (j == x) ? c : mine; }
        if (sum == G) break;
        __builtin_amdgcn_s_sleep(1);
        if ((++sp & 255u) == 0u) { if (xb_ld(&bar[XB_TMO])) break; if (sp > XB_SPIN_CAP) { atomicAdd(&bar[XB_TMO], 1u); break; } }
    }
    nloc = mine > 0u ? mine : 1u; nx = cnt > 0u ? cnt : 1u;
}

template <bool LOCAL> __device__ __forceinline__ void xcd_barrier(const XcdBarrier& b) {
    asm volatile("s_waitcnt vmcnt(0)" ::: "memory");
    __syncthreads();
    if (threadIdx.x == 0) {
        unsigned* bar = b.bar;
        __builtin_amdgcn_s_waitcnt(0);
        unsigned nloc = b.st[0], nx = b.st[1];
        if (nloc == 0u) { xcd_barrier_complete(bar, b.x, nloc, nx); b.st[0] = nloc; b.st[1] = nx; }
        const unsigned old = xb_add(&bar[XB_XSUB(b.x)], 1u);
        const unsigned gen = old / nloc;
        if (old + 1u == (gen + 1u) * nloc) {
            __builtin_amdgcn_fence(__ATOMIC_RELEASE, "agent");
            asm volatile("s_waitcnt vmcnt(0)" ::: "memory");
            if (!LOCAL) {
            const unsigned og = xb_add(&bar[XB_TOP], 1u);
            const unsigned tg = og / nx;
            if (og + 1u == (tg + 1u) * nx) xb_add(&bar[XB_TOPGEN], 1u);
            else XB_SPIN(xb_ld(&bar[XB_TOPGEN]) == tg, bar);
            }
            __builtin_amdgcn_fence(__ATOMIC_ACQUIRE, "agent");
            xb_add(&bar[XB_XGEN(b.x)], 1u);
            asm volatile("s_waitcnt vmcnt(0)" ::: "memory");
        } else {
            XB_SPIN(xb_ld(&bar[XB_XGEN(b.x)]) == gen, bar);
            __builtin_amdgcn_fence(__ATOMIC_ACQUIRE, "agent");
            asm volatile("s_waitcnt vmcnt(0)" ::: "memory");
        }
    }
    __syncthreads();
}

struct Args { const float* in[16]; float* out; unsigned char* ws; };
__device__ __forceinline__ const float* in_ptr(int i) { const char __attribute__((address_space(4)))* ka = (const char __attribute__((address_space(4)))*)__builtin_amdgcn_kernarg_segment_ptr(); int off = i * 8; asm volatile("" : "+s"(off)); return *(const float* const __attribute__((address_space(4)))*)(ka + off); }
__device__ __forceinline__ float* out_ptr() { return (float*)in_ptr(16); }
__device__ __forceinline__ unsigned char* ws_ptr() { return (unsigned char*)in_ptr(17); }

__device__ __forceinline__ void p0_transpose_item(const float* W, int K, int N, bf16* WT, int k0, int n0, int drow0, LAS float* scr, int lane) {
#pragma unroll 8
    for (int i = 0; i < 32; ++i) { const int kk = 2 * i + (lane >> 5); scr[kk * 33 + (lane & 31)] = __builtin_nontemporal_load(&W[(size_t)(k0 + kk) * N + n0 + (lane & 31)]); }
    LDS_WAIT(); asm volatile("" ::: "memory");
    const int c = lane & 7;
#pragma unroll
    for (int j = 0; j < 4; ++j) { const int n = (lane >> 3) + 8 * j; const LAS float* s = scr + (8 * c) * 33 + n;
        v4u o; o.x = pk2(s[0 * 33], s[1 * 33]); o.y = pk2(s[2 * 33], s[3 * 33]); o.z = pk2(s[4 * 33], s[5 * 33]); o.w = pk2(s[6 * 33], s[7 * 33]);
        *(GAS v4u*)(WT + (size_t)(drow0 + n) * K + k0 + 8 * c) = o; }
    LDS_WAIT(); asm volatile("" ::: "memory");
}
__device__ __forceinline__ float* hrow_ptr(float* out, float* hmeta, int m) { return m < MREAL ? out + (size_t)m * DM_ : hmeta + (size_t)(m - MREAL) * DM_; }
__device__ __forceinline__ int qkv_row(int m) { return m < MREAL ? (m >> 11) * 2112 + 64 + (m & 2047) : ((m - MREAL) >> 4) * 2112 + 48 + ((m - MREAL) & 15); }
__device__ __forceinline__ int prev_row(int m, int k) {
    if (m < MREAL) { const int t = m & 2047, b = m >> 11; return (t >= k) ? m - k : MREAL + b * 16 + (16 + t - k); }
    const int i = (m - MREAL) & 15; return (i >= k) ? m - k : -1;
}


typedef short tg_bf16x8 __attribute__((ext_vector_type(8)));
template <int MODE, int KW  , int TR  , int TC  >
__device__ __forceinline__ void tail_gemm(LAS unsigned char* lds, const bf16* A, const bf16* Bt, int N, bf16* O, int ldc, const float* rope, float scale0, size_t buf_stride, int cu, int ncu) {
    constexpr int K = KW * 8, NS = KW / 32, NCP = 16 * TC, NRW = 16 * TR, NCO = (MODE == 1) ? NCP / 2 : NCP, NRB = 128 / NRW, WSZ = NRW * NCP;
    const int tid = opaque_tid(), lane = tid & 63, wid = __builtin_amdgcn_readfirstlane(tid >> 6), fr = lane & 15, fq = lane >> 4;
    const int ncolt = ((MODE == 1) ? N / 2 : N) / NCO, ntiles = NRB * ncolt;
    LAS float* red = (LAS float*)lds;
    if (cu < 0) return;
    for (int tile = cu; tile < ntiles; tile += ncu) {
        const int rb = tile % NRB, ct = tile / NRB;
        tg_bf16x8 fa[TR][NS], fb[TC][NS];
#pragma unroll
        for (int ci = 0; ci < TC; ++ci) { int brow;
            if (MODE == 1) { const int oc = ct * NCO, base = 256 * (oc >> 7) + (oc & 127); brow = (ci < TC / 2) ? base + 16 * ci : base + 128 + 16 * (ci - TC / 2); } else brow = ct * NCP + 16 * ci;
            const bf16* bp = Bt + (size_t)(brow + fr) * K + wid * KW + 8 * fq;
#pragma unroll
            for (int i = 0; i < NS; ++i) fb[ci][i] = *(const tg_bf16x8*)(bp + i * 32); }
#pragma unroll
        for (int ri = 0; ri < TR; ++ri) { const bf16* ap = A + (size_t)(rb * NRW + ri * 16 + fr) * K + wid * KW + 8 * fq;
#pragma unroll
            for (int i = 0; i < NS; ++i) fa[ri][i] = *(const tg_bf16x8*)(ap + i * 32); }
        f32x4 c[TR][TC];
#pragma unroll
        for (int ri = 0; ri < TR; ++ri)
#pragma unroll
            for (int ci = 0; ci < TC; ++ci) c[ri][ci] = (f32x4){0.f, 0.f, 0.f, 0.f};
#pragma unroll
        for (int i = 0; i < NS; ++i)
#pragma unroll
            for (int ri = 0; ri < TR; ++ri)
#pragma unroll
                for (int ci = 0; ci < TC; ++ci) c[ri][ci] = __builtin_amdgcn_mfma_f32_16x16x32_bf16(fb[ci][i], fa[ri][i], c[ri][ci], 0, 0, 0);
        LAS float* rw = red + wid * WSZ;
#pragma unroll
        for (int ri = 0; ri < TR; ++ri)
#pragma unroll
            for (int ci = 0; ci < TC; ++ci) *(LAS f32x4*)(rw + (ri * 16 + fr) * NCP + ci * 16 + 4 * fq) = c[ri][ci];
        __syncthreads();
#define TG_RED(rr_, cc_) (((red[0 * WSZ + (rr_) * NCP + (cc_)] + red[1 * WSZ + (rr_) * NCP + (cc_)]) + (red[2 * WSZ + (rr_) * NCP + (cc_)] + red[3 * WSZ + (rr_) * NCP + (cc_)])) + ((red[4 * WSZ + (rr_) * NCP + (cc_)] + red[5 * WSZ + (rr_) * NCP + (cc_)]) + (red[6 * WSZ + (rr_) * NCP + (cc_)] + red[7 * WSZ + (rr_) * NCP + (cc_)])))
#pragma unroll
        for (int e = tid; e < NRW * NCO; e += NWAVES * 64) { const int row = e / NCO, cc = e % NCO, r = rb * NRW + row;
            if (MODE == 0) { O[(size_t)(MREAL + r) * ldc + ct * NCO + cc] = (bf16)f2bf(TG_RED(row, cc)); }
            else if (MODE == 1) { const float g = TG_RED(row, cc), u = TG_RED(row, NCO + cc); O[(size_t)(MREAL + r) * ldc + ct * NCO + cc] = (bf16)f2bf(pg8::EpiSwiGLU::silu_mul(g, u)); }
            else { const int gcol = ct * NCO + cc, t = gcol >> 10, d = gcol & 63; float v0 = TG_RED(row, cc);
                const int orow = (r >> 4) * 2112 + 48 + (r & 15), pos = r & 15;
                if (t < 2 && d < 16) { const int pc = cc + ((gcol ^ 8) - gcol); const float o0 = TG_RED(row, pc); const int j = d & 7; const float sgn = (d < 8) ? -1.f : 1.f;
                    v0 = v0 * rope[pos * 16 + j] + sgn * o0 * rope[pos * 16 + 8 + j]; }
                if (t == 0) v0 *= scale0;
                O[(size_t)t * buf_stride + (size_t)orow * 1024 + (gcol & 1023)] = (bf16)f2bf(v0); } }
#undef TG_RED
        __syncthreads();
    }
}

__device__ __forceinline__ int batch_row(int b, int i) { return i < SEQL ? b * SEQL + i : MREAL + b * NMETA + ((i - SEQL) >> 4); }
__global__ void __launch_bounds__(NWAVES * 64, 2) trunk_fwd(Args args) {
    extern __shared__ __attribute__((aligned(16))) unsigned char lds[];
    cg::grid_group grid = cg::this_grid();
    const int tid = threadIdx.x, lane = tid & 63, wave = __builtin_amdgcn_readfirstlane(tid >> 6);
    const int G = gridDim.x; const int bx = blockIdx.x; const int vcu = (G % 8 == 0) ? (bx % 8) * (G / 8) + bx / 8 : bx;
    const int gw = vcu * NWAVES + wave, NGW = G * NWAVES;
    LAS unsigned char* ldsl = (LAS unsigned char*)lds;
#define WSB(off) (ws_ptr() + (off))
#define P_HMETA ((float*)WSB(WS_HMETA))
#define P_ROPE ((float*)WSB(WS_ROPE))
#define P_WB ((bf16*)WSB(WS_W))
#define P_XN ((bf16*)WSB(WS_XN))
#define P_FB ((bf16*)WSB(WS_F))
#define P_BIG ((bf16*)WSB(WS_BIG))
    for (int u = tid; u < (LDS_BYTES - RING_BYTES) / 4; u += NWAVES * 64) ((LAS unsigned*)(ldsl + RING_BYTES))[u] = 0u;
    __syncthreads();
    XcdBarrier xbar = xcd_barrier_post((unsigned*)ws_ptr(), (volatile LAS unsigned*)(ldsl + RING_BYTES + 352));
#define GSYNC() xcd_barrier<false>(xbar)
#define LSYNC() xcd_barrier<true>(xbar)
#define GSYNC_CG() do { asm volatile("s_waitcnt vmcnt(0) lgkmcnt(0)" ::: "memory"); __builtin_amdgcn_fence(__ATOMIC_RELEASE, "agent"); grid.sync(); __builtin_amdgcn_fence(__ATOMIC_ACQUIRE, "agent"); } while (0)

    if (tid == 0) ((unsigned*)(ws_ptr() + 32768))[bx] = xbar.x + 1u;
    {
        LAS float* scr = (LAS float*)(ldsl + wave * 16384); bf16* const Wb0 = P_WB;
        constexpr int I_GU = (DM_ / 64) * (NGU / 32), I_DN = (DFF / 64) * (DM_ / 32), I_FFN = I_GU + I_DN;
        constexpr int I_IN = (DM_ / 64) * (3 * DM_ / 32), I_OUT = (DM_ / 64) * (DM_ / 32), I_MIX = I_IN + I_OUT;
        constexpr int NITEMS = 8 * I_FFN + 4 * I_MIX;
        for (int it = gw; it < NITEMS; it += NGW) {
            if (it < 8 * I_FFN) { const int fi = it / I_FFN, r = it % I_FFN, l = fi >> 1, which = fi & 1; bf16* dst = Wb0 + (size_t)fi * W_FFN_E;
                if (r < I_GU) { const float* W = (which ? in_ptr(14) : in_ptr(3)) + (size_t)l * DM_ * NGU; const int nblk = NGU / 32, kb = r / nblk, nb = r % nblk, n0 = 32 * nb;
                    const int half = n0 / DFF, within = n0 % DFF, drow0 = 256 * (within / 128) + 128 * half + (within % 128);
                    p0_transpose_item(W, DM_, NGU, dst, 64 * kb, n0, drow0, scr, lane); }
                else { const int r2 = r - I_GU; const float* W = (which ? in_ptr(15) : in_ptr(4)) + (size_t)l * DFF * DM_; const int nblk = DM_ / 32, kb = r2 / nblk, nb = r2 % nblk;
                    p0_transpose_item(W, DFF, DM_, dst + W_GU_E, 64 * kb, 32 * nb, 32 * nb, scr, lane); }
            } else { const int it2 = it - 8 * I_FFN, l = it2 / I_MIX, r = it2 % I_MIX, j = l >> 1, isattn = l & 1; bf16* dst = Wb0 + 8 * W_FFN_E + (size_t)l * W_MIX_E;
                if (r < I_IN) { const float* W = (isattn ? in_ptr(9) : in_ptr(6)) + (size_t)j * DM_ * 3 * DM_; const int nblk = 3 * DM_ / 32, kb = r / nblk, nb = r % nblk;
                    p0_transpose_item(W, DM_, 3 * DM_, dst, 64 * kb, 32 * nb, 32 * nb, scr, lane); }
                else { const int r2 = r - I_IN; const float* W = (isattn ? in_ptr(12) : in_ptr(8)) + (size_t)j * DM_ * DM_; const int nblk = DM_ / 32, kb = r2 / nblk, nb = r2 % nblk;
                    p0_transpose_item(W, DM_, DM_, dst + W_IN_E, 64 * kb, 32 * nb, 32 * nb, scr, lane); }
            }
        }
        float* const rope0 = P_ROPE;
        for (int e = gw * 64 + lane; e < 2064 * 8; e += NGW * 64) { const int pos = e >> 3, j = e & 7;
            const float inv = (float)exp2(-(double)j * (18.931568569324174 / 8.0));
            const float ang = (float)pos * inv; const double rev = (double)ang * 0.15915494309189535; const float fr = (float)(rev - floor(rev));
            rope0[pos * 16 + j] = __builtin_amdgcn_cosf(fr); rope0[pos * 16 + 8 + j] = __builtin_amdgcn_sinf(fr); }
        { const v4u z = {0u, 0u, 0u, 0u}; bf16* const xn0 = P_XN; bf16* const big0 = P_BIG;
          for (int e = gw * 64 + lane; e < (MPAD - MVALID) * 128; e += NGW * 64) *(v4u*)(xn0 + (size_t)MVALID * 1024 + (size_t)e * 8) = z;
          for (int e = gw * 64 + lane; e < 3 * (8 * 48 + 256) * 128; e += NGW * 64) { const int bufi = e / ((8 * 48 + 256) * 128), r = (e / 128) % (8 * 48 + 256), c = e % 128;
              const int row = r < 384 ? (r / 48) * 2112 + (r % 48) : 8 * 2112 + (r - 384);
              *(v4u*)(big0 + (size_t)bufi * QROWS * 1024 + (size_t)row * 1024 + c * 8) = z; } }
    }
    { float* const hp_out = out_ptr(); float* const hp_meta = P_HMETA; const float* const xin = in_ptr(0); const float* const min_ = in_ptr(1); const float* const g = in_ptr(2); bf16* const xn0 = P_XN;
    for (int m = gw; m < MVALID; m += NGW) {
        const float* src = m < MREAL ? xin + (size_t)m * DM_ : min_ + (size_t)((m - MREAL) & 15) * DM_;
        float* hr = hrow_ptr(hp_out, hp_meta, m);
        f32x4 v[4]; float s = 0.f;
#pragma unroll
        for (int q = 0; q < 4; ++q) { v[q] = *(const f32x4*)(src + (q >> 1) * 512 + lane * 8 + (q & 1) * 4); s += (v[q][0] * v[q][0] + v[q][1] * v[q][1]) + (v[q][2] * v[q][2] + v[q][3] * v[q][3]); }
        const float r2 = 1.0f / sqrtf(wave_sum(s) * (1.f / DM_) + 1e-6f);
        if (m >= MREAL) {
#pragma unroll
        for (int q = 0; q < 4; ++q) *(f32x4*)(hr + (q >> 1) * 512 + lane * 8 + (q & 1) * 4) = v[q]; }
#pragma unroll
        for (int hh = 0; hh < 2; ++hh) { const f32x4 g0 = *(const f32x4*)(g + hh * 512 + lane * 8), g1 = *(const f32x4*)(g + hh * 512 + lane * 8 + 4); const f32x4 a = v[2 * hh] * r2 * g0, b = v[2 * hh + 1] * r2 * g1;
            v4u o; o.x = pk2(a[0], a[1]); o.y = pk2(a[2], a[3]); o.z = pk2(b[0], b[1]); o.w = pk2(b[2], b[3]); *(v4u*)(xn0 + (size_t)m * 1024 + hh * 512 + lane * 8) = o; }
    } }
    GSYNC();
    if (G == 0x7fffff) GSYNC_CG();
    int fastsync;
    { int ok = 1; const unsigned* xt = (const unsigned*)(ws_ptr() + 32768);
      if (G != 256) ok = 0; else if (tid < 256) ok = (xt[tid] != 0u) && (xt[tid] == xt[tid & 7]);
      fastsync = __syncthreads_and(ok); }

    enum { K_GU = 0, K_PLAIN = 1, K_NORM = 2, K_CONV = 3, K_QKV = 4, K_ATTN = 5, K_COMB = 6 };
    for (int l = 0; l < DEPTH_; ++l) {
        const int nsteps = (l & 1) ? 11 : 10;
        for (int s = 0; s < nsteps; ++s) {
            int lq = l; asm volatile("" : "+s"(lq));
            const int isattn = lq & 1, jm = lq >> 1;
            const bf16* Wmix = P_WB + 8 * W_FFN_E + (size_t)lq * W_MIX_E;
            int kind; const bf16* gA = P_XN; const bf16* gB = P_WB; int gN = 1024, gK = 1024; bf16* gO = P_FB;
            float coef = 0.5f; const float* gpost = in_ptr(2); const float* gnext = in_ptr(2); int wnext = 1;
            int ffn_i = 0;
            const int sm = (isattn && s >= 5) ? s - 1 : s;
            if (s == 0 || sm == 7) { kind = K_GU; ffn_i = (s == 0) ? 0 : 1; }
            else if (s == 1 || sm == 8) { kind = K_PLAIN; ffn_i = (s == 1) ? 0 : 1; gA = P_BIG; gB = P_WB + (size_t)(2 * lq + ffn_i) * W_FFN_E + W_GU_E; gN = 1024; gK = DFF; gO = P_FB; }
            else if (s == 2) { kind = K_NORM; coef = 0.5f; gpost = in_ptr(2) + (size_t)(lq * 2 + 1) * DM_; gnext = in_ptr(5) + (size_t)(lq * 2) * DM_; }
            else if (s == 3) { if (isattn) kind = K_QKV; else { kind = K_PLAIN; gA = P_XN; gB = Wmix; gN = 3 * DM_; gK = DM_; gO = P_BIG; } }
            else if (s == 4) { kind = isattn ? K_ATTN : K_CONV; }
            else if (isattn && s == 5) { kind = K_COMB; }
            else if (sm == 5) { kind = K_PLAIN; gA = P_XN; gB = Wmix + W_IN_E; gN = 1024; gK = 1024; gO = P_FB; }
            else if (sm == 6) { kind = K_NORM; coef = 1.0f; gpost = in_ptr(5) + (size_t)(lq * 2 + 1) * DM_; gnext = in_ptr(13) + (size_t)(lq * 2) * DM_; }
            else { kind = K_NORM; coef = 0.5f; gpost = in_ptr(13) + (size_t)(lq * 2 + 1) * DM_; wnext = (lq < DEPTH_ - 1); gnext = in_ptr(2) + (size_t)((lq < DEPTH_ - 1 ? lq + 1 : lq) * 2) * DM_; }

            const bool meta_live = !(lq == DEPTH_ - 1 && s >= 5);
            const int lane = opaque_tid() & 63;
            const bool ral = (G == 256); const int ri0 = ral ? (gw & 255) : gw, rin = ral ? ((meta_live && (gw & 15) == 0) ? SEQL + 256 : SEQL) : (meta_live ? MVALID : MREAL),        ris = ral ? 256 : NGW, rbt = gw >> 8;
#define ROWMAP(i_) (ral ? batch_row(rbt, (i_)) : (i_))
            if (kind == K_GU) {
                pg8::Gemm g{P_XN, P_WB + (size_t)(2 * lq + ffn_i) * W_FFN_E, MREAL, NGU, DM_}; pg8::StaticOrder S; S.init(MREAL, NGU, G, bx);
                pg8::EpiSwiGLU E{P_BIG, DFF};
                pg8::gemm_phase<pg8::EpiSwiGLU, pg8::StaticOrder, true, true>(ldsl, g, S, E);
                { const int lo = (G == 256) ? 128 : 0;
                  tail_gemm<1, 128, 1, 8>(ldsl, P_XN + (size_t)MREAL * DM_, P_WB + (size_t)(2 * lq + ffn_i) * W_FFN_E, NGU, P_BIG, DFF, nullptr, 1.f, 0, meta_live ? bx - lo : -1, G - lo); }
            } else if (kind == K_PLAIN) {
                pg8::Gemm g{gA, gB, MREAL, gN, gK}; pg8::StaticOrder S; S.init(MREAL, gN, G, bx);
                pg8::EpiBf16<0> E{gO, gN, nullptr, 0, 0, 1.f};
                pg8::gemm_phase<pg8::EpiBf16<0>, pg8::StaticOrder, true, true>(ldsl, g, S, E);
                if (gK == DM_) { if (gN == DM_) tail_gemm<0, 128, 1, 2>(ldsl, gA + (size_t)MREAL * DM_, gB, gN, gO, gN, nullptr, 1.f, 0, meta_live ? bx : -1, G); else tail_gemm<0, 128, 1, 6>(ldsl, gA + (size_t)MREAL * DM_, gB, gN, gO, gN, nullptr, 1.f, 0, bx, G); }
                else tail_gemm<0, 352, 1, 2>(ldsl, gA + (size_t)MREAL * DFF, gB, gN, gO, gN, nullptr, 1.f, 0, meta_live ? bx : -1, G);
            } else if (kind == K_QKV) {
                pg8::Gemm g{P_XN, Wmix, MREAL, 3 * DM_, DM_}; pg8::StaticOrder S; S.init(MREAL, 3 * DM_, G, bx);
                pg8::EpiQKV E{P_BIG, (size_t)QROWS * 1024, P_ROPE, attn_body::C2};
                pg8::gemm_phase<pg8::EpiQKV, pg8::StaticOrder, true, true>(ldsl, g, S, E);
                tail_gemm<2, 128, 1, 6>(ldsl, P_XN + (size_t)MREAL * DM_, Wmix, 3 * DM_, P_BIG, 1024, P_ROPE, attn_body::C2, (size_t)QROWS * 1024, bx, G);
            } else if (kind == K_NORM) {
                float* const hp_out = out_ptr(); float* const hp_meta = P_HMETA; const bf16* const fb0 = P_FB; bf16* const xn0 = P_XN;
                f32x4 nv[4]; v4u nw[2];
#define NORM_LOAD(mm) do { const float* hq_ = hrow_ptr(hsrc0, hp_meta, (mm)); const bf16* fq_ = fb0 + (size_t)(mm) * 1024; \
                    nw[0] = __builtin_nontemporal_load((const v4u*)(fq_ + lane * 8)); nw[1] = __builtin_nontemporal_load((const v4u*)(fq_ + 512 + lane * 8)); \
                    _Pragma("unroll") for (int q = 0; q < 4; ++q) nv[q] = *(const f32x4*)(hq_ + (q >> 1) * 512 + lane * 8 + (q & 1) * 4); } while (0)
                float* const hsrc0 = (lq == 0 && s == 2) ? (float*)in_ptr(0) : hp_out;
                NORM_LOAD(ROWMAP(ri0 < rin ? ri0 : 0));
                for (int ri = ri0; ri < rin; ri += ris) { const int m = ROWMAP(ri);
                    float* hr = hrow_ptr(hp_out, hp_meta, m);
                    f32x4 v[4]; float fv[16]; float s1 = 0.f;
#pragma unroll
                    for (int hh = 0; hh < 2; ++hh) { const v4u w = nw[hh];
                        fv[hh * 8 + 0] = bflo(w.x); fv[hh * 8 + 1] = bfhi(w.x); fv[hh * 8 + 2] = bflo(w.y); fv[hh * 8 + 3] = bfhi(w.y); fv[hh * 8 + 4] = bflo(w.z); fv[hh * 8 + 5] = bfhi(w.z); fv[hh * 8 + 6] = bflo(w.w); fv[hh * 8 + 7] = bfhi(w.w); }
#pragma unroll
                    for (int q = 0; q < 4; ++q) v[q] = nv[q];
                    if (ri + ris < rin) NORM_LOAD(ROWMAP(ri + ris));
#pragma unroll
                    for (int e = 0; e < 16; ++e) s1 += fv[e] * fv[e];
                    const float r1 = coef / sqrtf(wave_sum(s1) * (1.f / DM_) + 1e-6f); float s2 = 0.f;
#pragma unroll
                    for (int q = 0; q < 4; ++q) { const f32x4 gp = *(const f32x4*)(gpost + (q >> 1) * 512 + lane * 8 + (q & 1) * 4);
#pragma unroll
                        for (int i = 0; i < 4; ++i) { v[q][i] += fv[q * 4 + i] * r1 * gp[i]; s2 += v[q][i] * v[q][i]; } }
                    const float r2 = 1.0f / sqrtf(wave_sum(s2) * (1.f / DM_) + 1e-6f);
#pragma unroll
                    for (int q = 0; q < 4; ++q) *(f32x4*)(hr + (q >> 1) * 512 + lane * 8 + (q & 1) * 4) = v[q];
                    if (wnext) {
#pragma unroll
                        for (int hh = 0; hh < 2; ++hh) { const f32x4 g0 = *(const f32x4*)(gnext + hh * 512 + lane * 8), g1 = *(const f32x4*)(gnext + hh * 512 + lane * 8 + 4); const f32x4 a = v[2 * hh] * r2 * g0, b = v[2 * hh + 1] * r2 * g1;
                            v4u o; o.x = pk2(a[0], a[1]); o.y = pk2(a[2], a[3]); o.z = pk2(b[0], b[1]); o.w = pk2(b[2], b[3]); *(v4u*)(xn0 + (size_t)m * 1024 + hh * 512 + lane * 8) = o; }
                    }
                }
#undef NORM_LOAD
            } else if (kind == K_CONV) {
                const float* cw = in_ptr(7) + (size_t)jm * 3 * DM_; const bf16* const big0 = P_BIG; bf16* const xn0 = P_XN;
                for (int ri = ri0; ri < rin; ri += ris) { const int m = ROWMAP(ri);
                    const int m1 = prev_row(m, 1), m2 = prev_row(m, 2);
#pragma unroll
                    for (int hh = 0; hh < 2; ++hh) { const int d0 = hh * 512 + lane * 8; float acc8[8];
#pragma unroll
                        for (int k = 0; k < 3; ++k) { const int mr = (k == 2) ? m : (k == 1 ? m1 : m2); v4u cc = {0u, 0u, 0u, 0u}, xx = cc;
                            if (mr >= 0) { cc = *(const v4u*)(big0 + (size_t)mr * 3072 + 1024 + d0); xx = *(const v4u*)(big0 + (size_t)mr * 3072 + 2048 + d0); }
                            const f32x4 w0 = *(const f32x4*)(cw + k * DM_ + d0), w1 = *(const f32x4*)(cw + k * DM_ + d0 + 4);
                            const float u0 = bflo(cc.x) * bflo(xx.x), u1 = bfhi(cc.x) * bfhi(xx.x), u2 = bflo(cc.y) * bflo(xx.y), u3 = bfhi(cc.y) * bfhi(xx.y);
                            const float u4 = bflo(cc.z) * bflo(xx.z), u5 = bfhi(cc.z) * bfhi(xx.z), u6 = bflo(cc.w) * bflo(xx.w), u7 = bfhi(cc.w) * bfhi(xx.w);
                            if (k == 0) { acc8[0] = w0[0] * u0; acc8[1] = w0[1] * u1; acc8[2] = w0[2] * u2; acc8[3] = w0[3] * u3; acc8[4] = w1[0] * u4; acc8[5] = w1[1] * u5; acc8[6] = w1[2] * u6; acc8[7] = w1[3] * u7; }
                            else { acc8[0] += w0[0] * u0; acc8[1] += w0[1] * u1; acc8[2] += w0[2] * u2; acc8[3] += w0[3] * u3; acc8[4] += w1[0] * u4; acc8[5] += w1[1] * u5; acc8[6] += w1[2] * u6; acc8[7] += w1[3] * u7; } }
                        const v4u bb = __builtin_nontemporal_load((const v4u*)(big0 + (size_t)m * 3072 + d0));
                        v4u o; o.x = pk2(bflo(bb.x) * acc8[0], bfhi(bb.x) * acc8[1]); o.y = pk2(bflo(bb.y) * acc8[2], bfhi(bb.y) * acc8[3]); o.z = pk2(bflo(bb.z) * acc8[4], bfhi(bb.z) * acc8[5]); o.w = pk2(bflo(bb.w) * acc8[6], bfhi(bb.w) * acc8[7]);
                        *(v4u*)(xn0 + (size_t)m * 1024 + d0) = o; }
                }
            } else if (kind == K_ATTN) {
                bf16* const big0 = P_BIG; const attn_body::AttnTensors AT{(const attn_body::bf16*)big0, (const attn_body::bf16*)(big0 + (size_t)QROWS * 1024), (const attn_body::bf16*)(big0 + (size_t)2 * QROWS * 1024), (attn_body::bf16*)P_XN, (attn_body::bf16*)P_FB};
                attn_body::attn_phase<8>((char*)lds, AT, vcu, G);
            } else {
                const float linit = 0.8f - 0.6f * expf(-0.3f * (float)lq);
                const float* lp = in_ptr(10) + (size_t)jm * 4 * 64;
                const float lam = expf(wave_sum(lp[lane] * lp[64 + lane])) - expf(wave_sum(lp[128 + lane] * lp[192 + lane])) + linit;
                const float* sg = in_ptr(11) + (size_t)jm * 128; const int hd = lane >> 3, dv0 = (lane & 7) * 16;
                float gs[16];
#pragma unroll
                for (int q = 0; q < 4; ++q) { const f32x4 t4 = *(const f32x4*)(sg + dv0 + q * 4); gs[q * 4 + 0] = t4[0] * (1.f - linit); gs[q * 4 + 1] = t4[1] * (1.f - linit); gs[q * 4 + 2] = t4[2] * (1.f - linit); gs[q * 4 + 3] = t4[3] * (1.f - linit); }
                bf16* const ob0 = P_XN; const bf16* const ob1 = P_FB;
                for (int ri = ri0; ri < rin; ri += ris) { const int m = ROWMAP(ri);
                    bf16* orow = ob0 + (size_t)m * 1024 + hd * 128 + dv0; const bf16* orow1 = ob1 + (size_t)m * 1024 + hd * 128 + dv0;
                    const v4u a0 = *(const v4u*)(orow), a1 = *(const v4u*)(orow + 8), b0 = __builtin_nontemporal_load((const v4u*)(orow1)), b1 = __builtin_nontemporal_load((const v4u*)(orow1 + 8));
                    float d[16];
                    d[0] = bflo(a0.x) - lam * bflo(b0.x); d[1] = bfhi(a0.x) - lam * bfhi(b0.x); d[2] = bflo(a0.y) - lam * bflo(b0.y); d[3] = bfhi(a0.y) - lam * bfhi(b0.y);
                    d[4] = bflo(a0.z) - lam * bflo(b0.z); d[5] = bfhi(a0.z) - lam * bfhi(b0.z); d[6] = bflo(a0.w) - lam * bflo(b0.w); d[7] = bfhi(a0.w) - lam * bfhi(b0.w);
                    d[8] = bflo(a1.x) - lam * bflo(b1.x); d[9] = bfhi(a1.x) - lam * bfhi(b1.x); d[10] = bflo(a1.y) - lam * bflo(b1.y); d[11] = bfhi(a1.y) - lam * bfhi(b1.y);
                    d[12] = bflo(a1.z) - lam * bflo(b1.z); d[13] = bfhi(a1.z) - lam * bfhi(b1.z); d[14] = bflo(a1.w) - lam * bflo(b1.w); d[15] = bfhi(a1.w) - lam * bfhi(b1.w);
                    float ss = 0.f;
#pragma unroll
                    for (int e = 0; e < 16; ++e) ss += d[e] * d[e];
                    ss += __shfl_xor(ss, 1); ss += __shfl_xor(ss, 2); ss += __shfl_xor(ss, 4);
                    const float rr = 1.0f / sqrtf(ss * (1.f / 128.f) + 1e-5f);
                    v4u o0, o1;
                    o0.x = pk2(d[0] * rr * gs[0], d[1] * rr * gs[1]); o0.y = pk2(d[2] * rr * gs[2], d[3] * rr * gs[3]); o0.z = pk2(d[4] * rr * gs[4], d[5] * rr * gs[5]); o0.w = pk2(d[6] * rr * gs[6], d[7] * rr * gs[7]);
                    o1.x = pk2(d[8] * rr * gs[8], d[9] * rr * gs[9]); o1.y = pk2(d[10] * rr * gs[10], d[11] * rr * gs[11]); o1.z = pk2(d[12] * rr * gs[12], d[13] * rr * gs[13]); o1.w = pk2(d[14] * rr * gs[14], d[15] * rr * gs[15]);
                    *(v4u*)orow = o0; *(v4u*)(orow + 8) = o1;
                }
            }
#undef ROWMAP
            {
              const int arrive_s = (s == 1) ? 0 : (s == 4) ? 1 : -1;
              const int wait_s = isattn ? ((s == 2) ? 0 : (s == 7) ? 1 : -1) : ((s == 2) ? 0 : (s == 6) ? 1 : -1);
              const bool full = false;
              unsigned* const splitc = (unsigned*)(ws_ptr() + 40960) + 64 * (2 * lq + (arrive_s >= 0 ? arrive_s : (wait_s >= 0 ? wait_s : 0)));
              if (lq == DEPTH_ - 1 && s == nsteps - 1) {   }
              else if (!fastsync || full) GSYNC();
              else { LSYNC();
                     if (arrive_s >= 0) { if (opaque_tid() == 0) __hip_atomic_fetch_add(splitc, 1u, __ATOMIC_RELAXED, __HIP_MEMORY_SCOPE_AGENT); }
                     if (wait_s >= 0) { if (opaque_tid() == 0) { unsigned sp_ = 0; while (__hip_atomic_load(splitc, __ATOMIC_RELAXED, __HIP_MEMORY_SCOPE_AGENT) < (unsigned)G && ++sp_ < (1u << 22)) __builtin_amdgcn_s_sleep(1); }
                                        __syncthreads(); } } }
        }
    }
}

extern "C" void kernel_launch(void* const* d_in, const int* in_sizes, int n_in, void* d_out, int out_size, void* d_ws, size_t ws_size, hipStream_t stream) {
    static int grid = 0;
    if (grid == 0) {
        if (n_in != 16 || out_size != MREAL * DM_ || ws_size < WS_END) { fprintf(stderr, "kernel_launch: unexpected shapes: n_in %d out %d ws %zu (need %zu)\n", n_in, out_size, ws_size, (size_t)WS_END); grid = -1; return; }
        int dev = 0, cus = 0, per_cu = 0;
        if (hipGetDevice(&dev) != hipSuccess || hipDeviceGetAttribute(&cus, hipDeviceAttributeMultiprocessorCount, dev) != hipSuccess) { grid = -1; return; }
        if (hipFuncSetAttribute((const void*)trunk_fwd, hipFuncAttributeMaxDynamicSharedMemorySize, LDS_BYTES) != hipSuccess) { fprintf(stderr, "kernel_launch: hipFuncSetAttribute failed\n"); grid = -1; return; }
        if (hipOccupancyMaxActiveBlocksPerMultiprocessor(&per_cu, (const void*)trunk_fwd, NWAVES * 64, LDS_BYTES) != hipSuccess || per_cu < 1) { fprintf(stderr, "kernel_launch: occupancy query says %d\n", per_cu); per_cu = 1; }
        (void)hipGetLastError();
        grid = cus * per_cu;
    }
    if (grid < 0) return;
    if (hipMemsetAsync(d_ws, 0, 65536, stream) != hipSuccess) { fprintf(stderr, "kernel_launch: memset failed\n"); return; }
    Args a{};
    for (int i = 0; i < 16; ++i) a.in[i] = (const float*)d_in[i];
    a.out = (float*)d_out; a.ws = (unsigned char*)d_ws;
    void* kargs[] = {&a};
    hipError_t e = hipLaunchCooperativeKernel((const void*)trunk_fwd, dim3(grid), dim3(NWAVES * 64), kargs, LDS_BYTES, stream);
    if (e != hipSuccess) fprintf(stderr, "kernel_launch: cooperative launch failed: %s (grid %d)\n", hipGetErrorString(e), grid);
}
```

```cpp
#include <hip/hip_runtime.h>
#include <cstdio>
#include <cstdint>
__device__ __forceinline__ int opaque_tid() { int t = threadIdx.x; asm volatile("" : "+v"(t)); return t; }
namespace pg8 {
#define PG8_LAS __attribute__((address_space(3)))
typedef unsigned short bf16_t;
typedef short bf16x8 __attribute__((ext_vector_type(8)));
typedef float f32x4 __attribute__((ext_vector_type(4)));
typedef unsigned u32x4 __attribute__((ext_vector_type(4)));
constexpr int BM = 256, BK = 64, HALF = 128, HTB = HALF * BK * 2  , STAGE_BYTES = 8 * HTB, NXCD = 8, WGM = 4;

__host__ __device__ __forceinline__ int lds_byte(int r, int c) { const int st = (r >> 4) * 2 + (c >> 5), rr = r & 15, cc = c & 31, ob = rr * 64 + cc * 2; return st * 1024 + (ob ^ (((ob >> 9) & 1) << 5)); }
__host__ __device__ __forceinline__ void stage_rc(int b, int& R, int& C) { const int st = b / 1024, sb = b % 1024, swz = sb ^ (((sb >> 9) & 1) << 5); R = (st >> 1) * 16 + swz / 64; C = (st & 1) * 32 + (swz % 64) / 2; }
__host__ __device__ __forceinline__ int perm32(int rho) { const int n = rho >> 4, i = rho & 15; return 8 * (i >> 2) + 4 * n + (i & 3); }

struct Unit { int pm, pn; };
struct Gemm { const bf16_t* A; const bf16_t* Bt; int M, N, K; };

struct StaticOrder {
    int nM, nN, nwg, G, c;
    __host__ __device__ void init(int M, int N, int G_, int c_) { nM = M / BM; nN = N / BM; nwg = nM * nN; G = G_; c = c_; }
    __host__ __device__ bool next(int i, Unit& u) const {
        const long L = (long)i * G + c; if (L >= nwg) return false;
        int wgid = (int)L; { const int q = nwg / NXCD, r = nwg % NXCD, xcd = wgid % NXCD, off = wgid / NXCD; wgid = (xcd < r ? xcd * (q + 1) : r * (q + 1) + (xcd - r) * q) + off; }
        const int nig = WGM * nN, gid = wgid / nig, fm = gid * WGM, gsz = (nM - fm) < WGM ? (nM - fm) : WGM;
        u.pm = fm + ((wgid % nig) % gsz); u.pn = (wgid % nig) / gsz; return true;
    }
    __device__ __forceinline__ void a_ready(const Unit&) const {}
    __device__ __forceinline__ void done(const Unit&) const {}
};

__device__ __forceinline__ unsigned cvt_pk_bf16(float lo, float hi) { unsigned r; asm volatile("v_cvt_pk_bf16_f32 %0, %1, %2" : "=v"(r) : "v"(lo), "v"(hi)); return r; }
typedef float f32x2 __attribute__((ext_vector_type(2)));
__device__ __forceinline__ f32x2 gelu_pk(f32x2 v) {
    const f32x2 av = __builtin_elementwise_abs(v), d = av * 0.2316418882f + 1.0f;
    f32x2 t; t.x = __builtin_amdgcn_rcpf(d.x); t.y = __builtin_amdgcn_rcpf(d.y);
    f32x2 q = t * 0.5307027145f + (-0.7265760135f); q = q * t + 0.7107068705f; q = q * t + (-0.142248368f); q = q * t + 0.127414796f; q = q * t;
    const f32x2 s = (v * v) * (-0.72134752044f);
    f32x2 e; e.x = __builtin_amdgcn_exp2f(s.x); e.y = __builtin_amdgcn_exp2f(s.y);
    const f32x2 m = v * (q * e), r = v - m;
    f32x2 o; o.x = v.x < 0.f ? m.x : r.x; o.y = v.y < 0.f ? m.y : r.y; return o;
}

template <int ACT  > struct EpiBf16 {
    static constexpr bool PERM = true, AFTER_DRAIN = false; static_assert(ACT == 0 || ACT == 1, "EpiBf16: ACT is 0 (none) or 1 (gelu_pk)");
    bf16_t* O; int ldc; const float* bias; int split_cols; size_t split_stride; float scale0;
    __device__ __forceinline__ void operator()(const f32x4 (&acc)[2][2][4][2], const Unit& u, int wr, int wc, int fr, int fq) const {
        const int row0 = u.pm * BM + wr * 64 + fr; int colt = u.pn * BM; bf16_t* base = O;
        float sc = 1.f; if (split_cols) { const int t = colt / split_cols; base += (size_t)t * split_stride; colt -= t * split_cols; if (t == 0) sc = scale0; }
        const int col0 = colt + wc * 32 + 8 * fq, bcol0 = u.pn * BM + wc * 32 + 8 * fq;
        f32x4 bv[2][2];
#pragma unroll
        for (int bj = 0; bj < 2; ++bj)
#pragma unroll
            for (int n = 0; n < 2; ++n) bv[bj][n] = bias ? *(const f32x4*)(bias + bcol0 + bj * HALF + 4 * n) : (f32x4){0.f, 0.f, 0.f, 0.f};
#pragma unroll
        for (int ai = 0; ai < 2; ++ai)
#pragma unroll
            for (int m = 0; m < 4; ++m) { bf16_t* rowp = base + (size_t)(row0 + ai * HALF + m * 16) * ldc + col0;
#pragma unroll
                for (int bj = 0; bj < 2; ++bj) { f32x4 v0 = acc[ai][bj][m][0] + bv[bj][0], v1 = acc[ai][bj][m][1] + bv[bj][1];
                    if (ACT == 1) { f32x2 a = gelu_pk((f32x2){v0[0], v0[1]}), b = gelu_pk((f32x2){v0[2], v0[3]}), c = gelu_pk((f32x2){v1[0], v1[1]}), d = gelu_pk((f32x2){v1[2], v1[3]});
                        v0 = (f32x4){a.x, a.y, b.x, b.y}; v1 = (f32x4){c.x, c.y, d.x, d.y}; }
                    v0 = v0 * sc; v1 = v1 * sc; u32x4 w; w.x = cvt_pk_bf16(v0[0], v0[1]); w.y = cvt_pk_bf16(v0[2], v0[3]); w.z = cvt_pk_bf16(v1[0], v1[1]); w.w = cvt_pk_bf16(v1[2], v1[3]);
                    *(u32x4*)(rowp + bj * HALF) = w; } }
    }
};

struct PanelStats {
    unsigned* xbuf;
    unsigned* cnt;
    unsigned* tmo;
    int ntn; float eps;
    unsigned code;
    __device__ __forceinline__ bool run(const f32x4 (&v)[2][2][4][2], const Unit& u, int wr, int wc, int fr, int fq, PG8_LAS unsigned char* lds, int wid, int lane) const {
        typedef float f32x2v __attribute__((ext_vector_type(2)));
        PG8_LAS f32x2v* P = (PG8_LAS f32x2v*)lds;
        PG8_LAS f32x2v* S = (PG8_LAS f32x2v*)(lds + 8192);
        PG8_LAS unsigned* flag = (PG8_LAS unsigned*)(lds + 8192 + 2048);
#pragma unroll
        for (int ai = 0; ai < 2; ++ai)
#pragma unroll
            for (int m = 0; m < 4; ++m) {
                float s = 0.f;
#pragma unroll
                for (int bj = 0; bj < 2; ++bj)
#pragma unroll
                    for (int n = 0; n < 2; ++n) { const f32x4 x = v[ai][bj][m][n]; s += (x[0] + x[1]) + (x[2] + x[3]); }
                s += __shfl_xor(s, 16); s += __shfl_xor(s, 32);
                const float mw = s * (1.0f / 64.0f); float q = 0.f;
#pragma unroll
                for (int bj = 0; bj < 2; ++bj)
#pragma unroll
                    for (int n = 0; n < 2; ++n) { const f32x4 d = v[ai][bj][m][n] - mw; q += (d[0] * d[0] + d[1] * d[1]) + (d[2] * d[2] + d[3] * d[3]); }
                q += __shfl_xor(q, 16); q += __shfl_xor(q, 32);
                if (fq == 0) P[(ai * HALF + wr * 64 + m * 16 + fr) * 4 + wc] = (f32x2v){mw, q};
            }
        asm volatile("s_waitcnt lgkmcnt(0)" ::: "memory"); __builtin_amdgcn_s_barrier(); asm volatile("" ::: "memory");
#if defined(BROKEN_EXCHANGE_NO_WAIT)
#warning BROKEN CONTROL BUILD: the row-statistics exchange does not wait; results are wrong by design
        if (blockIdx.x >= 64) { const long long t0_ = clock64(); while (clock64() - t0_ < 60000) __builtin_amdgcn_s_sleep(8); }
#endif
        const int row = wid * 32 + (lane & 31);
        if (lane < 32) {
            const f32x2v a = P[row * 4 + 0], b = P[row * 4 + 1], c = P[row * 4 + 2], d = P[row * 4 + 3];
            const float mt = (a.x + b.x + c.x + d.x) * 0.25f;
            const float da = a.x - mt, db = b.x - mt, dc = c.x - mt, dd = d.x - mt;
            const float m2 = (a.y + b.y) + (c.y + d.y) + 64.0f * ((da * da + db * db) + (dc * dc + dd * dd));
            unsigned long long* slot = (unsigned long long*)xbuf + ((size_t)(u.pm * BM + row) * 4 + u.pn);
            __hip_atomic_store(slot, ((unsigned long long)__float_as_uint(m2) << 32) | __float_as_uint(mt), __ATOMIC_RELAXED, __HIP_MEMORY_SCOPE_AGENT);
        }
        asm volatile("s_waitcnt vmcnt(0)" ::: "memory");
        if (lane == 0) __hip_atomic_fetch_add(cnt + 64 * u.pm, 1u, __ATOMIC_RELAXED, __HIP_MEMORY_SCOPE_AGENT);
        if (wid == 0) {
            bool dead = false; const unsigned long long t0 = __builtin_amdgcn_s_memrealtime(); const unsigned want = 8u * (unsigned)ntn;
            for (;;) {
#if defined(BROKEN_EXCHANGE_NO_WAIT)
                break;
#endif
                if ((unsigned)__builtin_amdgcn_readfirstlane(__hip_atomic_load(cnt + 64 * u.pm, __ATOMIC_RELAXED, __HIP_MEMORY_SCOPE_AGENT)) >= want) break;
                if (__builtin_amdgcn_s_memrealtime() - t0 > 2000000ull) {
                    if (lane == 0) { unsigned expect = 0u; __hip_atomic_compare_exchange_strong(tmo + 1, &expect, code | (unsigned)(u.pm & 0xff), __ATOMIC_RELAXED, __ATOMIC_RELAXED, __HIP_MEMORY_SCOPE_AGENT);
                                     __hip_atomic_store(tmo, 1u, __ATOMIC_RELAXED, __HIP_MEMORY_SCOPE_AGENT); }
                    dead = true; break; }
                __builtin_amdgcn_s_sleep(2);
            }
            __builtin_amdgcn_fence(__ATOMIC_ACQUIRE, "agent");
            if (lane == 0) flag[0] = dead ? 1u : 0u;
        }
        asm volatile("s_waitcnt vmcnt(0) lgkmcnt(0)" ::: "memory"); __builtin_amdgcn_s_barrier(); asm volatile("" ::: "memory");
        const bool bad = flag[0] != 0u;
        if (lane < 32) {
            const unsigned long long* slot = (const unsigned long long*)xbuf + (size_t)(u.pm * BM + row) * 4; float mt[4], m2[4]; float ms = 0.f;
#pragma unroll
            for (int t = 0; t < 4; ++t) { if (t < ntn) { const unsigned long long w = __hip_atomic_load(slot + t, __ATOMIC_RELAXED, __HIP_MEMORY_SCOPE_AGENT); mt[t] = __uint_as_float((unsigned)w); m2[t] = __uint_as_float((unsigned)(w >> 32)); } else { mt[t] = 0.f; m2[t] = 0.f; } ms += mt[t]; }
            const float mean = ms / (float)ntn; float q = 0.f;
#pragma unroll
            for (int t = 0; t < 4; ++t) if (t < ntn) { const float dm = mt[t] - mean; q += m2[t] + 256.0f * dm * dm; }
            S[row] = (f32x2v){mean, 1.0f / sqrtf(q / (256.0f * (float)ntn) + eps)};
        }
        asm volatile("s_waitcnt lgkmcnt(0)" ::: "memory"); __builtin_amdgcn_s_barrier(); asm volatile("" ::: "memory");
        return bad;
    }
};
struct EpiLnRes {
    static constexpr bool PERM = false, AFTER_DRAIN = true;
    const float* base; float* out; int ldc; const float* bias; PanelStats st; unsigned poison;
    __device__ __forceinline__ void fused(f32x4 (&acc)[2][2][4][2], const Unit& u, int wr, int wc, int fr, int fq, PG8_LAS unsigned char* lds, int wid, int lane) const {
        typedef float f32x2v __attribute__((ext_vector_type(2)));
        const PG8_LAS f32x2v* S = (const PG8_LAS f32x2v*)(lds + 8192);
        const int col0 = u.pn * BM + wc * 32 + 4 * fq;
#pragma unroll
        for (int bj = 0; bj < 2; ++bj)
#pragma unroll
            for (int n = 0; n < 2; ++n) { const f32x4 bv = bias ? *(const f32x4*)(bias + col0 + bj * HALF + n * 16) : (f32x4){0.f, 0.f, 0.f, 0.f};
#pragma unroll
                for (int ai = 0; ai < 2; ++ai)
#pragma unroll
                    for (int m = 0; m < 4; ++m) acc[ai][bj][m][n] += bv; }
        f32x4 pre[4][2][2];
#pragma unroll
        for (int m = 0; m < 4; ++m) { const size_t off = (size_t)(u.pm * BM + wr * 64 + m * 16 + fr) * ldc + col0;
#pragma unroll
            for (int bj = 0; bj < 2; ++bj)
#pragma unroll
                for (int n = 0; n < 2; ++n) pre[m][bj][n] = *(const f32x4*)(base + off + bj * HALF + n * 16); }
        const bool bad = st.run(acc, u, wr, wc, fr, fq, lds, wid, lane) || poison != 0u;
        const float qnan = __builtin_nanf("");
#pragma unroll
        for (int ai = 0; ai < 2; ++ai)
#pragma unroll
            for (int m = 0; m < 4; ++m) { const int r = ai * HALF + wr * 64 + m * 16 + fr; const f32x2v sr = S[r]; const size_t off = (size_t)(u.pm * BM + r) * ldc + col0;
#pragma unroll
                for (int bj = 0; bj < 2; ++bj)
#pragma unroll
                    for (int n = 0; n < 2; ++n) { const f32x4 bs = ai == 0 ? pre[m][bj][n] : *(const f32x4*)(base + off + bj * HALF + n * 16); f32x4 o = bs + (acc[ai][bj][m][n] - sr.x) * sr.y;
                        if (bad) o = (f32x4){qnan, qnan, qnan, qnan}; *(f32x4*)(out + off + bj * HALF + n * 16) = o; }
                if (m & 1) asm volatile("" ::: "memory"); }
    }
};
struct EpiLnResLn {
    static constexpr bool PERM = false, AFTER_DRAIN = true;
    const float* base; float* out; bf16_t* xn; int ldc; const float* bias; PanelStats st1, st2; unsigned poison;
    __device__ __forceinline__ void fused(f32x4 (&acc)[2][2][4][2], const Unit& u, int wr, int wc, int fr, int fq, PG8_LAS unsigned char* lds, int wid, int lane) const {
        typedef float f32x2v __attribute__((ext_vector_type(2))); typedef unsigned u32x2v __attribute__((ext_vector_type(2)));
        const PG8_LAS f32x2v* S = (const PG8_LAS f32x2v*)(lds + 8192);
        const int col0 = u.pn * BM + wc * 32 + 4 * fq;
#pragma unroll
        for (int bj = 0; bj < 2; ++bj)
#pragma unroll
            for (int n = 0; n < 2; ++n) { const f32x4 bv = bias ? *(const f32x4*)(bias + col0 + bj * HALF + n * 16) : (f32x4){0.f, 0.f, 0.f, 0.f};
#pragma unroll
                for (int ai = 0; ai < 2; ++ai)
#pragma unroll
                    for (int m = 0; m < 4; ++m) acc[ai][bj][m][n] += bv; }
        bool bad = st1.run(acc, u, wr, wc, fr, fq, lds, wid, lane) || poison != 0u;
        const float qnan = __builtin_nanf("");
#pragma unroll
        for (int ai = 0; ai < 2; ++ai)
#pragma unroll
            for (int m = 0; m < 4; ++m) { const int r = ai * HALF + wr * 64 + m * 16 + fr; const f32x2v sr = S[r]; const size_t off = (size_t)(u.pm * BM + r) * ldc + col0;
#pragma unroll
                for (int bj = 0; bj < 2; ++bj)
#pragma unroll
                    for (int n = 0; n < 2; ++n) { const f32x4 bs = *(const f32x4*)(base + off + bj * HALF + n * 16); acc[ai][bj][m][n] = bs + (acc[ai][bj][m][n] - sr.x) * sr.y; }
                asm volatile("" : "+v"(acc[ai][0][m][0]), "+v"(acc[ai][0][m][1]), "+v"(acc[ai][1][m][0]), "+v"(acc[ai][1][m][1]));
                if (m & 1) asm volatile("" ::: "memory"); }
        const bool bad1 = bad;
        bad = st2.run(acc, u, wr, wc, fr, fq, lds, wid, lane) || bad;
#pragma unroll
        for (int ai = 0; ai < 2; ++ai)
#pragma unroll
            for (int m = 0; m < 4; ++m) { const int r = ai * HALF + wr * 64 + m * 16 + fr; const f32x2v sr = S[r]; const size_t off = (size_t)(u.pm * BM + r) * ldc + col0;
#pragma unroll
                for (int bj = 0; bj < 2; ++bj)
#pragma unroll
                    for (int n = 0; n < 2; ++n) { const f32x4 x1 = acc[ai][bj][m][n]; *(f32x4*)(out + off + bj * HALF + n * 16) = bad1 ? (f32x4){qnan, qnan, qnan, qnan} : x1;
                        const f32x4 o = (x1 - sr.x) * sr.y; u32x2v w; w.x = cvt_pk_bf16(o[0], o[1]); w.y = cvt_pk_bf16(o[2], o[3]);
                        if (bad) { w.x = 0x7fc07fc0u; w.y = 0x7fc07fc0u; } *(u32x2v*)(xn + off + bj * HALF + n * 16) = w; }
                asm volatile("" ::: "memory"); }
    }
};

template <class Epi, class Sched, bool ALIGN_EPI = false, bool SP2 = false>
__device__ __forceinline__ void gemm_phase(PG8_LAS unsigned char* lds, const Gemm g, const Sched& S, const Epi& E) {
    const int tid = opaque_tid(), wid = __builtin_amdgcn_readfirstlane(tid >> 6), lane = tid & 63, wr = wid >> 2, wc = wid & 3, fr = lane & 15, fq = lane >> 4;
    const int K = g.K, nt = K / BK;
    unsigned voffA[2], voffB[2];
#pragma unroll
    for (int i = 0; i < 2; ++i) { int R, C; stage_rc(tid * 16 + i * 8192, R, C); const int Rb = Epi::PERM ? ((R & ~31) + perm32(R & 31)) : R;
        voffA[i] = (unsigned)(R * K + C) * 2u; voffB[i] = (unsigned)(Rb * K + C) * 2u; }
    const size_t kstep = (size_t)(BK * 2);
    const size_t hstep = (size_t)HALF * K * 2;
    const size_t tstep = 2 * hstep;
    const unsigned ldsw = (unsigned)wid * 1024u;
    const int aoff = lds_byte(wr * 64 + fr, fq * 8), boff = lds_byte(wc * 32 + fr, fq * 8);
#define PG8_SA(b, h) (((b) * 2 + (h)) * HTB)
#define PG8_SB(b, h) ((4 + (b) * 2 + (h)) * HTB)
#define PG8_STAGE(bufoff, gbase, voff) do { _Pragma("unroll") for (int _i = 0; _i < 2; ++_i) \
        __builtin_amdgcn_global_load_lds((const unsigned*)((const char*)(gbase) + (voff)[_i]), (PG8_LAS unsigned*)(lds + (bufoff) + ldsw + _i * 8192), 16, 0, 0); } while (0)
#define PG8_LDA(dst, b, h) do { _Pragma("unroll") for (int m = 0; m < 4; ++m) _Pragma("unroll") for (int k = 0; k < 2; ++k) dst[m][k] = *(const PG8_LAS bf16x8*)(lds + PG8_SA(b, h) + aoff + m * 2048 + k * 1024); } while (0)
#define PG8_LDB(dst, b, h) do { _Pragma("unroll") for (int n = 0; n < 2; ++n) _Pragma("unroll") for (int k = 0; k < 2; ++k) dst[n][k] = *(const PG8_LAS bf16x8*)(lds + PG8_SB(b, h) + boff + n * 2048 + k * 1024); } while (0)
#define PG8_MMA(ai, bj, At, Bt) do { __builtin_amdgcn_s_setprio(1); _Pragma("unroll") for (int m = 0; m < 4; ++m) _Pragma("unroll") for (int n = 0; n < 2; ++n) _Pragma("unroll") for (int k = 0; k < 2; ++k) \
        acc[ai][bj][m][n] = __builtin_amdgcn_mfma_f32_16x16x32_bf16(Bt[n][k], At[m][k], acc[ai][bj][m][n], 0, 0, 0); __builtin_amdgcn_s_setprio(0); } while (0)
#define PG8_WAIT_V(n) asm volatile("s_waitcnt vmcnt(" #n ")" ::: "memory")
#define PG8_WAIT_L(n) asm volatile("s_waitcnt lgkmcnt(" #n ")" ::: "memory")
#define PG8_BAR __builtin_amdgcn_s_barrier()
#define PG8_SCHED __builtin_amdgcn_sched_barrier(0)
    Unit cur, nxt; int ui = 0;
    if (!S.next(0, cur)) return;
    f32x4 acc[2][2][4][2];
#pragma unroll
    for (int a = 0; a < 2; ++a)
#pragma unroll
        for (int b = 0; b < 2; ++b)
#pragma unroll
            for (int m = 0; m < 4; ++m)
#pragma unroll
                for (int n = 0; n < 2; ++n) acc[a][b][m][n] = (f32x4){0.f, 0.f, 0.f, 0.f};
    bf16x8 At[4][2], B0[2][2], B1[2][2];
    const char* cA = (const char*)g.A + (size_t)cur.pm * tstep; const char* cB = (const char*)g.Bt + (size_t)cur.pn * tstep;
    S.a_ready(cur);
    if constexpr (SP2) {
        PG8_STAGE(PG8_SB(0, 0), cB, voffB); PG8_STAGE(PG8_SB(0, 1), cB + hstep, voffB); PG8_STAGE(PG8_SA(0, 0), cA, voffA); PG8_STAGE(PG8_SA(0, 1), cA + hstep, voffA);
        if (wr == 1) PG8_BAR;
        PG8_WAIT_V(2); PG8_BAR;
        PG8_STAGE(PG8_SB(1, 0), cB + kstep, voffB); PG8_STAGE(PG8_SA(1, 0), cA + kstep, voffA); PG8_STAGE(PG8_SB(1, 1), cB + hstep + kstep, voffB);
        PG8_WAIT_V(6); PG8_BAR;
    } else {
        PG8_STAGE(PG8_SB(0, 0), cB, voffB); PG8_STAGE(PG8_SA(0, 0), cA, voffA); PG8_STAGE(PG8_SB(0, 1), cB + hstep, voffB); PG8_STAGE(PG8_SA(0, 1), cA + hstep, voffA);
        if (wr == 1) PG8_BAR;
        PG8_WAIT_V(4); PG8_BAR;
        PG8_STAGE(PG8_SB(1, 0), cB + kstep, voffB); PG8_STAGE(PG8_SA(1, 0), cA + kstep, voffA); PG8_STAGE(PG8_SB(1, 1), cB + hstep + kstep, voffB);
        PG8_WAIT_V(6); PG8_BAR;
    }
    for (;;) {
        const bool has_next = S.next(ui + 1, nxt);
        const char* nA = has_next ? (const char*)g.A + (size_t)nxt.pm * tstep : cA; const char* nB = has_next ? (const char*)g.Bt + (size_t)nxt.pn * tstep : cB;
        for (int t = 0; t < nt; t += 2) {
            const bool last = (t == nt - 2);
            const char* a1 = cA + (size_t)(t + 1) * kstep;
            const char* a2 = last ? nA : cA + (size_t)(t + 2) * kstep; const char* b2 = last ? nB : cB + (size_t)(t + 2) * kstep;
            const char* a3 = a2 + kstep; const char* b3 = b2 + kstep;
            if (last && has_next) S.a_ready(nxt);
            if constexpr (SP2) {
            PG8_LDB(B0, 0, 0); PG8_LDB(B1, 0, 1); PG8_SCHED; PG8_LDA(At, 0, 0); PG8_STAGE(PG8_SA(1, 1), a1 + hstep, voffA);
            PG8_WAIT_V(8); PG8_WAIT_L(0); PG8_BAR; PG8_MMA(0, 0, At, B0); PG8_MMA(0, 1, At, B1); PG8_BAR; PG8_SCHED;
            PG8_LDA(At, 0, 1); PG8_STAGE(PG8_SB(0, 0), b2, voffB); PG8_STAGE(PG8_SB(0, 1), b2 + hstep, voffB); PG8_STAGE(PG8_SA(0, 0), a2, voffA);
            PG8_WAIT_V(8); PG8_WAIT_L(0); PG8_BAR; PG8_MMA(1, 0, At, B0); PG8_MMA(1, 1, At, B1); PG8_BAR; PG8_SCHED;
            PG8_LDB(B0, 1, 0); PG8_LDB(B1, 1, 1); PG8_SCHED; PG8_LDA(At, 1, 0); PG8_STAGE(PG8_SA(0, 1), a2 + hstep, voffA);
            PG8_WAIT_V(8); PG8_WAIT_L(0); PG8_BAR; PG8_MMA(0, 0, At, B0); PG8_MMA(0, 1, At, B1); PG8_BAR; PG8_SCHED;
            PG8_LDA(At, 1, 1); PG8_STAGE(PG8_SB(1, 0), b3, voffB); PG8_STAGE(PG8_SB(1, 1), b3 + hstep, voffB); PG8_STAGE(PG8_SA(1, 0), a3, voffA);
            PG8_WAIT_V(8); PG8_WAIT_L(0); PG8_BAR; PG8_MMA(1, 0, At, B0); PG8_MMA(1, 1, At, B1); PG8_BAR; PG8_SCHED;
            } else {
            PG8_LDB(B0, 0, 0); PG8_SCHED; PG8_LDA(At, 0, 0); PG8_STAGE(PG8_SA(1, 1), a1 + hstep, voffA);
            PG8_WAIT_L(8); PG8_BAR; PG8_WAIT_L(0); PG8_MMA(0, 0, At, B0); PG8_BAR; PG8_SCHED;
            PG8_LDB(B1, 0, 1); PG8_STAGE(PG8_SB(0, 0), b2, voffB);
            PG8_BAR; PG8_WAIT_L(0); PG8_MMA(0, 1, At, B1); PG8_BAR;
            PG8_LDA(At, 0, 1); PG8_STAGE(PG8_SA(0, 0), a2, voffA);
            PG8_BAR; PG8_WAIT_L(0); PG8_MMA(1, 0, At, B0); PG8_BAR; PG8_SCHED;
            PG8_STAGE(PG8_SB(0, 1), b2 + hstep, voffB);
            PG8_WAIT_V(6); PG8_BAR; PG8_MMA(1, 1, At, B1); PG8_BAR;
            PG8_LDB(B0, 1, 0); PG8_SCHED; PG8_LDA(At, 1, 0); PG8_STAGE(PG8_SA(0, 1), a2 + hstep, voffA);
            PG8_WAIT_L(8); PG8_BAR; PG8_WAIT_L(0); PG8_MMA(0, 0, At, B0); PG8_BAR; PG8_SCHED;
            PG8_LDB(B1, 1, 1); PG8_STAGE(PG8_SB(1, 0), b3, voffB);
            PG8_BAR; PG8_WAIT_L(0); PG8_MMA(0, 1, At, B1); PG8_BAR;
            PG8_LDA(At, 1, 1); PG8_STAGE(PG8_SA(1, 0), a3, voffA);
            PG8_BAR; PG8_WAIT_L(0); PG8_MMA(1, 0, At, B0); PG8_BAR; PG8_SCHED;
            PG8_STAGE(PG8_SB(1, 1), b3 + hstep, voffB);
            PG8_WAIT_V(6); PG8_BAR; PG8_MMA(1, 1, At, B1); PG8_BAR;
            }
        }
        if constexpr (ALIGN_EPI) { if (wr == 0) PG8_BAR; }
        if constexpr (!Epi::AFTER_DRAIN) { E(acc, cur, wr, wc, fr, fq); S.done(cur); }
        if (!has_next) break;
#pragma unroll
        for (int a = 0; a < 2; ++a)
#pragma unroll
            for (int b = 0; b < 2; ++b)
#pragma unroll
                for (int m = 0; m < 4; ++m)
#pragma unroll
                    for (int n = 0; n < 2; ++n) acc[a][b][m][n] = (f32x4){0.f, 0.f, 0.f, 0.f};
        cur = nxt; cA = nA; cB = nB; ++ui;
        if constexpr (ALIGN_EPI) { if (wr == 1) PG8_BAR; }
    }
    PG8_WAIT_V(0);
    if constexpr (!ALIGN_EPI) { if (wr == 0) PG8_BAR; }
    PG8_BAR;
    if constexpr (Epi::AFTER_DRAIN) { E.fused(acc, cur, wr, wc, fr, fq, lds, wid, lane); S.done(cur); }
#undef PG8_SA
#undef PG8_SB
#undef PG8_STAGE
#undef PG8_LDA
#undef PG8_LDB
#undef PG8_MMA
#undef PG8_WAIT_V
#undef PG8_WAIT_L
#undef PG8_BAR
#undef PG8_SCHED
}
}
namespace pg8 {
struct EpiSwiGLU {
    static constexpr bool PERM = true, AFTER_DRAIN = false;
    bf16_t* O; int ldc;
    static __device__ __forceinline__ float silu_mul(float g, float u) { const float e = __builtin_amdgcn_exp2f(-1.4426950408889634f * g); return g * __builtin_amdgcn_rcpf(1.0f + e) * u; }
    __device__ __forceinline__ void operator()(const f32x4 (&acc)[2][2][4][2], const Unit& u, int wr, int wc, int fr, int fq) const {
        const int row0 = u.pm * BM + wr * 64 + fr, col0 = u.pn * HALF + wc * 32 + 8 * fq;
#pragma unroll
        for (int ai = 0; ai < 2; ++ai)
#pragma unroll
            for (int m = 0; m < 4; ++m) { bf16_t* rowp = O + (size_t)(row0 + ai * HALF + m * 16) * ldc + col0;
                const f32x4 g0 = acc[ai][0][m][0], g1 = acc[ai][0][m][1], u0 = acc[ai][1][m][0], u1 = acc[ai][1][m][1];
                u32x4 w; w.x = cvt_pk_bf16(silu_mul(g0[0], u0[0]), silu_mul(g0[1], u0[1])); w.y = cvt_pk_bf16(silu_mul(g0[2], u0[2]), silu_mul(g0[3], u0[3]));
                w.z = cvt_pk_bf16(silu_mul(g1[0], u1[0]), silu_mul(g1[1], u1[1])); w.w = cvt_pk_bf16(silu_mul(g1[2], u1[2]), silu_mul(g1[3], u1[3]));
                *(u32x4*)rowp = w; }
    }
};
struct EpiQKV {
    static constexpr bool PERM = true, AFTER_DRAIN = false;
    bf16_t* Q; size_t buf_stride; const float* rope; float scale0;
    __device__ __forceinline__ void operator()(const f32x4 (&acc)[2][2][4][2], const Unit& u, int wr, int wc, int fr, int fq) const {
        const int t = u.pn >> 2; bf16_t* base = Q + (size_t)t * buf_stride; const float sc = (t == 0) ? scale0 : 1.f;
        const int col0 = (u.pn & 3) * BM + wc * 32 + 8 * fq;
        const bool rot = (t < 2) && ((wc & 1) == 0);
        const float sgn = (fq == 0) ? -1.f : 1.f;
#pragma unroll
        for (int ai = 0; ai < 2; ++ai)
#pragma unroll
            for (int m = 0; m < 4; ++m) { const int r = ai * HALF + wr * 64 + m * 16 + fr; int orow, pos; bool valid = true;
                if (u.pm < 64) { orow = (u.pm >> 3) * 2112 + 64 + (u.pm & 7) * 256 + r; pos = 16 + (u.pm & 7) * 256 + r; }
                else { valid = r < 128; orow = (r >> 4) * 2112 + 48 + (r & 15); pos = r & 15; }
                f32x4 cs0 = {1.f, 1.f, 1.f, 1.f}, cs1 = cs0, sn0 = {0.f, 0.f, 0.f, 0.f}, sn1 = sn0;
                if (rot && fq < 2) { const f32x4* rp = (const f32x4*)(rope + (size_t)pos * 16); cs0 = rp[0]; cs1 = rp[1]; sn0 = rp[2]; sn1 = rp[3]; }
#pragma unroll
                for (int bj = 0; bj < 2; ++bj) { f32x4 v0 = acc[ai][bj][m][0], v1 = acc[ai][bj][m][1];
                    if (rot) { f32x4 o0, o1;
#pragma unroll
                        for (int i = 0; i < 4; ++i) { o0[i] = __shfl_xor(v0[i], 16); o1[i] = __shfl_xor(v1[i], 16); }
                        v0 = v0 * cs0 + (o0 * sn0) * sgn; v1 = v1 * cs1 + (o1 * sn1) * sgn; }
                    v0 = v0 * sc; v1 = v1 * sc; u32x4 w; w.x = cvt_pk_bf16(v0[0], v0[1]); w.y = cvt_pk_bf16(v0[2], v0[3]); w.z = cvt_pk_bf16(v1[0], v1[1]); w.w = cvt_pk_bf16(v1[2], v1[3]);
                    if (valid) *(u32x4*)(base + (size_t)orow * 1024 + col0 + bj * HALF) = w; } }
    }
};
}
#include <hip/hip_bf16.h>
#include <cmath>
namespace attn_body {
using bf16=__hip_bfloat16;
using bf16x8=__attribute__((ext_vector_type(8)))short;
using s16x4=__attribute__((ext_vector_type(4)))short;
using f32x16=__attribute__((ext_vector_type(16)))float;
using u32x4=__attribute__((ext_vector_type(4)))unsigned;
constexpr int D=64,DM=1024,OPITCH=2048,BSTRIDE=2112,FRONT=48,RVEND=2112;
constexpr int NW=8,QBLK=32,QB=QBLK*NW,KVBLK=64,NQB=9;
constexpr int ATTN_PITCH=DM, ATTN_UNIT_ROWS=QB;
__device__ __forceinline__ int crow(int r,int hi){return (r&3)+8*(r>>2)+4*hi;}
#define SBAR() __builtin_amdgcn_sched_barrier(0)
__device__ __forceinline__ void cmask(f32x16&p0,f32x16&p1,int jb,int qrel,int hi){
  const float NEG=-INFINITY; int kb=64*jb+4*hi;
  #pragma unroll
  for(int r=0;r<16;++r){int kv=kb+(r&3)+8*(r>>2); if(kv>qrel)p0[r]=NEG; if(kv+32>qrel)p1[r]=NEG;}
}

constexpr int NSLOT=3, SLOTB=8192;
constexpr int LDS_K=0, LDS_V=NSLOT*SLOTB, LDS_WS=3*NSLOT*SLOTB, LDS_OST=LDS_WS+NW*64*4, LDS_BYTES=LDS_OST+NW*4096;
constexpr float C2=0.125f*1.4426950408889634f;
__device__ __forceinline__ void glds16(const void*gsrc,unsigned lds_dst){unsigned keep;
  asm volatile("s_mov_b32 %0, m0\n\ts_mov_b32 m0, %2\n\ts_nop 0\n\tglobal_load_lds_dwordx4 %1, off\n\ts_mov_b32 m0, %0":"=&s"(keep):"v"(gsrc),"s"(lds_dst):"memory");}
__device__ __forceinline__ float max3f(float a,float b,float c){float r;asm("v_max3_f32 %0, %1, %2, %3":"=v"(r):"v"(a),"v"(b),"v"(c));return r;}
__device__ __forceinline__ float max2f(float a,float b){float r;asm("v_max_f32_e32 %0, %1, %2":"=v"(r):"v"(a),"v"(b));return r;}
__device__ __forceinline__ float fadd_s(float a,float b){float r;asm("v_add_f32_e32 %0, %1, %2":"=v"(r):"v"(a),"v"(b));return r;}
__device__ __forceinline__ float fsub_s(float a,float b){float r;asm("v_sub_f32_e32 %0, %1, %2":"=v"(r):"v"(a),"v"(b));return r;}
typedef float f32x2_t __attribute__((ext_vector_type(2))); typedef __bf16 bf16x2_t __attribute__((ext_vector_type(2)));
__device__ __forceinline__ unsigned cvtpk_s(float lo,float hi){f32x2_t v={lo,hi};bf16x2_t b=__builtin_convertvector(v,bf16x2_t);return __builtin_bit_cast(unsigned,b);}
#define WAIT_BAR(N) asm volatile("s_waitcnt vmcnt(" #N ") lgkmcnt(0)\n\ts_barrier":::"memory")

__device__ __forceinline__ void qkt(f32x16&p0,f32x16&p1,const char*Kslot,const bf16x8*qr,const f32x16&negm,int r32,int hi){
  const char*kb=Kslot+hi*1024+r32*16;
  #pragma unroll
  for(int d0=0;d0<4;++d0){
    const bf16x8 b0=*reinterpret_cast<const bf16x8*>(kb+d0*2048);
    const bf16x8 b1=*reinterpret_cast<const bf16x8*>(kb+d0*2048+512);
    if(d0==0){p0=__builtin_amdgcn_mfma_f32_32x32x16_bf16(b0,qr[0],negm,0,0,0);p1=__builtin_amdgcn_mfma_f32_32x32x16_bf16(b1,qr[0],negm,0,0,0);}
    else{p0=__builtin_amdgcn_mfma_f32_32x32x16_bf16(b0,qr[d0],p0,0,0,0);p1=__builtin_amdgcn_mfma_f32_32x32x16_bf16(b1,qr[d0],p1,0,0,0);}}
}
typedef __attribute__((address_space(3))) const char* lds_cptr;
typedef short v4i16_t __attribute__((ext_vector_type(4)));
__device__ __forceinline__ void kload8(bf16x8*kf,lds_cptr kp){
  kf[0]=*(const __attribute__((address_space(3))) bf16x8*)(kp);      kf[1]=*(const __attribute__((address_space(3))) bf16x8*)(kp+512);
  kf[2]=*(const __attribute__((address_space(3))) bf16x8*)(kp+2048); kf[3]=*(const __attribute__((address_space(3))) bf16x8*)(kp+2560);
  kf[4]=*(const __attribute__((address_space(3))) bf16x8*)(kp+4096); kf[5]=*(const __attribute__((address_space(3))) bf16x8*)(kp+4608);
  kf[6]=*(const __attribute__((address_space(3))) bf16x8*)(kp+6144); kf[7]=*(const __attribute__((address_space(3))) bf16x8*)(kp+6656);
}
__device__ __forceinline__ void kload2(bf16x8*kf,lds_cptr kp,int j){ kf[2*j]=*(const __attribute__((address_space(3))) bf16x8*)(kp+j*2048); kf[2*j+1]=*(const __attribute__((address_space(3))) bf16x8*)(kp+j*2048+512); }
__device__ __forceinline__ s16x4 vtr(lds_cptr p){ return __builtin_bit_cast(s16x4,__builtin_amdgcn_ds_read_tr16_b64_v4i16((__attribute__((address_space(3))) v4i16_t*)p)); }
__device__ __forceinline__ float rowmax(const f32x16&p0,const f32x16&p1){
  float a=max3f(p0[0],p0[1],p1[0]),b=max3f(p0[2],p0[3],p1[1]);a=max3f(a,p1[2],p1[3]);
  #pragma unroll
  for(int r=4;r<16;r+=4){a=max3f(a,p0[r],p0[r+1]);b=max3f(b,p0[r+2],p0[r+3]);a=max3f(a,p1[r],p1[r+1]);b=max3f(b,p1[r+2],p1[r+3]);}
  const float m=max2f(a,b);
  auto rr=__builtin_amdgcn_permlane32_swap(__float_as_uint(m),__float_as_uint(m),false,false);
  return max2f(__uint_as_float(rr[0]),__uint_as_float(rr[1]));
}
__device__ __forceinline__ void pv(f32x16*o,int vb,bf16x8 pa0,bf16x8 pa1,bf16x8 pa2,bf16x8 pa3){
  #pragma unroll
  for(int d0=0;d0<2;++d0){s16x4 lo[4],hi[4];
    #pragma unroll
    for(int ks=0;ks<4;++ks){
      asm volatile("ds_read_b64_tr_b16 %0,%1 offset:%c2":"=&v"(lo[ks]):"v"(vb),"i"(d0*4096+ks*1024):"memory");
      asm volatile("ds_read_b64_tr_b16 %0,%1 offset:%c2":"=&v"(hi[ks]):"v"(vb),"i"(d0*4096+ks*1024+512):"memory");}
    asm volatile("s_waitcnt lgkmcnt(0)":::"memory");SBAR();
    #define PK(k) (bf16x8){lo[k][0],lo[k][1],lo[k][2],lo[k][3],hi[k][0],hi[k][1],hi[k][2],hi[k][3]}
    o[d0]=__builtin_amdgcn_mfma_f32_32x32x16_bf16(pa0,PK(0),o[d0],0,0,0);
    o[d0]=__builtin_amdgcn_mfma_f32_32x32x16_bf16(pa1,PK(1),o[d0],0,0,0);
    o[d0]=__builtin_amdgcn_mfma_f32_32x32x16_bf16(pa2,PK(2),o[d0],0,0,0);
    o[d0]=__builtin_amdgcn_mfma_f32_32x32x16_bf16(pa3,PK(3),o[d0],0,0,0);
    #undef PK
  }
}

#ifndef ATTN_STORE16
#define ATTN_STORE16(p,v) (*(u32x4*)(p)=(v))
#endif
template<int THRL,bool ODD> __device__ __forceinline__ void attn_unit(int b,int cq,int cv,int co,int q0,const bf16*Q,const bf16*__restrict__ K,const bf16*__restrict__ V,bf16*O,char*shm){
  const int tid=opaque_tid(),lane=tid&63,r32=lane&31,hi=lane>>5; const int wid=__builtin_amdgcn_readfirstlane(tid>>6);
  const long rowbase=(long)b*BSTRIDE;
  const bf16*Qw=Q+(rowbase+q0+wid*QBLK)*DM+cq;
  const bf16*Kh=K+rowbase*DM+cq,*Vh=V+rowbase*DM+cv;
  const unsigned lds0=(unsigned)(uintptr_t)shm;
  float*wsf=(float*)(shm+LDS_WS)+wid*64;
  const bf16*ksrc=Kh+(long)lane*DM+wid*8;
  const bf16*vsrc=Vh+(long)(16*(wid&3)+(lane>>2))*DM+(wid>>2)*32+(lane&3)*8;
  const unsigned kdst=lds0+LDS_K+wid*1024, vdst=lds0+LDS_V+wid*1024;
  #define DMA_K(t,slot) glds16(ksrc+(long)(t)*KVBLK*DM,(unsigned)__builtin_amdgcn_readfirstlane(kdst+(slot)))
  #define DMA_V(t,slot) do{ glds16(vsrc+(long)(t)*KVBLK*DM,(unsigned)__builtin_amdgcn_readfirstlane(vdst+2*(slot))); glds16(vsrc+(long)(t)*KVBLK*DM+64,(unsigned)__builtin_amdgcn_readfirstlane(vdst+2*(slot)+SLOTB)); }while(0)
  const int vb0=(int)(lds0+LDS_V)+((lane>>4)&1)*32+(lane&3)*8+(4*hi+((lane&15)>>2))*64;
  const char*Kbase=shm+LDS_K; bf16x8 kf[8];
  const lds_cptr shm3=(lds_cptr)shm; const lds_cptr kp0=shm3+LDS_K+hi*1024+r32*16; const lds_cptr vp0=shm3+LDS_V+((lane>>4)&1)*32+(lane&3)*8+(4*hi+((lane&15)>>2))*64;
  const int NT=(q0+QB)/KVBLK;
  DMA_K(0,0);DMA_V(0,0);DMA_K(1,SLOTB);
  bf16x8 qr[4];
  #pragma unroll
  for(int d0=0;d0<4;++d0)qr[d0]=*reinterpret_cast<const bf16x8*>(&Qw[(long)r32*DM+d0*16+hi*8]);
  float mhat=0.f,l_reg=0.f;f32x16 o[4];o[0]=f32x16{};o[1]=f32x16{};o[2]=f32x16{};o[3]=f32x16{};const f32x16 zero16=f32x16{};
  const int qrel=wid*QBLK+r32;
  #define CMASK(P0,P1,t) do{int jb_=(t)-(NT-4); if(jb_>=0)cmask(P0,P1,jb_,qrel,hi);}while(0)
  #define CM1(P0,P1,t,r) do{int jb_=(t)-(NT-4); if(jb_>=0){ const int kv_=64*jb_+4*hi+((r)&3)+8*((r)>>2); if(kv_>qrel)P0[r]=-INFINITY; if(kv_+32>qrel)P1[r]=-INFINITY; } }while(0)
  bool resc=false;
  #define START(P0,P1) do{ const float rm=rowmax(P0,P1); resc=false; \
    { const float dl=rm; mhat=fadd_s(mhat,dl); \
      _Pragma("unroll") for(int r=0;r<16;++r){P0[r]=fsub_s(P0[r],dl);P1[r]=fsub_s(P1[r],dl);} \
      } \
    _Pragma("unroll") for(int r=0;r<16;++r)P0[r]=__builtin_amdgcn_exp2f(P0[r]); }while(0)
  #define RESC() do{ if(resc){ asm volatile("s_waitcnt lgkmcnt(0)":::"memory"); \
      _Pragma("unroll") for(int d_=0;d_<4;++d_) _Pragma("unroll") for(int r=0;r<16;++r)o[d_][r]*=wsf[crow(r,hi)]; } }while(0)
  f32x16 pA0,pA1,pB0,pB1;
  int sl_prev=0,sl_cur=0,sl_next=SLOTB;
  #define ROT() do{sl_prev=sl_cur;sl_cur=sl_next;sl_next=(sl_next==(NSLOT-1)*SLOTB)?0:sl_next+SLOTB;}while(0)
  DMA_K(2,2*SLOTB);
  WAIT_BAR(3);
  qkt(pA0,pA1,Kbase,qr,zero16,r32,hi);asm volatile("s_nop 15\n\ts_nop 7":"+v"(pA0),"+v"(pA1));CMASK(pA0,pA1,0);
  if(q0+qrel>=FRONT){ _Pragma("unroll") for(int r=0;r<16;++r)pA0[r]=-INFINITY; _Pragma("unroll") for(int r=0;r<8;++r)pA1[r]=-INFINITY; }
  START(pA0,pA1);
  _Pragma("unroll") for(int r=0;r<16;++r)pA1[r]=__builtin_amdgcn_exp2f(pA1[r]);
  WAIT_BAR(0);
  DMA_K(3,0);DMA_V(1,SLOTB);
  ROT();
  kload8(kf,kp0+sl_cur);
  WAIT_BAR(3);
  s16x4 vlo[8],vhi[8]; u32x4 pw0,pw1,pw2,pw3;
  #define PKW(P,B) cvtpk_s(P[B],P[B+1])
  #define PAF(k) __builtin_bit_cast(bf16x8,pw##k)
  #define PIN(x) asm volatile("":"+v"(x))
  #define MX3(a,b,c) __builtin_fmaxf(__builtin_fmaxf((a),(b)),(c))
  #define GAPA(MF,A0,A1,A2,A3,W0,W1,PW) do{ MF; sacc+=A0; sacc+=A1; sacc+=A2; sacc+=A3; PIN(sacc); W0; W1; PIN(PW); SBAR(); }while(0)
  #define EX(v) __builtin_amdgcn_exp2f(v)
  #define GAPS(MF,X0,X1,t,R) do{ MF; X0[R]-=mhat; X0[(R)+1]-=mhat; X1[R]-=mhat; X1[(R)+1]-=mhat; CM1(X0,X1,t,R); CM1(X0,X1,t,(R)+1); mxa=MX3(mxa,X0[R],X0[(R)+1]); mxb=MX3(mxb,X1[R],X1[(R)+1]); PIN(mxa); PIN(mxb); SBAR(); }while(0)
  #define GAPB(MF,X,B) do{ MF; X[B]=EX(X[B]); X[B+1]=EX(X[B+1]); X[B+2]=EX(X[B+2]); X[B+3]=EX(X[B+3]); PIN(X); SBAR(); }while(0)
  #define VRD(i,hf) do{ vlo[(i)&7]=vtr(vp_+((hf)*8192+((i)>>2)*4096+((i)&3)*1024)); vhi[(i)&7]=vtr(vp_+((hf)*8192+((i)>>2)*4096+((i)&3)*1024+512)); }while(0)
  #define KRD(G,j) do{ if(G){ kload2(kf,kp0+sl_next,j); SBAR(); } }while(0)
  #define VF4(i) (bf16x8){vlo[i][0],vlo[i][1],vlo[i][2],vlo[i][3],vhi[i][0],vhi[i][1],vhi[i][2],vhi[i][3]}
  #define STEP(C0,C1,P0,P1,t,GK,GV,GL) do{ SBAR(); \
      \
    if(GV){DMA_V((t)+1,sl_next);} if(GK){DMA_K((t)+3,sl_cur);} \
    const lds_cptr vp_=vp0+2*sl_prev; \
    float sacc=(P0[0]+P0[1]); \
    GAPA(C0=__builtin_amdgcn_mfma_f32_32x32x16_bf16(kf[0],qr[0],zero16,0,0,0), P0[2],P0[3],P0[4],P0[5],     pw0[0]=PKW(P0,0), pw0[1]=PKW(P0,2), pw0); \
    GAPA(C1=__builtin_amdgcn_mfma_f32_32x32x16_bf16(kf[1],qr[0],zero16,0,0,0), P0[6],P0[7],P0[8],P0[9],     pw0[2]=PKW(P0,4), pw0[3]=PKW(P0,6), pw0); \
    GAPA(C0=__builtin_amdgcn_mfma_f32_32x32x16_bf16(kf[2],qr[1],C0,0,0,0),   P0[10],P0[11],P0[12],P0[13], pw1[0]=PKW(P0,8), pw1[1]=PKW(P0,10), pw1); \
    GAPA(C1=__builtin_amdgcn_mfma_f32_32x32x16_bf16(kf[3],qr[1],C1,0,0,0),   P0[14],P0[15],P1[0],P1[1],   pw1[2]=PKW(P0,12),pw1[3]=PKW(P0,14), pw1); \
    GAPA(C0=__builtin_amdgcn_mfma_f32_32x32x16_bf16(kf[4],qr[2],C0,0,0,0),   P1[2],P1[3],P1[4],P1[5],     pw2[0]=PKW(P1,0), pw2[1]=PKW(P1,2), pw2); \
    GAPA(C1=__builtin_amdgcn_mfma_f32_32x32x16_bf16(kf[5],qr[2],C1,0,0,0),   P1[6],P1[7],P1[8],P1[9],     pw2[2]=PKW(P1,4), pw2[3]=PKW(P1,6), pw2); \
    GAPA(C0=__builtin_amdgcn_mfma_f32_32x32x16_bf16(kf[6],qr[3],C0,0,0,0),   P1[10],P1[11],P1[12],P1[13], pw3[0]=PKW(P1,8), pw3[1]=PKW(P1,10), pw3); \
    VRD(0,0); VRD(1,0); VRD(2,0); VRD(3,0); SBAR(); \
    GAPA(C1=__builtin_amdgcn_mfma_f32_32x32x16_bf16(kf[7],qr[3],C1,0,0,0),   P1[14],P1[15],0.f,0.f,       pw3[2]=PKW(P1,12),pw3[3]=PKW(P1,14), pw3); \
    l_reg+=sacc; \
      \
      \
    VRD(4,0); VRD(5,0); VRD(6,0); VRD(7,0); SBAR(); \
    float mxa=-INFINITY,mxb=-INFINITY; \
    GAPS(o[0]=__builtin_amdgcn_mfma_f32_32x32x16_bf16(PAF(0),VF4(0),o[0],0,0,0), C0,C1,t,0); \
    GAPS(o[0]=__builtin_amdgcn_mfma_f32_32x32x16_bf16(PAF(1),VF4(1),o[0],0,0,0), C0,C1,t,2); \
    GAPS(o[0]=__builtin_amdgcn_mfma_f32_32x32x16_bf16(PAF(2),VF4(2),o[0],0,0,0), C0,C1,t,4); \
    GAPS(o[0]=__builtin_amdgcn_mfma_f32_32x32x16_bf16(PAF(3),VF4(3),o[0],0,0,0), C0,C1,t,6); \
    VRD(0,1); VRD(1,1); VRD(2,1); VRD(3,1); KRD(GL,0); SBAR(); \
    GAPS(o[1]=__builtin_amdgcn_mfma_f32_32x32x16_bf16(PAF(0),VF4(4),o[1],0,0,0), C0,C1,t,8); \
    GAPS(o[1]=__builtin_amdgcn_mfma_f32_32x32x16_bf16(PAF(1),VF4(5),o[1],0,0,0), C0,C1,t,10); \
    GAPS(o[1]=__builtin_amdgcn_mfma_f32_32x32x16_bf16(PAF(2),VF4(6),o[1],0,0,0), C0,C1,t,12); \
    GAPS(o[1]=__builtin_amdgcn_mfma_f32_32x32x16_bf16(PAF(3),VF4(7),o[1],0,0,0), C0,C1,t,14); \
    { float rm=__builtin_fmaxf(mxa,mxb); { auto rr=__builtin_amdgcn_permlane32_swap(__float_as_uint(rm),__float_as_uint(rm),false,false); rm=__builtin_fmaxf(__uint_as_float(rr[0]),__uint_as_float(rr[1])); } \
      resc=false; \
      if(__builtin_expect(__any(rm>(float)THRL),0)){ const float dl=__builtin_fmaxf(rm,0.f); mhat+=dl; \
        _Pragma("unroll") for(int r=0;r<16;++r){C0[r]-=dl;C1[r]-=dl;} \
        const float f=__builtin_amdgcn_exp2f(-dl); l_reg*=f; if(hi==0)wsf[r32]=f; resc=true; } } \
    SBAR(); \
    VRD(4,1); VRD(5,1); VRD(6,1); VRD(7,1); KRD(GL,1); SBAR(); \
    GAPB(o[2]=__builtin_amdgcn_mfma_f32_32x32x16_bf16(PAF(0),VF4(0),o[2],0,0,0), C0,0); \
    GAPB(o[2]=__builtin_amdgcn_mfma_f32_32x32x16_bf16(PAF(1),VF4(1),o[2],0,0,0), C0,4); \
    GAPB(o[2]=__builtin_amdgcn_mfma_f32_32x32x16_bf16(PAF(2),VF4(2),o[2],0,0,0), C0,8); \
    GAPB(o[2]=__builtin_amdgcn_mfma_f32_32x32x16_bf16(PAF(3),VF4(3),o[2],0,0,0), C0,12); \
    KRD(GL,2); \
    GAPB(o[3]=__builtin_amdgcn_mfma_f32_32x32x16_bf16(PAF(0),VF4(4),o[3],0,0,0), C1,0); \
    GAPB(o[3]=__builtin_amdgcn_mfma_f32_32x32x16_bf16(PAF(1),VF4(5),o[3],0,0,0), C1,4); \
    KRD(GL,3); \
    GAPB(o[3]=__builtin_amdgcn_mfma_f32_32x32x16_bf16(PAF(2),VF4(6),o[3],0,0,0), C1,8); \
    GAPB(o[3]=__builtin_amdgcn_mfma_f32_32x32x16_bf16(PAF(3),VF4(7),o[3],0,0,0), C1,12); \
    }while(0)
  int t=1;
  #undef CMASK
  #define CMASK(P0,P1,t) do{}while(0)
  #undef CM1
  #define CM1(P0,P1,t,r) do{}while(0)
  for(;t+5<NT;t+=2){
    STEP(pB0,pB1,pA0,pA1,t,true,true,true);     WAIT_BAR(3); RESC(); ROT();
    STEP(pA0,pA1,pB0,pB1,t+1,true,true,true);   WAIT_BAR(3); RESC(); ROT();
  }
  #undef CMASK
  #define CMASK(P0,P1,t) do{int jb_=(t)-(NT-4); if(jb_>=0)cmask(P0,P1,jb_,qrel,hi);}while(0)
  #undef CM1
  #define CM1(P0,P1,t,r) do{int jb_=(t)-(NT-4); if(jb_>=0){ const int kv_=64*jb_+4*hi+((r)&3)+8*((r)>>2); if(kv_>qrel)P0[r]=-INFINITY; if(kv_+32>qrel)P1[r]=-INFINITY; } }while(0)
  #define ENDW(tt) do{ if((tt)+3<NT){WAIT_BAR(3);} else if((tt)+2<NT){WAIT_BAR(2);} else {WAIT_BAR(0);} }while(0)
  for(;t+1<NT;t+=2){
    STEP(pB0,pB1,pA0,pA1,t,(t+3<NT),(t+1<NT),(t+1<NT));       ENDW(t);   RESC(); ROT();
    STEP(pA0,pA1,pB0,pB1,t+1,(t+4<NT),(t+2<NT),(t+2<NT));     ENDW(t+1); RESC(); ROT();
  }
  #define DRAIN(Q0,Q1,SL) do{ float sacc=Q0[0]+Q0[1]; _Pragma("unroll") for(int r=2;r<16;++r)sacc+=Q0[r]; _Pragma("unroll") for(int r=0;r<16;++r)sacc+=Q1[r]; l_reg+=sacc; \
    pw0=(u32x4){PKW(Q0,0),PKW(Q0,2),PKW(Q0,4),PKW(Q0,6)};pw1=(u32x4){PKW(Q0,8),PKW(Q0,10),PKW(Q0,12),PKW(Q0,14)};pw2=(u32x4){PKW(Q1,0),PKW(Q1,2),PKW(Q1,4),PKW(Q1,6)};pw3=(u32x4){PKW(Q1,8),PKW(Q1,10),PKW(Q1,12),PKW(Q1,14)}; \
    SBAR(); pv(o,vb0+2*(SL),PAF(0),PAF(1),PAF(2),PAF(3)); pv(o+2,vb0+2*(SL)+SLOTB,PAF(0),PAF(1),PAF(2),PAF(3)); }while(0)
  if constexpr(ODD){ DRAIN(pA0,pA1,sl_prev); }
  else{ STEP(pB0,pB1,pA0,pA1,NT-1,false,false,false); RESC(); DRAIN(pB0,pB1,sl_cur); }
  #undef DRAIN
  #undef PKW
  #undef PAF
  #undef VF4
  #undef PIN
  #undef MX3
  #undef GAPA
  #undef GAPB
  #undef GAPS
  #undef EX
  #undef VRD
  #undef KRD
  #undef STEP
  #undef ENDW
  {auto rr=__builtin_amdgcn_permlane32_swap(__float_as_uint(l_reg),__float_as_uint(l_reg),false,false);l_reg=__uint_as_float(rr[0])+__uint_as_float(rr[1]);}
  if(hi==0)wsf[32+r32]=l_reg;asm volatile("s_waitcnt lgkmcnt(0)":::"memory");
  float rli[16];
  #pragma unroll
  for(int r=0;r<16;++r)rli[r]=__builtin_amdgcn_rcpf(wsf[32+crow(r,hi)]);
  bf16*Ow=O+co;
  { bf16*stg=(bf16*)(shm+LDS_OST)+wid*2048;
    #pragma unroll
    for(int hf=0;hf<2;++hf){
    #pragma unroll
    for(int r=0;r<16;++r){const int orow=crow(r,hi);
      #pragma unroll
      for(int d0=0;d0<2;++d0)stg[orow*64+d0*32+r32]=__float2bfloat16(o[2*hf+d0][r]*rli[r]);}
    asm volatile("s_waitcnt lgkmcnt(0)":::"memory");
    #pragma unroll
    for(int i=0;i<4;++i){const int row=i*8+(lane>>3),ch=lane&7; const u32x4 v=*(const u32x4*)(stg+row*64+ch*8); const int rel=q0+wid*QBLK+row; const long m=(rel>=64)?(long)b*2048+(rel-64):16384L+16*b+(rel-FRONT); if(rel>=FRONT&&rel<RVEND&&(q0!=0||rel<64))ATTN_STORE16(Ow+m*DM+hf*64+ch*8,v);}
    asm volatile("s_waitcnt lgkmcnt(0)":::"memory"); } }
  asm volatile("s_waitcnt lgkmcnt(0)\n\ts_barrier":::"memory");
  #undef DMA_K
  #undef DMA_V
  #undef CMASK
  #undef CM1
  #undef START
  #undef RESC
  #undef ROT
}
constexpr int ATTN_LDS_BYTES=LDS_BYTES;
struct AttnTensors { const bf16* Q; const bf16* K; const bf16* V; bf16* O; bf16* O1; };
template<int THRL=8> __device__ __forceinline__ void attn_phase(char*lds,const AttnTensors&T,int vcu,int G){
  for(int w=vcu;w<256;w+=G){ const int item=w>>1,half=w&1,b=item>>4,hc=item&15,h=hc>>1,c=hc&1;
    const int n=half?4:5;
    for(int i=0;i<n;++i){ const int j=half?((i==0)?6:(i==1)?5:(i==2)?3:1):((i==0)?7:(i==1)?4:(i==2)?2:(i==3)?0:-1);
      if(j<0) attn_unit<THRL,false>(b,(2*h+c)*64,h*128,h*128,0,T.Q,T.K,T.V,c?T.O1:T.O,lds);
      else attn_unit<THRL,true>(b,(2*h+c)*64,h*128,h*128,64+256*j,T.Q,T.K,T.V,c?T.O1:T.O,lds); } }
}
#undef SBAR
#undef WAIT_BAR
}
#include <hip/hip_cooperative_groups.h>
namespace cg = cooperative_groups;
constexpr int NWAVES = 8;
constexpr int DM_ = 1024, DFF = 2816, NGU = 2 * DFF, NB = 8, SEQL = 2048, NMETA = 16, DEPTH_ = 4;
constexpr int MREAL = NB * SEQL;
constexpr int MVALID = MREAL + NB * NMETA;
constexpr int MPAD = 16640;
constexpr int QROWS = NB * 2112 + 256;
constexpr size_t MiB = 1u << 20;
constexpr size_t WS_ROPE = 1 * MiB;
constexpr size_t WS_HMETA = 1 * MiB + 512 * 1024;
constexpr size_t WS_W = 2 * MiB;
constexpr size_t W_GU_E = (size_t)NGU * DM_, W_DN_E = (size_t)DM_ * DFF, W_FFN_E = W_GU_E + W_DN_E;
constexpr size_t W_IN_E = (size_t)3 * DM_ * DM_, W_OUT_E = (size_t)DM_ * DM_, W_MIX_E = W_IN_E + W_OUT_E;
constexpr size_t W_TOTAL_E = 8 * W_FFN_E + 4 * W_MIX_E;
constexpr size_t WS_XN = 168 * MiB;
constexpr size_t WS_F = 201 * MiB;
constexpr size_t WS_BIG = 236 * MiB;
constexpr size_t WS_END = 338 * MiB;
static_assert(WS_W + W_TOTAL_E * 2 <= WS_XN && WS_XN + (size_t)MPAD * 1024 * 2 <= WS_F && WS_F + (size_t)MPAD * 1024 * 2 <= WS_BIG, "ws map");
static_assert(WS_XN + (size_t)QROWS * 2048 * 2 <= WS_BIG && WS_BIG + (size_t)MPAD * 3072 * 2 <= WS_END && WS_BIG + (size_t)3 * QROWS * 1024 * 2 <= WS_END, "ws map 2");
constexpr int RING_BYTES = 131072, LDS_BYTES = 147456;

#define GAS __attribute__((address_space(1)))
#define LAS __attribute__((address_space(3)))
typedef unsigned short bf16;
typedef unsigned v4u __attribute__((ext_vector_type(4)));
typedef float f32x4 __attribute__((ext_vector_type(4)));
#define LDS_WAIT() asm volatile("s_waitcnt lgkmcnt(0)" ::: "memory")
__device__ __forceinline__ unsigned f2bf(float f) { unsigned u = __builtin_bit_cast(unsigned, f); return (u + 0x7fffu + ((u >> 16) & 1u)) >> 16; }
__device__ __forceinline__ unsigned pk2(float lo, float hi) { typedef float f32x2p __attribute__((ext_vector_type(2))); typedef __bf16 bf16x2p __attribute__((ext_vector_type(2))); f32x2p v = {lo, hi}; bf16x2p b = __builtin_convertvector(v, bf16x2p); return __builtin_bit_cast(unsigned, b); }
__device__ __forceinline__ float bflo(unsigned w) { return __builtin_bit_cast(float, w << 16); }
__device__ __forceinline__ float bfhi(unsigned w) { return __builtin_bit_cast(float, w & 0xffff0000u); }
__device__ __forceinline__ float wave_sum(float v) {
#define WS_DPP(x, ctrl) __builtin_bit_cast(float, __builtin_amdgcn_update_dpp(0, __builtin_bit_cast(int, (x)), (ctrl), 0xF, 0xF, true))
    v += WS_DPP(v, 0xB1);
    v += WS_DPP(v, 0x4E);
    v += WS_DPP(v, 0x141);
    v += WS_DPP(v, 0x140);
#undef WS_DPP
    const int b_ = __builtin_bit_cast(int, v);
    const float r0 = __builtin_bit_cast(float, __builtin_amdgcn_readlane(b_, 0)), r1 = __builtin_bit_cast(float, __builtin_amdgcn_readlane(b_, 16));
    const float r2 = __builtin_bit_cast(float, __builtin_amdgcn_readlane(b_, 32)), r3 = __builtin_bit_cast(float, __builtin_amdgcn_readlane(b_, 48));
    return (r0 + r1) + (r2 + r3);
}
#define RLX_AGENT __ATOMIC_RELAXED, __HIP_MEMORY_SCOPE_AGENT
#define XB_TMO      128
#define XB_XCNT(j)  (256  + 64 * (j))
#define XB_XSUB(j)  (1280 + 64 * (j))
#define XB_XGEN(j)  (2304 + 64 * (j))
#define XB_TOP      3328
#define XB_TOPGEN   3392
#define XCD_BAR_WORDS 3456
#define XB_SPIN_CAP (1u << 18)

__device__ __forceinline__ unsigned xb_ld(unsigned* p)              { return __hip_atomic_load(p, __ATOMIC_RELAXED, __HIP_MEMORY_SCOPE_AGENT); }
__device__ __forceinline__ unsigned xb_add(unsigned* p, unsigned v) { return __hip_atomic_fetch_add(p, v, __ATOMIC_RELAXED, __HIP_MEMORY_SCOPE_AGENT); }
__device__ __forceinline__ unsigned xb_xcc_id() { return (unsigned)__builtin_amdgcn_s_getreg((3 << 11) | 20) & 0xFu; }
#define XB_SPIN(cond, bar) do { unsigned _sp = 0; while (cond) { __builtin_amdgcn_s_sleep(1); \
    if ((++_sp & 255u) == 0u) { if (xb_ld(&(bar)[XB_TMO])) break; if (_sp > XB_SPIN_CAP) { atomicAdd(&(bar)[XB_TMO], 1u); break; } } } } while (0)

struct XcdBarrier {
    unsigned* bar; unsigned x;
    volatile LAS unsigned* st;
};

__device__ __forceinline__ XcdBarrier xcd_barrier_post(unsigned* bar, volatile LAS unsigned* st) {
    XcdBarrier b; b.bar = bar; b.x = xb_xcc_id(); b.st = st;
    if (threadIdx.x == 0) (void)xb_add(&bar[XB_XCNT(b.x)], 1u);
    return b;
}
__device__ __forceinline__ void xcd_barrier_complete(unsigned* bar, unsigned x, unsigned& nloc, unsigned& nx) {
    const unsigned G = gridDim.x * gridDim.y * gridDim.z;
    unsigned sum, cnt, mine, sp = 0u;
    for (;;) {
        sum = 0u; cnt = 0u; mine = 0u;
#pragma unroll
        for (unsigned j = 0; j < 16; ++j) { const unsigned c = xb_ld(&bar[XB_XCNT(j)]); sum += c; cnt += (c > 0u) ? 1u : 0u; mine = (j == x) ? c : mine; }
        if (sum == G) break;
        __builtin_amdgcn_s_sleep(1);
        if ((++sp & 255u) == 0u) { if (xb_ld(&bar[XB_TMO])) break; if (sp > XB_SPIN_CAP) { atomicAdd(&bar[XB_TMO], 1u); break; } }
    }
    nloc = mine > 0u ? mine : 1u; nx = cnt > 0u ? cnt : 1u;
}

template <bool LOCAL> __device__ __forceinline__ void xcd_barrier(const XcdBarrier& b) {
    asm volatile("s_waitcnt vmcnt(0)" ::: "memory");
    __syncthreads();
    if (threadIdx.x == 0) {
        unsigned* bar = b.bar;
        __builtin_amdgcn_s_waitcnt(0);
        unsigned nloc = b.st[0], nx = b.st[1];
        if (nloc == 0u) { xcd_barrier_complete(bar, b.x, nloc, nx); b.st[0] = nloc; b.st[1] = nx; }
        const unsigned old = xb_add(&bar[XB_XSUB(b.x)], 1u);
        const unsigned gen = old / nloc;
        if (old + 1u == (gen + 1u) * nloc) {
            __builtin_amdgcn_fence(__ATOMIC_RELEASE, "agent");
            asm volatile("s_waitcnt vmcnt(0)" ::: "memory");
            if (!LOCAL) {
            const unsigned og = xb_add(&bar[XB_TOP], 1u);
            const unsigned tg = og / nx;
            if (og + 1u == (tg + 1u) * nx) xb_add(&bar[XB_TOPGEN], 1u);
            else XB_SPIN(xb_ld(&bar[XB_TOPGEN]) == tg, bar);
            }
            __builtin_amdgcn_fence(__ATOMIC_ACQUIRE, "agent");
            xb_add(&bar[XB_XGEN(b.x)], 1u);
            asm volatile("s_waitcnt vmcnt(0)" ::: "memory");
        } else {
            XB_SPIN(xb_ld(&bar[XB_XGEN(b.x)]) == gen, bar);
            __builtin_amdgcn_fence(__ATOMIC_ACQUIRE, "agent");
            asm volatile("s_waitcnt vmcnt(0)" ::: "memory");
        }
    }
    __syncthreads();
}

struct Args { const float* in[16]; float* out; unsigned char* ws; };
__device__ __forceinline__ const float* in_ptr(int i) { const char __attribute__((address_space(4)))* ka = (const char __attribute__((address_space(4)))*)__builtin_amdgcn_kernarg_segment_ptr(); int off = i * 8; asm volatile("" : "+s"(off)); return *(const float* const __attribute__((address_space(4)))*)(ka + off); }
__device__ __forceinline__ float* out_ptr() { return (float*)in_ptr(16); }
__device__ __forceinline__ unsigned char* ws_ptr() { return (unsigned char*)in_ptr(17); }

__device__ __forceinline__ void p0_transpose_item(const float* W, int K, int N, bf16* WT, int k0, int n0, int drow0, LAS float* scr, int lane) {
#pragma unroll 8
    for (int i = 0; i < 32; ++i) { const int kk = 2 * i + (lane >> 5); scr[kk * 33 + (lane & 31)] = __builtin_nontemporal_load(&W[(size_t)(k0 + kk) * N + n0 + (lane & 31)]); }
    LDS_WAIT(); asm volatile("" ::: "memory");
    const int c = lane & 7;
#pragma unroll
    for (int j = 0; j < 4; ++j) { const int n = (lane >> 3) + 8 * j; const LAS float* s = scr + (8 * c) * 33 + n;
        v4u o; o.x = pk2(s[0 * 33], s[1 * 33]); o.y = pk2(s[2 * 33], s[3 * 33]); o.z = pk2(s[4 * 33], s[5 * 33]); o.w = pk2(s[6 * 33], s[7 * 33]);
        *(GAS v4u*)(WT + (size_t)(drow0 + n) * K + k0 + 8 * c) = o; }
    LDS_WAIT(); asm volatile("" ::: "memory");
}
__device__ __forceinline__ float* hrow_ptr(float* out, float* hmeta, int m) { return m < MREAL ? out + (size_t)m * DM_ : hmeta + (size_t)(m - MREAL) * DM_; }
__device__ __forceinline__ int qkv_row(int m) { return m < MREAL ? (m >> 11) * 2112 + 64 + (m & 2047) : ((m - MREAL) >> 4) * 2112 + 48 + ((m - MREAL) & 15); }
__device__ __forceinline__ int prev_row(int m, int k) {
    if (m < MREAL) { const int t = m & 2047, b = m >> 11; return (t >= k) ? m - k : MREAL + b * 16 + (16 + t - k); }
    const int i = (m - MREAL) & 15; return (i >= k) ? m - k : -1;
}


typedef short tg_bf16x8 __attribute__((ext_vector_type(8)));
template <int MODE, int KW  , int TR  , int TC  >
__device__ __forceinline__ void tail_gemm(LAS unsigned char* lds, const bf16* A, const bf16* Bt, int N, bf16* O, int ldc, const float* rope, float scale0, size_t buf_stride, int cu, int ncu) {
    constexpr int K = KW * 8, NS = KW / 32, NCP = 16 * TC, NRW = 16 * TR, NCO = (MODE == 1) ? NCP / 2 : NCP, NRB = 128 / NRW, WSZ = NRW * NCP;
    const int tid = opaque_tid(), lane = tid & 63, wid = __builtin_amdgcn_readfirstlane(tid >> 6), fr = lane & 15, fq = lane >> 4;
    const int ncolt = ((MODE == 1) ? N / 2 : N) / NCO, ntiles = NRB * ncolt;
    LAS float* red = (LAS float*)lds;
    if (cu < 0) return;
    for (int tile = cu; tile < ntiles; tile += ncu) {
        const int rb = tile % NRB, ct = tile / NRB;
        tg_bf16x8 fa[TR][NS], fb[TC][NS];
#pragma unroll
        for (int ci = 0; ci < TC; ++ci) { int brow;
            if (MODE == 1) { const int oc = ct * NCO, base = 256 * (oc >> 7) + (oc & 127); brow = (ci < TC / 2) ? base + 16 * ci : base + 128 + 16 * (ci - TC / 2); } else brow = ct * NCP + 16 * ci;
            const bf16* bp = Bt + (size_t)(brow + fr) * K + wid * KW + 8 * fq;
#pragma unroll
            for (int i = 0; i < NS; ++i) fb[ci][i] = *(const tg_bf16x8*)(bp + i * 32); }
#pragma unroll
        for (int ri = 0; ri < TR; ++ri) { const bf16* ap = A + (size_t)(rb * NRW + ri * 16 + fr) * K + wid * KW + 8 * fq;
#pragma unroll
            for (int i = 0; i < NS; ++i) fa[ri][i] = *(const tg_bf16x8*)(ap + i * 32); }
        f32x4 c[TR][TC];
#pragma unroll
        for (int ri = 0; ri < TR; ++ri)
#pragma unroll
            for (int ci = 0; ci < TC; ++ci) c[ri][ci] = (f32x4){0.f, 0.f, 0.f, 0.f};
#pragma unroll
        for (int i = 0; i < NS; ++i)
#pragma unroll
            for (int ri = 0; ri < TR; ++ri)
#pragma unroll
                for (int ci = 0; ci < TC; ++ci) c[ri][ci] = __builtin_amdgcn_mfma_f32_16x16x32_bf16(fb[ci][i], fa[ri][i], c[ri][ci], 0, 0, 0);
        LAS float* rw = red + wid * WSZ;
#pragma unroll
        for (int ri = 0; ri < TR; ++ri)
#pragma unroll
            for (int ci = 0; ci < TC; ++ci) *(LAS f32x4*)(rw + (ri * 16 + fr) * NCP + ci * 16 + 4 * fq) = c[ri][ci];
        __syncthreads();
#define TG_RED(rr_, cc_) (((red[0 * WSZ + (rr_) * NCP + (cc_)] + red[1 * WSZ + (rr_) * NCP + (cc_)]) + (red[2 * WSZ + (rr_) * NCP + (cc_)] + red[3 * WSZ + (rr_) * NCP + (cc_)])) + ((red[4 * WSZ + (rr_) * NCP + (cc_)] + red[5 * WSZ + (rr_) * NCP + (cc_)]) + (red[6 * WSZ + (rr_) * NCP + (cc_)] + red[7 * WSZ + (rr_) * NCP + (cc_)])))
#pragma unroll
        for (int e = tid; e < NRW * NCO; e += NWAVES * 64) { const int row = e / NCO, cc = e % NCO, r = rb * NRW + row;
            if (MODE == 0) { O[(size_t)(MREAL + r) * ldc + ct * NCO + cc] = (bf16)f2bf(TG_RED(row, cc)); }
            else if (MODE == 1) { const float g = TG_RED(row, cc), u = TG_RED(row, NCO + cc); O[(size_t)(MREAL + r) * ldc + ct * NCO + cc] = (bf16)f2bf(pg8::EpiSwiGLU::silu_mul(g, u)); }
            else { const int gcol = ct * NCO + cc, t = gcol >> 10, d = gcol & 63; float v0 = TG_RED(row, cc);
                const int orow = (r >> 4) * 2112 + 48 + (r & 15), pos = r & 15;
                if (t < 2 && d < 16) { const int pc = cc + ((gcol ^ 8) - gcol); const float o0 = TG_RED(row, pc); const int j = d & 7; const float sgn = (d < 8) ? -1.f : 1.f;
                    v0 = v0 * rope[pos * 16 + j] + sgn * o0 * rope[pos * 16 + 8 + j]; }
                if (t == 0) v0 *= scale0;
                O[(size_t)t * buf_stride + (size_t)orow * 1024 + (gcol & 1023)] = (bf16)f2bf(v0); } }
#undef TG_RED
        __syncthreads();
    }
}

__device__ __forceinline__ int batch_row(int b, int i) { return i < SEQL ? b * SEQL + i : MREAL + b * NMETA + ((i - SEQL) >> 4); }
__global__ void __launch_bounds__(NWAVES * 64, 2) trunk_fwd(Args args) {
    extern __shared__ __attribute__((aligned(16))) unsigned char lds[];
    cg::grid_group grid = cg::this_grid();
    const int tid = threadIdx.x, lane = tid & 63, wave = __builtin_amdgcn_readfirstlane(tid >> 6);
    const int G = gridDim.x; const int bx = blockIdx.x; const int vcu = (G % 8 == 0) ? (bx % 8) * (G / 8) + bx / 8 : bx;
    const int gw = vcu * NWAVES + wave, NGW = G * NWAVES;
    LAS unsigned char* ldsl = (LAS unsigned char*)lds;
#define WSB(off) (ws_ptr() + (off))
#define P_HMETA ((float*)WSB(WS_HMETA))
#define P_ROPE ((float*)WSB(WS_ROPE))
#define P_WB ((bf16*)WSB(WS_W))
#define P_XN ((bf16*)WSB(WS_XN))
#define P_FB ((bf16*)WSB(WS_F))
#define P_BIG ((bf16*)WSB(WS_BIG))
    for (int u = tid; u < (LDS_BYTES - RING_BYTES) / 4; u += NWAVES * 64) ((LAS unsigned*)(ldsl + RING_BYTES))[u] = 0u;
    __syncthreads();
    XcdBarrier xbar = xcd_barrier_post((unsigned*)ws_ptr(), (volatile LAS unsigned*)(ldsl + RING_BYTES + 352));
#define GSYNC() xcd_barrier<false>(xbar)
#define LSYNC() xcd_barrier<true>(xbar)
#define GSYNC_CG() do { asm volatile("s_waitcnt vmcnt(0) lgkmcnt(0)" ::: "memory"); __builtin_amdgcn_fence(__ATOMIC_RELEASE, "agent"); grid.sync(); __builtin_amdgcn_fence(__ATOMIC_ACQUIRE, "agent"); } while (0)

    if (tid == 0) ((unsigned*)(ws_ptr() + 32768))[bx] = xbar.x + 1u;
    {
        LAS float* scr = (LAS float*)(ldsl + wave * 16384); bf16* const Wb0 = P_WB;
        constexpr int I_GU = (DM_ / 64) * (NGU / 32), I_DN = (DFF / 64) * (DM_ / 32), I_FFN = I_GU + I_DN;
        constexpr int I_IN = (DM_ / 64) * (3 * DM_ / 32), I_OUT = (DM_ / 64) * (DM_ / 32), I_MIX = I_IN + I_OUT;
        constexpr int NITEMS = 8 * I_FFN + 4 * I_MIX;
        for (int it = gw; it < NITEMS; it += NGW) {
            if (it < 8 * I_FFN) { const int fi = it / I_FFN, r = it % I_FFN, l = fi >> 1, which = fi & 1; bf16* dst = Wb0 + (size_t)fi * W_FFN_E;
                if (r < I_GU) { const float* W = (which ? in_ptr(14) : in_ptr(3)) + (size_t)l * DM_ * NGU; const int nblk = NGU / 32, kb = r / nblk, nb = r % nblk, n0 = 32 * nb;
                    const int half = n0 / DFF, within = n0 % DFF, drow0 = 256 * (within / 128) + 128 * half + (within % 128);
                    p0_transpose_item(W, DM_, NGU, dst, 64 * kb, n0, drow0, scr, lane); }
                else { const int r2 = r - I_GU; const float* W = (which ? in_ptr(15) : in_ptr(4)) + (size_t)l * DFF * DM_; const int nblk = DM_ / 32, kb = r2 / nblk, nb = r2 % nblk;
                    p0_transpose_item(W, DFF, DM_, dst + W_GU_E, 64 * kb, 32 * nb, 32 * nb, scr, lane); }
            } else { const int it2 = it - 8 * I_FFN, l = it2 / I_MIX, r = it2 % I_MIX, j = l >> 1, isattn = l & 1; bf16* dst = Wb0 + 8 * W_FFN_E + (size_t)l * W_MIX_E;
                if (r < I_IN) { const float* W = (isattn ? in_ptr(9) : in_ptr(6)) + (size_t)j * DM_ * 3 * DM_; const int nblk = 3 * DM_ / 32, kb = r / nblk, nb = r % nblk;
                    p0_transpose_item(W, DM_, 3 * DM_, dst, 64 * kb, 32 * nb, 32 * nb, scr, lane); }
                else { const int r2 = r - I_IN; const float* W = (isattn ? in_ptr(12) : in_ptr(8)) + (size_t)j * DM_ * DM_; const int nblk = DM_ / 32, kb = r2 / nblk, nb = r2 % nblk;
                    p0_transpose_item(W, DM_, DM_, dst + W_IN_E, 64 * kb, 32 * nb, 32 * nb, scr, lane); }
            }
        }
        float* const rope0 = P_ROPE;
        for (int e = gw * 64 + lane; e < 2064 * 8; e += NGW * 64) { const int pos = e >> 3, j = e & 7;
            const float inv = (float)exp2(-(double)j * (18.931568569324174 / 8.0));
            const float ang = (float)pos * inv; const double rev = (double)ang * 0.15915494309189535; const float fr = (float)(rev - floor(rev));
            rope0[pos * 16 + j] = __builtin_amdgcn_cosf(fr); rope0[pos * 16 + 8 + j] = __builtin_amdgcn_sinf(fr); }
        { const v4u z = {0u, 0u, 0u, 0u}; bf16* const xn0 = P_XN; bf16* const big0 = P_BIG;
          for (int e = gw * 64 + lane; e < (MPAD - MVALID) * 128; e += NGW * 64) *(v4u*)(xn0 + (size_t)MVALID * 1024 + (size_t)e * 8) = z;
          for (int e = gw * 64 + lane; e < 3 * (8 * 48 + 256) * 128; e += NGW * 64) { const int bufi = e / ((8 * 48 + 256) * 128), r = (e / 128) % (8 * 48 + 256), c = e % 128;
              const int row = r < 384 ? (r / 48) * 2112 + (r % 48) : 8 * 2112 + (r - 384);
              *(v4u*)(big0 + (size_t)bufi * QROWS * 1024 + (size_t)row * 1024 + c * 8) = z; } }
    }
    { float* const hp_out = out_ptr(); float* const hp_meta = P_HMETA; const float* const xin = in_ptr(0); const float* const min_ = in_ptr(1); const float* const g = in_ptr(2); bf16* const xn0 = P_XN;
    for (int m = gw; m < MVALID; m += NGW) {
        const float* src = m < MREAL ? xin + (size_t)m * DM_ : min_ + (size_t)((m - MREAL) & 15) * DM_;
        float* hr = hrow_ptr(hp_out, hp_meta, m);
        f32x4 v[4]; float s = 0.f;
#pragma unroll
        for (int q = 0; q < 4; ++q) { v[q] = *(const f32x4*)(src + (q >> 1) * 512 + lane * 8 + (q & 1) * 4); s += (v[q][0] * v[q][0] + v[q][1] * v[q][1]) + (v[q][2] * v[q][2] + v[q][3] * v[q][3]); }
        const float r2 = 1.0f / sqrtf(wave_sum(s) * (1.f / DM_) + 1e-6f);
        if (m >= MREAL) {
#pragma unroll
        for (int q = 0; q < 4; ++q) *(f32x4*)(hr + (q >> 1) * 512 + lane * 8 + (q & 1) * 4) = v[q]; }
#pragma unroll
        for (int hh = 0; hh < 2; ++hh) { const f32x4 g0 = *(const f32x4*)(g + hh * 512 + lane * 8), g1 = *(const f32x4*)(g + hh * 512 + lane * 8 + 4); const f32x4 a = v[2 * hh] * r2 * g0, b = v[2 * hh + 1] * r2 * g1;
            v4u o; o.x = pk2(a[0], a[1]); o.y = pk2(a[2], a[3]); o.z = pk2(b[0], b[1]); o.w = pk2(b[2], b[3]); *(v4u*)(xn0 + (size_t)m * 1024 + hh * 512 + lane * 8) = o; }
    } }
    GSYNC();
    if (G == 0x7fffff) GSYNC_CG();
    int fastsync;
    { int ok = 1; const unsigned* xt = (const unsigned*)(ws_ptr() + 32768);
      if (G != 256) ok = 0; else if (tid < 256) ok = (xt[tid] != 0u) && (xt[tid] == xt[tid & 7]);
      fastsync = __syncthreads_and(ok); }

    enum { K_GU = 0, K_PLAIN = 1, K_NORM = 2, K_CONV = 3, K_QKV = 4, K_ATTN = 5, K_COMB = 6 };
    for (int l = 0; l < DEPTH_; ++l) {
        const int nsteps = (l & 1) ? 11 : 10;
        for (int s = 0; s < nsteps; ++s) {
            int lq = l; asm volatile("" : "+s"(lq));
            const int isattn = lq & 1, jm = lq >> 1;
            const bf16* Wmix = P_WB + 8 * W_FFN_E + (size_t)lq * W_MIX_E;
            int kind; const bf16* gA = P_XN; const bf16* gB = P_WB; int gN = 1024, gK = 1024; bf16* gO = P_FB;
            float coef = 0.5f; const float* gpost = in_ptr(2); const float* gnext = in_ptr(2); int wnext = 1;
            int ffn_i = 0;
            const int sm = (isattn && s >= 5) ? s - 1 : s;
            if (s == 0 || sm == 7) { kind = K_GU; ffn_i = (s == 0) ? 0 : 1; }
            else if (s == 1 || sm == 8) { kind = K_PLAIN; ffn_i = (s == 1) ? 0 : 1; gA = P_BIG; gB = P_WB + (size_t)(2 * lq + ffn_i) * W_FFN_E + W_GU_E; gN = 1024; gK = DFF; gO = P_FB; }
            else if (s == 2) { kind = K_NORM; coef = 0.5f; gpost = in_ptr(2) + (size_t)(lq * 2 + 1) * DM_; gnext = in_ptr(5) + (size_t)(lq * 2) * DM_; }
            else if (s == 3) { if (isattn) kind = K_QKV; else { kind = K_PLAIN; gA = P_XN; gB = Wmix; gN = 3 * DM_; gK = DM_; gO = P_BIG; } }
            else if (s == 4) { kind = isattn ? K_ATTN : K_CONV; }
            else if (isattn && s == 5) { kind = K_COMB; }
            else if (sm == 5) { kind = K_PLAIN; gA = P_XN; gB = Wmix + W_IN_E; gN = 1024; gK = 1024; gO = P_FB; }
            else if (sm == 6) { kind = K_NORM; coef = 1.0f; gpost = in_ptr(5) + (size_t)(lq * 2 + 1) * DM_; gnext = in_ptr(13) + (size_t)(lq * 2) * DM_; }
            else { kind = K_NORM; coef = 0.5f; gpost = in_ptr(13) + (size_t)(lq * 2 + 1) * DM_; wnext = (lq < DEPTH_ - 1); gnext = in_ptr(2) + (size_t)((lq < DEPTH_ - 1 ? lq + 1 : lq) * 2) * DM_; }

            const bool meta_live = !(lq == DEPTH_ - 1 && s >= 5);
            const int lane = opaque_tid() & 63;
            const bool ral = (G == 256); const int ri0 = ral ? (gw & 255) : gw, rin = ral ? ((meta_live && (gw & 15) == 0) ? SEQL + 256 : SEQL) : (meta_live ? MVALID : MREAL),        ris = ral ? 256 : NGW, rbt = gw >> 8;
#define ROWMAP(i_) (ral ? batch_row(rbt, (i_)) : (i_))
            if (kind == K_GU) {
                pg8::Gemm g{P_XN, P_WB + (size_t)(2 * lq + ffn_i) * W_FFN_E, MREAL, NGU, DM_}; pg8::StaticOrder S; S.init(MREAL, NGU, G, bx);
                pg8::EpiSwiGLU E{P_BIG, DFF};
                pg8::gemm_phase<pg8::EpiSwiGLU, pg8::StaticOrder, true, true>(ldsl, g, S, E);
                { const int lo = (G == 256) ? 128 : 0;
                  tail_gemm<1, 128, 1, 8>(ldsl, P_XN + (size_t)MREAL * DM_, P_WB + (size_t)(2 * lq + ffn_i) * W_FFN_E, NGU, P_BIG, DFF, nullptr, 1.f, 0, meta_live ? bx - lo : -1, G - lo); }
            } else if (kind == K_PLAIN) {
                pg8::Gemm g{gA, gB, MREAL, gN, gK}; pg8::StaticOrder S; S.init(MREAL, gN, G, bx);
                pg8::EpiBf16<0> E{gO, gN, nullptr, 0, 0, 1.f};
                pg8::gemm_phase<pg8::EpiBf16<0>, pg8::StaticOrder, true, true>(ldsl, g, S, E);
                if (gK == DM_) { if (gN == DM_) tail_gemm<0, 128, 1, 2>(ldsl, gA + (size_t)MREAL * DM_, gB, gN, gO, gN, nullptr, 1.f, 0, meta_live ? bx : -1, G); else tail_gemm<0, 128, 1, 6>(ldsl, gA + (size_t)MREAL * DM_, gB, gN, gO, gN, nullptr, 1.f, 0, bx, G); }
                else tail_gemm<0, 352, 1, 2>(ldsl, gA + (size_t)MREAL * DFF, gB, gN, gO, gN, nullptr, 1.f, 0, meta_live ? bx : -1, G);
            } else if (kind == K_QKV) {
                pg8::Gemm g{P_XN, Wmix, MREAL, 3 * DM_, DM_}; pg8::StaticOrder S; S.init(MREAL, 3 * DM_, G, bx);
                pg8::EpiQKV E{P_BIG, (size_t)QROWS * 1024, P_ROPE, attn_body::C2};
                pg8::gemm_phase<pg8::EpiQKV, pg8::StaticOrder, true, true>(ldsl, g, S, E);
                tail_gemm<2, 128, 1, 6>(ldsl, P_XN + (size_t)MREAL * DM_, Wmix, 3 * DM_, P_BIG, 1024, P_ROPE, attn_body::C2, (size_t)QROWS * 1024, bx, G);
            } else if (kind == K_NORM) {
                float* const hp_out = out_ptr(); float* const hp_meta = P_HMETA; const bf16* const fb0 = P_FB; bf16* const xn0 = P_XN;
                f32x4 nv[4]; v4u nw[2];
#define NORM_LOAD(mm) do { const float* hq_ = hrow_ptr(hsrc0, hp_meta, (mm)); const bf16* fq_ = fb0 + (size_t)(mm) * 1024; \
                    nw[0] = __builtin_nontemporal_load((const v4u*)(fq_ + lane * 8)); nw[1] = __builtin_nontemporal_load((const v4u*)(fq_ + 512 + lane * 8)); \
                    _Pragma("unroll") for (int q = 0; q < 4; ++q) nv[q] = *(const f32x4*)(hq_ + (q >> 1) * 512 + lane * 8 + (q & 1) * 4); } while (0)
                float* const hsrc0 = (lq == 0 && s == 2) ? (float*)in_ptr(0) : hp_out;
                NORM_LOAD(ROWMAP(ri0 < rin ? ri0 : 0));
                for (int ri = ri0; ri < rin; ri += ris) { const int m = ROWMAP(ri);
                    float* hr = hrow_ptr(hp_out, hp_meta, m);
                    f32x4 v[4]; float fv[16]; float s1 = 0.f;
#pragma unroll
                    for (int hh = 0; hh < 2; ++hh) { const v4u w = nw[hh];
                        fv[hh * 8 + 0] = bflo(w.x); fv[hh * 8 + 1] = bfhi(w.x); fv[hh * 8 + 2] = bflo(w.y); fv[hh * 8 + 3] = bfhi(w.y); fv[hh * 8 + 4] = bflo(w.z); fv[hh * 8 + 5] = bfhi(w.z); fv[hh * 8 + 6] = bflo(w.w); fv[hh * 8 + 7] = bfhi(w.w); }
#pragma unroll
                    for (int q = 0; q < 4; ++q) v[q] = nv[q];
                    if (ri + ris < rin) NORM_LOAD(ROWMAP(ri + ris));
#pragma unroll
                    for (int e = 0; e < 16; ++e) s1 += fv[e] * fv[e];
                    const float r1 = coef / sqrtf(wave_sum(s1) * (1.f / DM_) + 1e-6f); float s2 = 0.f;
#pragma unroll
                    for (int q = 0; q < 4; ++q) { const f32x4 gp = *(const f32x4*)(gpost + (q >> 1) * 512 + lane * 8 + (q & 1) * 4);
#pragma unroll
                        for (int i = 0; i < 4; ++i) { v[q][i] += fv[q * 4 + i] * r1 * gp[i]; s2 += v[q][i] * v[q][i]; } }
                    const float r2 = 1.0f / sqrtf(wave_sum(s2) * (1.f / DM_) + 1e-6f);
#pragma unroll
                    for (int q = 0; q < 4; ++q) *(f32x4*)(hr + (q >> 1) * 512 + lane * 8 + (q & 1) * 4) = v[q];
                    if (wnext) {
#pragma unroll
                        for (int hh = 0; hh < 2; ++hh) { const f32x4 g0 = *(const f32x4*)(gnext + hh * 512 + lane * 8), g1 = *(const f32x4*)(gnext + hh * 512 + lane * 8 + 4); const f32x4 a = v[2 * hh] * r2 * g0, b = v[2 * hh + 1] * r2 * g1;
                            v4u o; o.x = pk2(a[0], a[1]); o.y = pk2(a[2], a[3]); o.z = pk2(b[0], b[1]); o.w = pk2(b[2], b[3]); *(v4u*)(xn0 + (size_t)m * 1024 + hh * 512 + lane * 8) = o; }
                    }
                }
#undef NORM_LOAD
            } else if (kind == K_CONV) {
                const float* cw = in_ptr(7) + (size_t)jm * 3 * DM_; const bf16* const big0 = P_BIG; bf16* const xn0 = P_XN;
                for (int ri = ri0; ri < rin; ri += ris) { const int m = ROWMAP(ri);
                    const int m1 = prev_row(m, 1), m2 = prev_row(m, 2);
#pragma unroll
                    for (int hh = 0; hh < 2; ++hh) { const int d0 = hh * 512 + lane * 8; float acc8[8];
#pragma unroll
                        for (int k = 0; k < 3; ++k) { const int mr = (k == 2) ? m : (k == 1 ? m1 : m2); v4u cc = {0u, 0u, 0u, 0u}, xx = cc;
                            if (mr >= 0) { cc = *(const v4u*)(big0 + (size_t)mr * 3072 + 1024 + d0); xx = *(const v4u*)(big0 + (size_t)mr * 3072 + 2048 + d0); }
                            const f32x4 w0 = *(const f32x4*)(cw + k * DM_ + d0), w1 = *(const f32x4*)(cw + k * DM_ + d0 + 4);
                            const float u0 = bflo(cc.x) * bflo(xx.x), u1 = bfhi(cc.x) * bfhi(xx.x), u2 = bflo(cc.y) * bflo(xx.y), u3 = bfhi(cc.y) * bfhi(xx.y);
                            const float u4 = bflo(cc.z) * bflo(xx.z), u5 = bfhi(cc.z) * bfhi(xx.z), u6 = bflo(cc.w) * bflo(xx.w), u7 = bfhi(cc.w) * bfhi(xx.w);
                            if (k == 0) { acc8[0] = w0[0] * u0; acc8[1] = w0[1] * u1; acc8[2] = w0[2] * u2; acc8[3] = w0[3] * u3; acc8[4] = w1[0] * u4; acc8[5] = w1[1] * u5; acc8[6] = w1[2] * u6; acc8[7] = w1[3] * u7; }
                            else { acc8[0] += w0[0] * u0; acc8[1] += w0[1] * u1; acc8[2] += w0[2] * u2; acc8[3] += w0[3] * u3; acc8[4] += w1[0] * u4; acc8[5] += w1[1] * u5; acc8[6] += w1[2] * u6; acc8[7] += w1[3] * u7; } }
                        const v4u bb = __builtin_nontemporal_load((const v4u*)(big0 + (size_t)m * 3072 + d0));
                        v4u o; o.x = pk2(bflo(bb.x) * acc8[0], bfhi(bb.x) * acc8[1]); o.y = pk2(bflo(bb.y) * acc8[2], bfhi(bb.y) * acc8[3]); o.z = pk2(bflo(bb.z) * acc8[4], bfhi(bb.z) * acc8[5]); o.w = pk2(bflo(bb.w) * acc8[6], bfhi(bb.w) * acc8[7]);
                        *(v4u*)(xn0 + (size_t)m * 1024 + d0) = o; }
                }
            } else if (kind == K_ATTN) {
                bf16* const big0 = P_BIG; const attn_body::AttnTensors AT{(const attn_body::bf16*)big0, (const attn_body::bf16*)(big0 + (size_t)QROWS * 1024), (const attn_body::bf16*)(big0 + (size_t)2 * QROWS * 1024), (attn_body::bf16*)P_XN, (attn_body::bf16*)P_FB};
                attn_body::attn_phase<8>((char*)lds, AT, vcu, G);
            } else {
                const float linit = 0.8f - 0.6f * expf(-0.3f * (float)lq);
                const float* lp = in_ptr(10) + (size_t)jm * 4 * 64;
                const float lam = expf(wave_sum(lp[lane] * lp[64 + lane])) - expf(wave_sum(lp[128 + lane] * lp[192 + lane])) + linit;
                const float* sg = in_ptr(11) + (size_t)jm * 128; const int hd = lane >> 3, dv0 = (lane & 7) * 16;
                float gs[16];
#pragma unroll
                for (int q = 0; q < 4; ++q) { const f32x4 t4 = *(const f32x4*)(sg + dv0 + q * 4); gs[q * 4 + 0] = t4[0] * (1.f - linit); gs[q * 4 + 1] = t4[1] * (1.f - linit); gs[q * 4 + 2] = t4[2] * (1.f - linit); gs[q * 4 + 3] = t4[3] * (1.f - linit); }
                bf16* const ob0 = P_XN; const bf16* const ob1 = P_FB;
                for (int ri = ri0; ri < rin; ri += ris) { const int m = ROWMAP(ri);
                    bf16* orow = ob0 + (size_t)m * 1024 + hd * 128 + dv0; const bf16* orow1 = ob1 + (size_t)m * 1024 + hd * 128 + dv0;
                    const v4u a0 = *(const v4u*)(orow), a1 = *(const v4u*)(orow + 8), b0 = __builtin_nontemporal_load((const v4u*)(orow1)), b1 = __builtin_nontemporal_load((const v4u*)(orow1 + 8));
                    float d[16];
                    d[0] = bflo(a0.x) - lam * bflo(b0.x); d[1] = bfhi(a0.x) - lam * bfhi(b0.x); d[2] = bflo(a0.y) - lam * bflo(b0.y); d[3] = bfhi(a0.y) - lam * bfhi(b0.y);
                    d[4] = bflo(a0.z) - lam * bflo(b0.z); d[5] = bfhi(a0.z) - lam * bfhi(b0.z); d[6] = bflo(a0.w) - lam * bflo(b0.w); d[7] = bfhi(a0.w) - lam * bfhi(b0.w);
                    d[8] = bflo(a1.x) - lam * bflo(b1.x); d[9] = bfhi(a1.x) - lam * bfhi(b1.x); d[10] = bflo(a1.y) - lam * bflo(b1.y); d[11] = bfhi(a1.y) - lam * bfhi(b1.y);
                    d[12] = bflo(a1.z) - lam * bflo(b1.z); d[13] = bfhi(a1.z) - lam * bfhi(b1.z); d[14] = bflo(a1.w) - lam * bflo(b1.w); d[15] = bfhi(a1.w) - lam * bfhi(b1.w);
                    float ss = 0.f;
#pragma unroll
                    for (int e = 0; e < 16; ++e) ss += d[e] * d[e];
                    ss += __shfl_xor(ss, 1); ss += __shfl_xor(ss, 2); ss += __shfl_xor(ss, 4);
                    const float rr = 1.0f / sqrtf(ss * (1.f / 128.f) + 1e-5f);
                    v4u o0, o1;
                    o0.x = pk2(d[0] * rr * gs[0], d[1] * rr * gs[1]); o0.y = pk2(d[2] * rr * gs[2], d[3] * rr * gs[3]); o0.z = pk2(d[4] * rr * gs[4], d[5] * rr * gs[5]); o0.w = pk2(d[6] * rr * gs[6], d[7] * rr * gs[7]);
                    o1.x = pk2(d[8] * rr * gs[8], d[9] * rr * gs[9]); o1.y = pk2(d[10] * rr * gs[10], d[11] * rr * gs[11]); o1.z = pk2(d[12] * rr * gs[12], d[13] * rr * gs[13]); o1.w = pk2(d[14] * rr * gs[14], d[15] * rr * gs[15]);
                    *(v4u*)orow = o0; *(v4u*)(orow + 8) = o1;
                }
            }
#undef ROWMAP
            {
              const int arrive_s = (s == 1) ? 0 : (s == 4) ? 1 : -1;
              const int wait_s = isattn ? ((s == 2) ? 0 : (s == 7) ? 1 : -1) : ((s == 2) ? 0 : (s == 6) ? 1 : -1);
              const bool full = false;
              unsigned* const splitc = (unsigned*)(ws_ptr() + 40960) + 64 * (2 * lq + (arrive_s >= 0 ? arrive_s : (wait_s >= 0 ? wait_s : 0)));
              if (lq == DEPTH_ - 1 && s == nsteps - 1) {   }
              else if (!fastsync || full) GSYNC();
              else { LSYNC();
                     if (arrive_s >= 0) { if (opaque_tid() == 0) __hip_atomic_fetch_add(splitc, 1u, __ATOMIC_RELAXED, __HIP_MEMORY_SCOPE_AGENT); }
                     if (wait_s >= 0) { if (opaque_tid() == 0) { unsigned sp_ = 0; while (__hip_atomic_load(splitc, __ATOMIC_RELAXED, __HIP_MEMORY_SCOPE_AGENT) < (unsigned)G && ++sp_ < (1u << 22)) __builtin_amdgcn_s_sleep(1); }
                                        __syncthreads(); } } }
        }
    }
}

extern "C" void kernel_launch(void* const* d_in, const int* in_sizes, int n_in, void* d_out, int out_size, void* d_ws, size_t ws_size, hipStream_t stream) {
    static int grid = 0;
    if (grid == 0) {
        if (n_in != 16 || out_size != MREAL * DM_ || ws_size < WS_END) { fprintf(stderr, "kernel_launch: unexpected shapes: n_in %d out %d ws %zu (need %zu)\n", n_in, out_size, ws_size, (size_t)WS_END); grid = -1; return; }
        int dev = 0, cus = 0, per_cu = 0;
        if (hipGetDevice(&dev) != hipSuccess || hipDeviceGetAttribute(&cus, hipDeviceAttributeMultiprocessorCount, dev) != hipSuccess) { grid = -1; return; }
        if (hipFuncSetAttribute((const void*)trunk_fwd, hipFuncAttributeMaxDynamicSharedMemorySize, LDS_BYTES) != hipSuccess) { fprintf(stderr, "kernel_launch: hipFuncSetAttribute failed\n"); grid = -1; return; }
        if (hipOccupancyMaxActiveBlocksPerMultiprocessor(&per_cu, (const void*)trunk_fwd, NWAVES * 64, LDS_BYTES) != hipSuccess || per_cu < 1) { fprintf(stderr, "kernel_launch: occupancy query says %d\n", per_cu); per_cu = 1; }
        (void)hipGetLastError();
        grid = cus * per_cu;
    }
    if (grid < 0) return;
    if (hipMemsetAsync(d_ws, 0, 65536, stream) != hipSuccess) { fprintf(stderr, "kernel_launch: memset failed\n"); return; }
    Args a{};
    for (int i = 0; i < 16; ++i) a.in[i] = (const float*)d_in[i];
    a.out = (float*)d_out; a.ws = (unsigned char*)d_ws;
    void* kargs[] = {&a};
    hipError_t e = hipLaunchCooperativeKernel((const void*)trunk_fwd, dim3(grid), dim3(NWAVES * 64), kargs, LDS_BYTES, stream);
    if (e != hipSuccess) fprintf(stderr, "kernel_launch: cooperative launch failed: %s (grid %d)\n", hipGetErrorString(e), grid);
}
```

```cpp
#include <hip/hip_runtime.h>
#include <cstdio>
#include <cstdint>
__device__ __forceinline__ int opaque_tid() { int t = threadIdx.x; asm volatile("" : "+v"(t)); return t; }
namespace pg8 {
#define PG8_LAS __attribute__((address_space(3)))
typedef unsigned short bf16_t;
typedef short bf16x8 __attribute__((ext_vector_type(8)));
typedef float f32x4 __attribute__((ext_vector_type(4)));
typedef unsigned u32x4 __attribute__((ext_vector_type(4)));
constexpr int BM = 256, BK = 64, HALF = 128, HTB = HALF * BK * 2  , STAGE_BYTES = 8 * HTB, NXCD = 8, WGM = 4;

__host__ __device__ __forceinline__ int lds_byte(int r, int c) { const int st = (r >> 4) * 2 + (c >> 5), rr = r & 15, cc = c & 31, ob = rr * 64 + cc * 2; return st * 1024 + (ob ^ (((ob >> 9) & 1) << 5)); }
__host__ __device__ __forceinline__ void stage_rc(int b, int& R, int& C) { const int st = b / 1024, sb = b % 1024, swz = sb ^ (((sb >> 9) & 1) << 5); R = (st >> 1) * 16 + swz / 64; C = (st & 1) * 32 + (swz % 64) / 2; }
__host__ __device__ __forceinline__ int perm32(int rho) { const int n = rho >> 4, i = rho & 15; return 8 * (i >> 2) + 4 * n + (i & 3); }

struct Unit { int pm, pn; };
struct Gemm { const bf16_t* A; const bf16_t* Bt; int M, N, K; };

struct StaticOrder {
    int nM, nN, nwg, G, c;
    __host__ __device__ void init(int M, int N, int G_, int c_) { nM = M / BM; nN = N / BM; nwg = nM * nN; G = G_; c = c_; }
    __host__ __device__ bool next(int i, Unit& u) const {
        const long L = (long)i * G + c; if (L >= nwg) return false;
        int wgid = (int)L; { const int q = nwg / NXCD, r = nwg % NXCD, xcd = wgid % NXCD, off = wgid / NXCD; wgid = (xcd < r ? xcd * (q + 1) : r * (q + 1) + (xcd - r) * q) + off; }
        const int nig = WGM * nN, gid = wgid / nig, fm = gid * WGM, gsz = (nM - fm) < WGM ? (nM - fm) : WGM;
        u.pm = fm + ((wgid % nig) % gsz); u.pn = (wgid % nig) / gsz; return true;
    }
    __device__ __forceinline__ void a_ready(const Unit&) const {}
    __device__ __forceinline__ void done(const Unit&) const {}
};

__device__ __forceinline__ unsigned cvt_pk_bf16(float lo, float hi) { unsigned r; asm volatile("v_cvt_pk_bf16_f32 %0, %1, %2" : "=v"(r) : "v"(lo), "v"(hi)); return r; }
typedef float f32x2 __attribute__((ext_vector_type(2)));
__device__ __forceinline__ f32x2 gelu_pk(f32x2 v) {
    const f32x2 av = __builtin_elementwise_abs(v), d = av * 0.2316418882f + 1.0f;
    f32x2 t; t.x = __builtin_amdgcn_rcpf(d.x); t.y = __builtin_amdgcn_rcpf(d.y);
    f32x2 q = t * 0.5307027145f + (-0.7265760135f); q = q * t + 0.7107068705f; q = q * t + (-0.142248368f); q = q * t + 0.127414796f; q = q * t;
    const f32x2 s = (v * v) * (-0.72134752044f);
    f32x2 e; e.x = __builtin_amdgcn_exp2f(s.x); e.y = __builtin_amdgcn_exp2f(s.y);
    const f32x2 m = v * (q * e), r = v - m;
    f32x2 o; o.x = v.x < 0.f ? m.x : r.x; o.y = v.y < 0.f ? m.y : r.y; return o;
}

template <int ACT  > struct EpiBf16 {
    static constexpr bool PERM = true, AFTER_DRAIN = false; static_assert(ACT == 0 || ACT == 1, "EpiBf16: ACT is 0 (none) or 1 (gelu_pk)");
    bf16_t* O; int ldc; const float* bias; int split_cols; size_t split_stride; float scale0;
    __device__ __forceinline__ void operator()(const f32x4 (&acc)[2][2][4][2], const Unit& u, int wr, int wc, int fr, int fq) const {
        const int row0 = u.pm * BM + wr * 64 + fr; int colt = u.pn * BM; bf16_t* base = O;
        float sc = 1.f; if (split_cols) { const int t = colt / split_cols; base += (size_t)t * split_stride; colt -= t * split_cols; if (t == 0) sc = scale0; }
        const int col0 = colt + wc * 32 + 8 * fq, bcol0 = u.pn * BM + wc * 32 + 8 * fq;
        f32x4 bv[2][2];
#pragma unroll
        for (int bj = 0; bj < 2; ++bj)
#pragma unroll
            for (int n = 0; n < 2; ++n) bv[bj][n] = bias ? *(const f32x4*)(bias + bcol0 + bj * HALF + 4 * n) : (f32x4){0.f, 0.f, 0.f, 0.f};
#pragma unroll
        for (int ai = 0; ai < 2; ++ai)
#pragma unroll
            for (int m = 0; m < 4; ++m) { bf16_t* rowp = base + (size_t)(row0 + ai * HALF + m * 16) * ldc + col0;
#pragma unroll
                for (int bj = 0; bj < 2; ++bj) { f32x4 v0 = acc[ai][bj][m][0] + bv[bj][0], v1 = acc[ai][bj][m][1] + bv[bj][1];
                    if (ACT == 1) { f32x2 a = gelu_pk((f32x2){v0[0], v0[1]}), b = gelu_pk((f32x2){v0[2], v0[3]}), c = gelu_pk((f32x2){v1[0], v1[1]}), d = gelu_pk((f32x2){v1[2], v1[3]});
                        v0 = (f32x4){a.x, a.y, b.x, b.y}; v1 = (f32x4){c.x, c.y, d.x, d.y}; }
                    v0 = v0 * sc; v1 = v1 * sc; u32x4 w; w.x = cvt_pk_bf16(v0[0], v0[1]); w.y = cvt_pk_bf16(v0[2], v0[3]); w.z = cvt_pk_bf16(v1[0], v1[1]); w.w = cvt_pk_bf16(v1[2], v1[3]);
                    *(u32x4*)(rowp + bj * HALF) = w; } }
    }
};

struct PanelStats {
    unsigned* xbuf;
    unsigned* cnt;
    unsigned* tmo;
    int ntn; float eps;
    unsigned code;
    __device__ __forceinline__ bool run(const f32x4 (&v)[2][2][4][2], const Unit& u, int wr, int wc, int fr, int fq, PG8_LAS unsigned char* lds, int wid, int lane) const {
        typedef float f32x2v __attribute__((ext_vector_type(2)));
        PG8_LAS f32x2v* P = (PG8_LAS f32x2v*)lds;
        PG8_LAS f32x2v* S = (PG8_LAS f32x2v*)(lds + 8192);
        PG8_LAS unsigned* flag = (PG8_LAS unsigned*)(lds + 8192 + 2048);
#pragma unroll
        for (int ai = 0; ai < 2; ++ai)
#pragma unroll
            for (int m = 0; m < 4; ++m) {
                float s = 0.f;
#pragma unroll
                for (int bj = 0; bj < 2; ++bj)
#pragma unroll
                    for (int n = 0; n < 2; ++n) { const f32x4 x = v[ai][bj][m][n]; s += (x[0] + x[1]) + (x[2] + x[3]); }
                s += __shfl_xor(s, 16); s += __shfl_xor(s, 32);
                const float mw = s * (1.0f / 64.0f); float q = 0.f;
#pragma unroll
                for (int bj = 0; bj < 2; ++bj)
#pragma unroll
                    for (int n = 0; n < 2; ++n) { const f32x4 d = v[ai][bj][m][n] - mw; q += (d[0] * d[0] + d[1] * d[1]) + (d[2] * d[2] + d[3] * d[3]); }
                q += __shfl_xor(q, 16); q += __shfl_xor(q, 32);
                if (fq == 0) P[(ai * HALF + wr * 64 + m * 16 + fr) * 4 + wc] = (f32x2v){mw, q};
            }
        asm volatile("s_waitcnt lgkmcnt(0)" ::: "memory"); __builtin_amdgcn_s_barrier(); asm volatile("" ::: "memory");
#if defined(BROKEN_EXCHANGE_NO_WAIT)
#warning BROKEN CONTROL BUILD: the row-statistics exchange does not wait; results are wrong by design
        if (blockIdx.x >= 64) { const long long t0_ = clock64(); while (clock64() - t0_ < 60000) __builtin_amdgcn_s_sleep(8); }
#endif
        const int row = wid * 32 + (lane & 31);
        if (lane < 32) {
            const f32x2v a = P[row * 4 + 0], b = P[row * 4 + 1], c = P[row * 4 + 2], d = P[row * 4 + 3];
            const float mt = (a.x + b.x + c.x + d.x) * 0.25f;
            const float da = a.x - mt, db = b.x - mt, dc = c.x - mt, dd = d.x - mt;
            const float m2 = (a.y + b.y) + (c.y + d.y) + 64.0f * ((da * da + db * db) + (dc * dc + dd * dd));
            unsigned long long* slot = (unsigned long long*)xbuf + ((size_t)(u.pm * BM + row) * 4 + u.pn);
            __hip_atomic_store(slot, ((unsigned long long)__float_as_uint(m2) << 32) | __float_as_uint(mt), __ATOMIC_RELAXED, __HIP_MEMORY_SCOPE_AGENT);
        }
        asm volatile("s_waitcnt vmcnt(0)" ::: "memory");
        if (lane == 0) __hip_atomic_fetch_add(cnt + 64 * u.pm, 1u, __ATOMIC_RELAXED, __HIP_MEMORY_SCOPE_AGENT);
        if (wid == 0) {
            bool dead = false; const unsigned long long t0 = __builtin_amdgcn_s_memrealtime(); const unsigned want = 8u * (unsigned)ntn;
            for (;;) {
#if defined(BROKEN_EXCHANGE_NO_WAIT)
                break;
#endif
                if ((unsigned)__builtin_amdgcn_readfirstlane(__hip_atomic_load(cnt + 64 * u.pm, __ATOMIC_RELAXED, __HIP_MEMORY_SCOPE_AGENT)) >= want) break;
                if (__builtin_amdgcn_s_memrealtime() - t0 > 2000000ull) {
                    if (lane == 0) { unsigned expect = 0u; __hip_atomic_compare_exchange_strong(tmo + 1, &expect, code | (unsigned)(u.pm & 0xff), __ATOMIC_RELAXED, __ATOMIC_RELAXED, __HIP_MEMORY_SCOPE_AGENT);
                                     __hip_atomic_store(tmo, 1u, __ATOMIC_RELAXED, __HIP_MEMORY_SCOPE_AGENT); }
                    dead = true; break; }
                __builtin_amdgcn_s_sleep(2);
            }
            __builtin_amdgcn_fence(__ATOMIC_ACQUIRE, "agent");
            if (lane == 0) flag[0] = dead ? 1u : 0u;
        }
        asm volatile("s_waitcnt vmcnt(0) lgkmcnt(0)" ::: "memory"); __builtin_amdgcn_s_barrier(); asm volatile("" ::: "memory");
        const bool bad = flag[0] != 0u;
        if (lane < 32) {
            const unsigned long long* slot = (const unsigned long long*)xbuf + (size_t)(u.pm * BM + row) * 4; float mt[4], m2[4]; float ms = 0.f;
#pragma unroll
            for (int t = 0; t < 4; ++t) { if (t < ntn) { const unsigned long long w = __hip_atomic_load(slot + t, __ATOMIC_RELAXED, __HIP_MEMORY_SCOPE_AGENT); mt[t] = __uint_as_float((unsigned)w); m2[t] = __uint_as_float((unsigned)(w >> 32)); } else { mt[t] = 0.f; m2[t] = 0.f; } ms += mt[t]; }
            const float mean = ms / (float)ntn; float q = 0.f;
#pragma unroll
            for (int t = 0; t < 4; ++t) if (t < ntn) { const float dm = mt[t] - mean; q += m2[t] + 256.0f * dm * dm; }
            S[row] = (f32x2v){mean, 1.0f / sqrtf(q / (256.0f * (float)ntn) + eps)};
        }
        asm volatile("s_waitcnt lgkmcnt(0)" ::: "memory"); __builtin_amdgcn_s_barrier(); asm volatile("" ::: "memory");
        return bad;
    }
};
struct EpiLnRes {
    static constexpr bool PERM = false, AFTER_DRAIN = true;
    const float* base; float* out; int ldc; const float* bias; PanelStats st; unsigned poison;
    __device__ __forceinline__ void fused(f32x4 (&acc)[2][2][4][2], const Unit& u, int wr, int wc, int fr, int fq, PG8_LAS unsigned char* lds, int wid, int lane) const {
        typedef float f32x2v __attribute__((ext_vector_type(2)));
        const PG8_LAS f32x2v* S = (const PG8_LAS f32x2v*)(lds + 8192);
        const int col0 = u.pn * BM + wc * 32 + 4 * fq;
#pragma unroll
        for (int bj = 0; bj < 2; ++bj)
#pragma unroll
            for (int n = 0; n < 2; ++n) { const f32x4 bv = bias ? *(const f32x4*)(bias + col0 + bj * HALF + n * 16) : (f32x4){0.f, 0.f, 0.f, 0.f};
#pragma unroll
                for (int ai = 0; ai < 2; ++ai)
#pragma unroll
                    for (int m = 0; m < 4; ++m) acc[ai][bj][m][n] += bv; }
        f32x4 pre[4][2][2];
#pragma unroll
        for (int m = 0; m < 4; ++m) { const size_t off = (size_t)(u.pm * BM + wr * 64 + m * 16 + fr) * ldc + col0;
#pragma unroll
            for (int bj = 0; bj < 2; ++bj)
#pragma unroll
                for (int n = 0; n < 2; ++n) pre[m][bj][n] = *(const f32x4*)(base + off + bj * HALF + n * 16); }
        const bool bad = st.run(acc, u, wr, wc, fr, fq, lds, wid, lane) || poison != 0u;
        const float qnan = __builtin_nanf("");
#pragma unroll
        for (int ai = 0; ai < 2; ++ai)
#pragma unroll
            for (int m = 0; m < 4; ++m) { const int r = ai * HALF + wr * 64 + m * 16 + fr; const f32x2v sr = S[r]; const size_t off = (size_t)(u.pm * BM + r) * ldc + col0;
#pragma unroll
                for (int bj = 0; bj < 2; ++bj)
#pragma unroll
                    for (int n = 0; n < 2; ++n) { const f32x4 bs = ai == 0 ? pre[m][bj][n] : *(const f32x4*)(base + off + bj * HALF + n * 16); f32x4 o = bs + (acc[ai][bj][m][n] - sr.x) * sr.y;
                        if (bad) o = (f32x4){qnan, qnan, qnan, qnan}; *(f32x4*)(out + off + bj * HALF + n * 16) = o; }
                if (m & 1) asm volatile("" ::: "memory"); }
    }
};
struct EpiLnResLn {
    static constexpr bool PERM = false, AFTER_DRAIN = true;
    const float* base; float* out; bf16_t* xn; int ldc; const float* bias; PanelStats st1, st2; unsigned poison;
    __device__ __forceinline__ void fused(f32x4 (&acc)[2][2][4][2], const Unit& u, int wr, int wc, int fr, int fq, PG8_LAS unsigned char* lds, int wid, int lane) const {
        typedef float f32x2v __attribute__((ext_vector_type(2))); typedef unsigned u32x2v __attribute__((ext_vector_type(2)));
        const PG8_LAS f32x2v* S = (const PG8_LAS f32x2v*)(lds + 8192);
        const int col0 = u.pn * BM + wc * 32 + 4 * fq;
#pragma unroll
        for (int bj = 0; bj < 2; ++bj)
#pragma unroll
            for (int n = 0; n < 2; ++n) { const f32x4 bv = bias ? *(const f32x4*)(bias + col0 + bj * HALF + n * 16) : (f32x4){0.f, 0.f, 0.f, 0.f};
#pragma unroll
                for (int ai = 0; ai < 2; ++ai)
#pragma unroll
                    for (int m = 0; m < 4; ++m) acc[ai][bj][m][n] += bv; }
        bool bad = st1.run(acc, u, wr, wc, fr, fq, lds, wid, lane) || poison != 0u;
        const float qnan = __builtin_nanf("");
#pragma unroll
        for (int ai = 0; ai < 2; ++ai)
#pragma unroll
            for (int m = 0; m < 4; ++m) { const int r = ai * HALF + wr * 64 + m * 16 + fr; const f32x2v sr = S[r]; const size_t off = (size_t)(u.pm * BM + r) * ldc + col0;
#pragma unroll
                for (int bj = 0; bj < 2; ++bj)
#pragma unroll
                    for (int n = 0; n < 2; ++n) { const f32x4 bs = *(const f32x4*)(base + off + bj * HALF + n * 16); acc[ai][bj][m][n] = bs + (acc[ai][bj][m][n] - sr.x) * sr.y; }
                asm volatile("" : "+v"(acc[ai][0][m][0]), "+v"(acc[ai][0][m][1]), "+v"(acc[ai][1][m][0]), "+v"(acc[ai][1][m][1]));
                if (m & 1) asm volatile("" ::: "memory"); }
        const bool bad1 = bad;
        bad = st2.run(acc, u, wr, wc, fr, fq, lds, wid, lane) || bad;
#pragma unroll
        for (int ai = 0; ai < 2; ++ai)
#pragma unroll
            for (int m = 0; m < 4; ++m) { const int r = ai * HALF + wr * 64 + m * 16 + fr; const f32x2v sr = S[r]; const size_t off = (size_t)(u.pm * BM + r) * ldc + col0;
#pragma unroll
                for (int bj = 0; bj < 2; ++bj)
#pragma unroll
                    for (int n = 0; n < 2; ++n) { const f32x4 x1 = acc[ai][bj][m][n]; *(f32x4*)(out + off + bj * HALF + n * 16) = bad1 ? (f32x4){qnan, qnan, qnan, qnan} : x1;
                        const f32x4 o = (x1 - sr.x) * sr.y; u32x2v w; w.x = cvt_pk_bf16(o[0], o[1]); w.y = cvt_pk_bf16(o[2], o[3]);
                        if (bad) { w.x = 0x7fc07fc0u; w.y = 0x7fc07fc0u; } *(u32x2v*)(xn + off + bj * HALF + n * 16) = w; }
                asm volatile("" ::: "memory"); }
    }
};

template <class Epi, class Sched, bool ALIGN_EPI = false, bool SP2 = false>
__device__ __forceinline__ void gemm_phase(PG8_LAS unsigned char* lds, const Gemm g, const Sched& S, const Epi& E) {
    const int tid = opaque_tid(), wid = __builtin_amdgcn_readfirstlane(tid >> 6), lane = tid & 63, wr = wid >> 2, wc = wid & 3, fr = lane & 15, fq = lane >> 4;
    const int K = g.K, nt = K / BK;
    unsigned voffA[2], voffB[2];
#pragma unroll
    for (int i = 0; i < 2; ++i) { int R, C; stage_rc(tid * 16 + i * 8192, R, C); const int Rb = Epi::PERM ? ((R & ~31) + perm32(R & 31)) : R;
        voffA[i] = (unsigned)(R * K + C) * 2u; voffB[i] = (unsigned)(Rb * K + C) * 2u; }
    const size_t kstep = (size_t)(BK * 2);
    const size_t hstep = (size_t)HALF * K * 2;
    const size_t tstep = 2 * hstep;
    const unsigned ldsw = (unsigned)wid * 1024u;
    const int aoff = lds_byte(wr * 64 + fr, fq * 8), boff = lds_byte(wc * 32 + fr, fq * 8);
#define PG8_SA(b, h) (((b) * 2 + (h)) * HTB)
#define PG8_SB(b, h) ((4 + (b) * 2 + (h)) * HTB)
#define PG8_STAGE(bufoff, gbase, voff) do { _Pragma("unroll") for (int _i = 0; _i < 2; ++_i) \
        __builtin_amdgcn_global_load_lds((const unsigned*)((const char*)(gbase) + (voff)[_i]), (PG8_LAS unsigned*)(lds + (bufoff) + ldsw + _i * 8192), 16, 0, 0); } while (0)
#define PG8_LDA(dst, b, h) do { _Pragma("unroll") for (int m = 0; m < 4; ++m) _Pragma("unroll") for (int k = 0; k < 2; ++k) dst[m][k] = *(const PG8_LAS bf16x8*)(lds + PG8_SA(b, h) + aoff + m * 2048 + k * 1024); } while (0)
#define PG8_LDB(dst, b, h) do { _Pragma("unroll") for (int n = 0; n < 2; ++n) _Pragma("unroll") for (int k = 0; k < 2; ++k) dst[n][k] = *(const PG8_LAS bf16x8*)(lds + PG8_SB(b, h) + boff + n * 2048 + k * 1024); } while (0)
#define PG8_MMA(ai, bj, At, Bt) do { __builtin_amdgcn_s_setprio(1); _Pragma("unroll") for (int m = 0; m < 4; ++m) _Pragma("unroll") for (int n = 0; n < 2; ++n) _Pragma("unroll") for (int k = 0; k < 2; ++k) \
        acc[ai][bj][m][n] = __builtin_amdgcn_mfma_f32_16x16x32_bf16(Bt[n][k], At[m][k], acc[ai][bj][m][n], 0, 0, 0); __builtin_amdgcn_s_setprio(0); } while (0)
#define PG8_WAIT_V(n) asm volatile("s_waitcnt vmcnt(" #n ")" ::: "memory")
#define PG8_WAIT_L(n) asm volatile("s_waitcnt lgkmcnt(" #n ")" ::: "memory")
#define PG8_BAR __builtin_amdgcn_s_barrier()
#define PG8_SCHED __builtin_amdgcn_sched_barrier(0)
    Unit cur, nxt; int ui = 0;
    if (!S.next(0, cur)) return;
    f32x4 acc[2][2][4][2];
#pragma unroll
    for (int a = 0; a < 2; ++a)
#pragma unroll
        for (int b = 0; b < 2; ++b)
#pragma unroll
            for (int m = 0; m < 4; ++m)
#pragma unroll
                for (int n = 0; n < 2; ++n) acc[a][b][m][n] = (f32x4){0.f, 0.f, 0.f, 0.f};
    bf16x8 At[4][2], B0[2][2], B1[2][2];
    const char* cA = (const char*)g.A + (size_t)cur.pm * tstep; const char* cB = (const char*)g.Bt + (size_t)cur.pn * tstep;
    S.a_ready(cur);
    if constexpr (SP2) {
        PG8_STAGE(PG8_SB(0, 0), cB, voffB); PG8_STAGE(PG8_SB(0, 1), cB + hstep, voffB); PG8_STAGE(PG8_SA(0, 0), cA, voffA); PG8_STAGE(PG8_SA(0, 1), cA + hstep, voffA);
        if (wr == 1) PG8_BAR;
        PG8_WAIT_V(2); PG8_BAR;
        PG8_STAGE(PG8_SB(1, 0), cB + kstep, voffB); PG8_STAGE(PG8_SA(1, 0), cA + kstep, voffA); PG8_STAGE(PG8_SB(1, 1), cB + hstep + kstep, voffB);
        PG8_WAIT_V(6); PG8_BAR;
    } else {
        PG8_STAGE(PG8_SB(0, 0), cB, voffB); PG8_STAGE(PG8_SA(0, 0), cA, voffA); PG8_STAGE(PG8_SB(0, 1), cB + hstep, voffB); PG8_STAGE(PG8_SA(0, 1), cA + hstep, voffA);
        if (wr == 1) PG8_BAR;
        PG8_WAIT_V(4); PG8_BAR;
        PG8_STAGE(PG8_SB(1, 0), cB + kstep, voffB); PG8_STAGE(PG8_SA(1, 0), cA + kstep, voffA); PG8_STAGE(PG8_SB(1, 1), cB + hstep + kstep, voffB);
        PG8_WAIT_V(6); PG8_BAR;
    }
    for (;;) {
        const bool has_next = S.next(ui + 1, nxt);
        const char* nA = has_next ? (const char*)g.A + (size_t)nxt.pm * tstep : cA; const char* nB = has_next ? (const char*)g.Bt + (size_t)nxt.pn * tstep : cB;
        for (int t = 0; t < nt; t += 2) {
            const bool last = (t == nt - 2);
            const char* a1 = cA + (size_t)(t + 1) * kstep;
            const char* a2 = last ? nA : cA + (size_t)(t + 2) * kstep; const char* b2 = last ? nB : cB + (size_t)(t + 2) * kstep;
            const char* a3 = a2 + kstep; const char* b3 = b2 + kstep;
            if (last && has_next) S.a_ready(nxt);
            if constexpr (SP2) {
            PG8_LDB(B0, 0, 0); PG8_LDB(B1, 0, 1); PG8_SCHED; PG8_LDA(At, 0, 0); PG8_STAGE(PG8_SA(1, 1), a1 + hstep, voffA);
            PG8_WAIT_V(8); PG8_WAIT_L(0); PG8_BAR; PG8_MMA(0, 0, At, B0); PG8_MMA(0, 1, At, B1); PG8_BAR; PG8_SCHED;
            PG8_LDA(At, 0, 1); PG8_STAGE(PG8_SB(0, 0), b2, voffB); PG8_STAGE(PG8_SB(0, 1), b2 + hstep, voffB); PG8_STAGE(PG8_SA(0, 0), a2, voffA);
            PG8_WAIT_V(8); PG8_WAIT_L(0); PG8_BAR; PG8_MMA(1, 0, At, B0); PG8_MMA(1, 1, At, B1); PG8_BAR; PG8_SCHED;
            PG8_LDB(B0, 1, 0); PG8_LDB(B1, 1, 1); PG8_SCHED; PG8_LDA(At, 1, 0); PG8_STAGE(PG8_SA(0, 1), a2 + hstep, voffA);
            PG8_WAIT_V(8); PG8_WAIT_L(0); PG8_BAR; PG8_MMA(0, 0, At, B0); PG8_MMA(0, 1, At, B1); PG8_BAR; PG8_SCHED;
            PG8_LDA(At, 1, 1); PG8_STAGE(PG8_SB(1, 0), b3, voffB); PG8_STAGE(PG8_SB(1, 1), b3 + hstep, voffB); PG8_STAGE(PG8_SA(1, 0), a3, voffA);
            PG8_WAIT_V(8); PG8_WAIT_L(0); PG8_BAR; PG8_MMA(1, 0, At, B0); PG8_MMA(1, 1, At, B1); PG8_BAR; PG8_SCHED;
            } else {
            PG8_LDB(B0, 0, 0); PG8_SCHED; PG8_LDA(At, 0, 0); PG8_STAGE(PG8_SA(1, 1), a1 + hstep, voffA);
            PG8_WAIT_L(8); PG8_BAR; PG8_WAIT_L(0); PG8_MMA(0, 0, At, B0); PG8_BAR; PG8_SCHED;
            PG8_LDB(B1, 0, 1); PG8_STAGE(PG8_SB(0, 0), b2, voffB);
            PG8_BAR; PG8_WAIT_L(0); PG8_MMA(0, 1, At, B1); PG8_BAR;
            PG8_LDA(At, 0, 1); PG8_STAGE(PG8_SA(0, 0), a2, voffA);
            PG8_BAR; PG8_WAIT_L(0); PG8_MMA(1, 0, At, B0); PG8_BAR; PG8_SCHED;
            PG8_STAGE(PG8_SB(0, 1), b2 + hstep, voffB);
            PG8_WAIT_V(6); PG8_BAR; PG8_MMA(1, 1, At, B1); PG8_BAR;
            PG8_LDB(B0, 1, 0); PG8_SCHED; PG8_LDA(At, 1, 0); PG8_STAGE(PG8_SA(0, 1), a2 + hstep, voffA);
            PG8_WAIT_L(8); PG8_BAR; PG8_WAIT_L(0); PG8_MMA(0, 0, At, B0); PG8_BAR; PG8_SCHED;
            PG8_LDB(B1, 1, 1); PG8_STAGE(PG8_SB(1, 0), b3, voffB);
            PG8_BAR; PG8_WAIT_L(0); PG8_MMA(0, 1, At, B1); PG8_BAR;
            PG8_LDA(At, 1, 1); PG8_STAGE(PG8_SA(1, 0), a3, voffA);
            PG8_BAR; PG8_WAIT_L(0); PG8_MMA(1, 0, At, B0); PG8_BAR; PG8_SCHED;
            PG8_STAGE(PG8_SB(1, 1), b3 + hstep, voffB);
            PG8_WAIT_V(6); PG8_BAR; PG8_MMA(1, 1, At, B1); PG8_BAR;
            }
        }
        if constexpr (ALIGN_EPI) { if (wr == 0) PG8_BAR; }
        if constexpr (!Epi::AFTER_DRAIN) { E(acc, cur, wr, wc, fr, fq); S.done(cur); }
        if (!has_next) break;
#pragma unroll
        for (int a = 0; a < 2; ++a)
#pragma unroll
            for (int b = 0; b < 2; ++b)
#pragma unroll
                for (int m = 0; m < 4; ++m)
#pragma unroll
                    for (int n = 0; n < 2; ++n) acc[a][b][m][n] = (f32x4){0.f, 0.f, 0.f, 0.f};
        cur = nxt; cA = nA; cB = nB; ++ui;
        if constexpr (ALIGN_EPI) { if (wr == 1) PG8_BAR; }
    }
    PG8_WAIT_V(0);
    if constexpr (!ALIGN_EPI) { if (wr == 0) PG8_BAR; }
    PG8_BAR;
    if constexpr (Epi::AFTER_DRAIN) { E.fused(acc, cur, wr, wc, fr, fq, lds, wid, lane); S.done(cur); }
#undef PG8_SA
#undef PG8_SB
#undef PG8_STAGE
#undef PG8_LDA
#undef PG8_LDB
#undef PG8_MMA
#undef PG8_WAIT_V
#undef PG8_WAIT_L
#undef PG8_BAR
#undef PG8_SCHED
}
}
namespace pg8 {
struct EpiSwiGLU {
    static constexpr bool PERM = true, AFTER_DRAIN = false;
    bf16_t* O; int ldc;
    static __device__ __forceinline__ float silu_mul(float g, float u) { const float e = __builtin_amdgcn_exp2f(-1.4426950408889634f * g); return g * __builtin_amdgcn_rcpf(1.0f + e) * u; }
    __device__ __forceinline__ void operator()(const f32x4 (&acc)[2][2][4][2], const Unit& u, int wr, int wc, int fr, int fq) const {
        const int row0 = u.pm * BM + wr * 64 + fr, col0 = u.pn * HALF + wc * 32 + 8 * fq;
#pragma unroll
        for (int ai = 0; ai < 2; ++ai)
#pragma unroll
            for (int m = 0; m < 4; ++m) { bf16_t* rowp = O + (size_t)(row0 + ai * HALF + m * 16) * ldc + col0;
                const f32x4 g0 = acc[ai][0][m][0], g1 = acc[ai][0][m][1], u0 = acc[ai][1][m][0], u1 = acc[ai][1][m][1];
                u32x4 w; w.x = cvt_pk_bf16(silu_mul(g0[0], u0[0]), silu_mul(g0[1], u0[1])); w.y = cvt_pk_bf16(silu_mul(g0[2], u0[2]), silu_mul(g0[3], u0[3]));
                w.z = cvt_pk_bf16(silu_mul(g1[0], u1[0]), silu_mul(g1[1], u1[1])); w.w = cvt_pk_bf16(silu_mul(g1[2], u1[2]), silu_mul(g1[3], u1[3]));
                *(u32x4*)rowp = w; }
    }
};
struct EpiQKV {
    static constexpr bool PERM = true, AFTER_DRAIN = false;
    bf16_t* Q; size_t buf_stride; const float* rope; float scale0;
    __device__ __forceinline__ void operator()(const f32x4 (&acc)[2][2][4][2], const Unit& u, int wr, int wc, int fr, int fq) const {
        const int t = u.pn >> 2; bf16_t* base = Q + (size_t)t * buf_stride; const float sc = (t == 0) ? scale0 : 1.f;
        const int col0 = (u.pn & 3) * BM + wc * 32 + 8 * fq;
        const bool rot = (t < 2) && ((wc & 1) == 0);
        const float sgn = (fq == 0) ? -1.f : 1.f;
#pragma unroll
        for (int ai = 0; ai < 2; ++ai)
#pragma unroll
            for (int m = 0; m < 4; ++m) { const int r = ai * HALF + wr * 64 + m * 16 + fr; int orow, pos; bool valid = true;
                if (u.pm < 64) { orow = (u.pm >> 3) * 2112 + 64 + (u.pm & 7) * 256 + r; pos = 16 + (u.pm & 7) * 256 + r; }
                else { valid = r < 128; orow = (r >> 4) * 2112 + 48 + (r & 15); pos = r & 15; }
                f32x4 cs0 = {1.f, 1.f, 1.f, 1.f}, cs1 = cs0, sn0 = {0.f, 0.f, 0.f, 0.f}, sn1 = sn0;
                if (rot && fq < 2) { const f32x4* rp = (const f32x4*)(rope + (size_t)pos * 16); cs0 = rp[0]; cs1 = rp[1]; sn0 = rp[2]; sn1 = rp[3]; }
#pragma unroll
                for (int bj = 0; bj < 2; ++bj) { f32x4 v0 = acc[ai][bj][m][0], v1 = acc[ai][bj][m][1];
                    if (rot) { f32x4 o0, o1;
#pragma unroll
                        for (int i = 0; i < 4; ++i) { o0[i] = __shfl_xor(v0[i], 16); o1[i] = __shfl_xor(v1[i], 16); }
                        v0 = v0 * cs0 + (o0 * sn0) * sgn; v1 = v1 * cs1 + (o1 * sn1) * sgn; }
                    v0 = v0 * sc; v1 = v1 * sc; u32x4 w; w.x = cvt_pk_bf16(v0[0], v0[1]); w.y = cvt_pk_bf16(v0[2], v0[3]); w.z = cvt_pk_bf16(v1[0], v1[1]); w.w = cvt_pk_bf16(v1[2], v1[3]);
                    if (valid) *(u32x4*)(base + (size_t)orow * 1024 + col0 + bj * HALF) = w; } }
    }
};
}
#include <hip/hip_bf16.h>
#include <cmath>
namespace attn_body {
using bf16=__hip_bfloat16;
using bf16x8=__attribute__((ext_vector_type(8)))short;
using s16x4=__attribute__((ext_vector_type(4)))short;
using f32x16=__attribute__((ext_vector_type(16)))float;
using u32x4=__attribute__((ext_vector_type(4)))unsigned;
constexpr int D=64,DM=1024,OPITCH=2048,BSTRIDE=2112,FRONT=48,RVEND=2112;
constexpr int NW=8,QBLK=32,QB=QBLK*NW,KVBLK=64,NQB=9;
constexpr int ATTN_PITCH=DM, ATTN_UNIT_ROWS=QB;
__device__ __forceinline__ int crow(int r,int hi){return (r&3)+8*(r>>2)+4*hi;}
#define SBAR() __builtin_amdgcn_sched_barrier(0)
__device__ __forceinline__ void cmask(f32x16&p0,f32x16&p1,int jb,int qrel,int hi){
  const float NEG=-INFINITY; int kb=64*jb+4*hi;
  #pragma unroll
  for(int r=0;r<16;++r){int kv=kb+(r&3)+8*(r>>2); if(kv>qrel)p0[r]=NEG; if(kv+32>qrel)p1[r]=NEG;}
}

constexpr int NSLOT=3, SLOTB=8192;
constexpr int LDS_K=0, LDS_V=NSLOT*SLOTB, LDS_WS=3*NSLOT*SLOTB, LDS_OST=LDS_WS+NW*64*4, LDS_BYTES=LDS_OST+NW*4096;
constexpr float C2=0.125f*1.4426950408889634f;
__device__ __forceinline__ void glds16(const void*gsrc,unsigned lds_dst){unsigned keep;
  asm volatile("s_mov_b32 %0, m0\n\ts_mov_b32 m0, %2\n\ts_nop 0\n\tglobal_load_lds_dwordx4 %1, off\n\ts_mov_b32 m0, %0":"=&s"(keep):"v"(gsrc),"s"(lds_dst):"memory");}
__device__ __forceinline__ float max3f(float a,float b,float c){float r;asm("v_max3_f32 %0, %1, %2, %3":"=v"(r):"v"(a),"v"(b),"v"(c));return r;}
__device__ __forceinline__ float max2f(float a,float b){float r;asm("v_max_f32_e32 %0, %1, %2":"=v"(r):"v"(a),"v"(b));return r;}
__device__ __forceinline__ float fadd_s(float a,float b){float r;asm("v_add_f32_e32 %0, %1, %2":"=v"(r):"v"(a),"v"(b));return r;}
__device__ __forceinline__ float fsub_s(float a,float b){float r;asm("v_sub_f32_e32 %0, %1, %2":"=v"(r):"v"(a),"v"(b));return r;}
typedef float f32x2_t __attribute__((ext_vector_type(2))); typedef __bf16 bf16x2_t __attribute__((ext_vector_type(2)));
__device__ __forceinline__ unsigned cvtpk_s(float lo,float hi){f32x2_t v={lo,hi};bf16x2_t b=__builtin_convertvector(v,bf16x2_t);return __builtin_bit_cast(unsigned,b);}
#define WAIT_BAR(N) asm volatile("s_waitcnt vmcnt(" #N ") lgkmcnt(0)\n\ts_barrier":::"memory")

__device__ __forceinline__ void qkt(f32x16&p0,f32x16&p1,const char*Kslot,const bf16x8*qr,const f32x16&negm,int r32,int hi){
  const char*kb=Kslot+hi*1024+r32*16;
  #pragma unroll
  for(int d0=0;d0<4;++d0){
    const bf16x8 b0=*reinterpret_cast<const bf16x8*>(kb+d0*2048);
    const bf16x8 b1=*reinterpret_cast<const bf16x8*>(kb+d0*2048+512);
    if(d0==0){p0=__builtin_amdgcn_mfma_f32_32x32x16_bf16(b0,qr[0],negm,0,0,0);p1=__builtin_amdgcn_mfma_f32_32x32x16_bf16(b1,qr[0],negm,0,0,0);}
    else{p0=__builtin_amdgcn_mfma_f32_32x32x16_bf16(b0,qr[d0],p0,0,0,0);p1=__builtin_amdgcn_mfma_f32_32x32x16_bf16(b1,qr[d0],p1,0,0,0);}}
}
typedef __attribute__((address_space(3))) const char* lds_cptr;
typedef short v4i16_t __attribute__((ext_vector_type(4)));
__device__ __forceinline__ void kload8(bf16x8*kf,lds_cptr kp){
  kf[0]=*(const __attribute__((address_space(3))) bf16x8*)(kp);      kf[1]=*(const __attribute__((address_space(3))) bf16x8*)(kp+512);
  kf[2]=*(const __attribute__((address_space(3))) bf16x8*)(kp+2048); kf[3]=*(const __attribute__((address_space(3))) bf16x8*)(kp+2560);
  kf[4]=*(const __attribute__((address_space(3))) bf16x8*)(kp+4096); kf[5]=*(const __attribute__((address_space(3))) bf16x8*)(kp+4608);
  kf[6]=*(const __attribute__((address_space(3))) bf16x8*)(kp+6144); kf[7]=*(const __attribute__((address_space(3))) bf16x8*)(kp+6656);
}
__device__ __forceinline__ void kload2(bf16x8*kf,lds_cptr kp,int j){ kf[2*j]=*(const __attribute__((address_space(3))) bf16x8*)(kp+j*2048); kf[2*j+1]=*(const __attribute__((address_space(3))) bf16x8*)(kp+j*2048+512); }
__device__ __forceinline__ s16x4 vtr(lds_cptr p){ return __builtin_bit_cast(s16x4,__builtin_amdgcn_ds_read_tr16_b64_v4i16((__attribute__((address_space(3))) v4i16_t*)p)); }
__device__ __forceinline__ float rowmax(const f32x16&p0,const f32x16&p1){
  float a=max3f(p0[0],p0[1],p1[0]),b=max3f(p0[2],p0[3],p1[1]);a=max3f(a,p1[2],p1[3]);
  #pragma unroll
  for(int r=4;r<16;r+=4){a=max3f(a,p0[r],p0[r+1]);b=max3f(b,p0[r+2],p0[r+3]);a=max3f(a,p1[r],p1[r+1]);b=max3f(b,p1[r+2],p1[r+3]);}
  const float m=max2f(a,b);
  auto rr=__builtin_amdgcn_permlane32_swap(__float_as_uint(m),__float_as_uint(m),false,false);
  return max2f(__uint_as_float(rr[0]),__uint_as_float(rr[1]));
}
__device__ __forceinline__ void pv(f32x16*o,int vb,bf16x8 pa0,bf16x8 pa1,bf16x8 pa2,bf16x8 pa3){
  #pragma unroll
  for(int d0=0;d0<2;++d0){s16x4 lo[4],hi[4];
    #pragma unroll
    for(int ks=0;ks<4;++ks){
      asm volatile("ds_read_b64_tr_b16 %0,%1 offset:%c2":"=&v"(lo[ks]):"v"(vb),"i"(d0*4096+ks*1024):"memory");
      asm volatile("ds_read_b64_tr_b16 %0,%1 offset:%c2":"=&v"(hi[ks]):"v"(vb),"i"(d0*4096+ks*1024+512):"memory");}
    asm volatile("s_waitcnt lgkmcnt(0)":::"memory");SBAR();
    #define PK(k) (bf16x8){lo[k][0],lo[k][1],lo[k][2],lo[k][3],hi[k][0],hi[k][1],hi[k][2],hi[k][3]}
    o[d0]=__builtin_amdgcn_mfma_f32_32x32x16_bf16(pa0,PK(0),o[d0],0,0,0);
    o[d0]=__builtin_amdgcn_mfma_f32_32x32x16_bf16(pa1,PK(1),o[d0],0,0,0);
    o[d0]=__builtin_amdgcn_mfma_f32_32x32x16_bf16(pa2,PK(2),o[d0],0,0,0);
    o[d0]=__builtin_amdgcn_mfma_f32_32x32x16_bf16(pa3,PK(3),o[d0],0,0,0);
    #undef PK
  }
}

#ifndef ATTN_STORE16
#define ATTN_STORE16(p,v) (*(u32x4*)(p)=(v))
#endif
template<int THRL,bool ODD> __device__ __forceinline__ void attn_unit(int b,int cq,int cv,int co,int q0,const bf16*Q,const bf16*__restrict__ K,const bf16*__restrict__ V,bf16*O,char*shm){
  const int tid=opaque_tid(),lane=tid&63,r32=lane&31,hi=lane>>5; const int wid=__builtin_amdgcn_readfirstlane(tid>>6);
  const long rowbase=(long)b*BSTRIDE;
  const bf16*Qw=Q+(rowbase+q0+wid*QBLK)*DM+cq;
  const bf16*Kh=K+rowbase*DM+cq,*Vh=V+rowbase*DM+cv;
  const unsigned lds0=(unsigned)(uintptr_t)shm;
  float*wsf=(float*)(shm+LDS_WS)+wid*64;
  const bf16*ksrc=Kh+(long)lane*DM+wid*8;
  const bf16*vsrc=Vh+(long)(16*(wid&3)+(lane>>2))*DM+(wid>>2)*32+(lane&3)*8;
  const unsigned kdst=lds0+LDS_K+wid*1024, vdst=lds0+LDS_V+wid*1024;
  #define DMA_K(t,slot) glds16(ksrc+(long)(t)*KVBLK*DM,(unsigned)__builtin_amdgcn_readfirstlane(kdst+(slot)))
  #define DMA_V(t,slot) do{ glds16(vsrc+(long)(t)*KVBLK*DM,(unsigned)__builtin_amdgcn_readfirstlane(vdst+2*(slot))); glds16(vsrc+(long)(t)*KVBLK*DM+64,(unsigned)__builtin_amdgcn_readfirstlane(vdst+2*(slot)+SLOTB)); }while(0)
  const int vb0=(int)(lds0+LDS_V)+((lane>>4)&1)*32+(lane&3)*8+(4*hi+((lane&15)>>2))*64;
  const char*Kbase=shm+LDS_K; bf16x8 kf[8];
  const lds_cptr shm3=(lds_cptr)shm; const lds_cptr kp0=shm3+LDS_K+hi*1024+r32*16; const lds_cptr vp0=shm3+LDS_V+((lane>>4)&1)*32+(lane&3)*8+(4*hi+((lane&15)>>2))*64;
  const int NT=(q0+QB)/KVBLK;
  DMA_K(0,0);DMA_V(0,0);DMA_K(1,SLOTB);
  bf16x8 qr[4];
  #pragma unroll
  for(int d0=0;d0<4;++d0)qr[d0]=*reinterpret_cast<const bf16x8*>(&Qw[(long)r32*DM+d0*16+hi*8]);
  float mhat=0.f,l_reg=0.f;f32x16 o[4];o[0]=f32x16{};o[1]=f32x16{};o[2]=f32x16{};o[3]=f32x16{};const f32x16 zero16=f32x16{};
  const int qrel=wid*QBLK+r32;
  #define CMASK(P0,P1,t) do{int jb_=(t)-(NT-4); if(jb_>=0)cmask(P0,P1,jb_,qrel,hi);}while(0)
  #define CM1(P0,P1,t,r) do{int jb_=(t)-(NT-4); if(jb_>=0){ const int kv_=64*jb_+4*hi+((r)&3)+8*((r)>>2); if(kv_>qrel)P0[r]=-INFINITY; if(kv_+32>qrel)P1[r]=-INFINITY; } }while(0)
  bool resc=false;
  #define START(P0,P1) do{ const float rm=rowmax(P0,P1); resc=false; \
    { const float dl=rm; mhat=fadd_s(mhat,dl); \
      _Pragma("unroll") for(int r=0;r<16;++r){P0[r]=fsub_s(P0[r],dl);P1[r]=fsub_s(P1[r],dl);} \
      } \
    _Pragma("unroll") for(int r=0;r<16;++r)P0[r]=__builtin_amdgcn_exp2f(P0[r]); }while(0)
  #define RESC() do{ if(resc){ asm volatile("s_waitcnt lgkmcnt(0)":::"memory"); \
      _Pragma("unroll") for(int d_=0;d_<4;++d_) _Pragma("unroll") for(int r=0;r<16;++r)o[d_][r]*=wsf[crow(r,hi)]; } }while(0)
  f32x16 pA0,pA1,pB0,pB1;
  int sl_prev=0,sl_cur=0,sl_next=SLOTB;
  #define ROT() do{sl_prev=sl_cur;sl_cur=sl_next;sl_next=(sl_next==(NSLOT-1)*SLOTB)?0:sl_next+SLOTB;}while(0)
  DMA_K(2,2*SLOTB);
  WAIT_BAR(3);
  qkt(pA0,pA1,Kbase,qr,zero16,r32,hi);asm volatile("s_nop 15\n\ts_nop 7":"+v"(pA0),"+v"(pA1));CMASK(pA0,pA1,0);
  if(q0+qrel>=FRONT){ _Pragma("unroll") for(int r=0;r<16;++r)pA0[r]=-INFINITY; _Pragma("unroll") for(int r=0;r<8;++r)pA1[r]=-INFINITY; }
  START(pA0,pA1);
  _Pragma("unroll") for(int r=0;r<16;++r)pA1[r]=__builtin_amdgcn_exp2f(pA1[r]);
  WAIT_BAR(0);
  DMA_K(3,0);DMA_V(1,SLOTB);
  ROT();
  kload8(kf,kp0+sl_cur);
  WAIT_BAR(3);
  s16x4 vlo[8],vhi[8]; u32x4 pw0,pw1,pw2,pw3;
  #define PKW(P,B) cvtpk_s(P[B],P[B+1])
  #define PAF(k) __builtin_bit_cast(bf16x8,pw##k)
  #define PIN(x) asm volatile("":"+v"(x))
  #define MX3(a,b,c) __builtin_fmaxf(__builtin_fmaxf((a),(b)),(c))
  #define GAPA(MF,A0,A1,A2,A3,W0,W1,PW) do{ MF; sacc+=A0; sacc+=A1; sacc+=A2; sacc+=A3; PIN(sacc); W0; W1; PIN(PW); SBAR(); }while(0)
  #define EX(v) __builtin_amdgcn_exp2f(v)
  #define GAPS(MF,X0,X1,t,R) do{ MF; X0[R]-=mhat; X0[(R)+1]-=mhat; X1[R]-=mhat; X1[(R)+1]-=mhat; CM1(X0,X1,t,R); CM1(X0,X1,t,(R)+1); mxa=MX3(mxa,X0[R],X0[(R)+1]); mxb=MX3(mxb,X1[R],X1[(R)+1]); PIN(mxa); PIN(mxb); SBAR(); }while(0)
  #define GAPB(MF,X,B) do{ MF; X[B]=EX(X[B]); X[B+1]=EX(X[B+1]); X[B+2]=EX(X[B+2]); X[B+3]=EX(X[B+3]); PIN(X); SBAR(); }while(0)
  #define VRD(i,hf) do{ vlo[(i)&7]=vtr(vp_+((hf)*8192+((i)>>2)*4096+((i)&3)*1024)); vhi[(i)&7]=vtr(vp_+((hf)*8192+((i)>>2)*4096+((i)&3)*1024+512)); }while(0)
  #define KRD(G,j) do{ if(G){ kload2(kf,kp0+sl_next,j); SBAR(); } }while(0)
  #define VF4(i) (bf16x8){vlo[i][0],vlo[i][1],vlo[i][2],vlo[i][3],vhi[i][0],vhi[i][1],vhi[i][2],vhi[i][3]}
  #define STEP(C0,C1,P0,P1,t,GK,GV,GL) do{ SBAR(); \
      \
    if(GV){DMA_V((t)+1,sl_next);} if(GK){DMA_K((t)+3,sl_cur);} \
    const lds_cptr vp_=vp0+2*sl_prev; \
    float sacc=(P0[0]+P0[1]); \
    GAPA(C0=__builtin_amdgcn_mfma_f32_32x32x16_bf16(kf[0],qr[0],zero16,0,0,0), P0[2],P0[3],P0[4],P0[5],     pw0[0]=PKW(P0,0), pw0[1]=PKW(P0,2), pw0); \
    GAPA(C1=__builtin_amdgcn_mfma_f32_32x32x16_bf16(kf[1],qr[0],zero16,0,0,0), P0[6],P0[7],P0[8],P0[9],     pw0[2]=PKW(P0,4), pw0[3]=PKW(P0,6), pw0); \
    GAPA(C0=__builtin_amdgcn_mfma_f32_32x32x16_bf16(kf[2],qr[1],C0,0,0,0),   P0[10],P0[11],P0[12],P0[13], pw1[0]=PKW(P0,8), pw1[1]=PKW(P0,10), pw1); \
    GAPA(C1=__builtin_amdgcn_mfma_f32_32x32x16_bf16(kf[3],qr[1],C1,0,0,0),   P0[14],P0[15],P1[0],P1[1],   pw1[2]=PKW(P0,12),pw1[3]=PKW(P0,14), pw1); \
    GAPA(C0=__builtin_amdgcn_mfma_f32_32x32x16_bf16(kf[4],qr[2],C0,0,0,0),   P1[2],P1[3],P1[4],P1[5],     pw2[0]=PKW(P1,0), pw2[1]=PKW(P1,2), pw2); \
    GAPA(C1=__builtin_amdgcn_mfma_f32_32x32x16_bf16(kf[5],qr[2],C1,0,0,0),   P1[6],P1[7],P1[8],P1[9],     pw2[2]=PKW(P1,4), pw2[3]=PKW(P1,6), pw2); \
    GAPA(C0=__builtin_amdgcn_mfma_f32_32x32x16_bf16(kf[6],qr[3],C0,0,0,0),   P1[10],P1[11],P1[12],P1[13], pw3[0]=PKW(P1,8), pw3[1]=PKW(P1,10), pw3); \
    VRD(0,0); VRD(1,0); VRD(2,0); VRD(3,0); SBAR(); \
    GAPA(C1=__builtin_amdgcn_mfma_f32_32x32x16_bf16(kf[7],qr[3],C1,0,0,0),   P1[14],P1[15],0.f,0.f,       pw3[2]=PKW(P1,12),pw3[3]=PKW(P1,14), pw3); \
    l_reg+=sacc; \
      \
      \
    VRD(4,0); VRD(5,0); VRD(6,0); VRD(7,0); SBAR(); \
    float mxa=-INFINITY,mxb=-INFINITY; \
    GAPS(o[0]=__builtin_amdgcn_mfma_f32_32x32x16_bf16(PAF(0),VF4(0),o[0],0,0,0), C0,C1,t,0); \
    GAPS(o[0]=__builtin_amdgcn_mfma_f32_32x32x16_bf16(PAF(1),VF4(1),o[0],0,0,0), C0,C1,t,2); \
    GAPS(o[0]=__builtin_amdgcn_mfma_f32_32x32x16_bf16(PAF(2),VF4(2),o[0],0,0,0), C0,C1,t,4); \
    GAPS(o[0]=__builtin_amdgcn_mfma_f32_32x32x16_bf16(PAF(3),VF4(3),o[0],0,0,0), C0,C1,t,6); \
    VRD(0,1); VRD(1,1); VRD(2,1); VRD(3,1); KRD(GL,0); SBAR(); \
    GAPS(o[1]=__builtin_amdgcn_mfma_f32_32x32x16_bf16(PAF(0),VF4(4),o[1],0,0,0), C0,C1,t,8); \
    GAPS(o[1]=__builtin_amdgcn_mfma_f32_32x32x16_bf16(PAF(1),VF4(5),o[1],0,0,0), C0,C1,t,10); \
    GAPS(o[1]=__builtin_amdgcn_mfma_f32_32x32x16_bf16(PAF(2),VF4(6),o[1],0,0,0), C0,C1,t,12); \
    GAPS(o[1]=__builtin_amdgcn_mfma_f32_32x32x16_bf16(PAF(3),VF4(7),o[1],0,0,0), C0,C1,t,14); \
    { float rm=__builtin_fmaxf(mxa,mxb); { auto rr=__builtin_amdgcn_permlane32_swap(__float_as_uint(rm),__float_as_uint(rm),false,false); rm=__builtin_fmaxf(__uint_as_float(rr[0]),__uint_as_float(rr[1])); } \
      resc=false; \
      if(__builtin_expect(__any(rm>(float)THRL),0)){ const float dl=__builtin_fmaxf(rm,0.f); mhat+=dl; \
        _Pragma("unroll") for(int r=0;r<16;++r){C0[r]-=dl;C1[r]-=dl;} \
        const float f=__builtin_amdgcn_exp2f(-dl); l_reg*=f; if(hi==0)wsf[r32]=f; resc=true; } } \
    SBAR(); \
    VRD(4,1); VRD(5,1); VRD(6,1); VRD(7,1); KRD(GL,1); SBAR(); \
    GAPB(o[2]=__builtin_amdgcn_mfma_f32_32x32x16_bf16(PAF(0),VF4(0),o[2],0,0,0), C0,0); \
    GAPB(o[2]=__builtin_amdgcn_mfma_f32_32x32x16_bf16(PAF(1),VF4(1),o[2],0,0,0), C0,4); \
    GAPB(o[2]=__builtin_amdgcn_mfma_f32_32x32x16_bf16(PAF(2),VF4(2),o[2],0,0,0), C0,8); \
    GAPB(o[2]=__builtin_amdgcn_mfma_f32_32x32x16_bf16(PAF(3),VF4(3),o[2],0,0,0), C0,12); \
    KRD(GL,2); \
    GAPB(o[3]=__builtin_amdgcn_mfma_f32_32x32x16_bf16(PAF(0),VF4(4),o[3],0,0,0), C1,0); \
    GAPB(o[3]=__builtin_amdgcn_mfma_f32_32x32x16_bf16(PAF(1),VF4(5),o[3],0,0,0), C1,4); \
    KRD(GL,3); \
    GAPB(o[3]=__builtin_amdgcn_mfma_f32_32x32x16_bf16(PAF(2),VF4(6),o[3],0,0,0), C1,8); \
    GAPB(o[3]=__builtin_amdgcn_mfma_f32_32x32x16_bf16(PAF(3),VF4(7),o[3],0,0,0), C1,12); \
    }while(0)
  int t=1;
  #undef CMASK
  #define CMASK(P0,P1,t) do{}while(0)
  #undef CM1
  #define CM1(P0,P1,t,r) do{}while(0)
  for(;t+5<NT;t+=2){
    STEP(pB0,pB1,pA0,pA1,t,true,true,true);     WAIT_BAR(3); RESC(); ROT();
    STEP(pA0,pA1,pB0,pB1,t+1,true,true,true);   WAIT_BAR(3); RESC(); ROT();
  }
  #undef CMASK
  #define CMASK(P0,P1,t) do{int jb_=(t)-(NT-4); if(jb_>=0)cmask(P0,P1,jb_,qrel,hi);}while(0)
  #undef CM1
  #define CM1(P0,P1,t,r) do{int jb_=(t)-(NT-4); if(jb_>=0){ const int kv_=64*jb_+4*hi+((r)&3)+8*((r)>>2); if(kv_>qrel)P0[r]=-INFINITY; if(kv_+32>qrel)P1[r]=-INFINITY; } }while(0)
  #define ENDW(tt) do{ if((tt)+3<NT){WAIT_BAR(3);} else if((tt)+2<NT){WAIT_BAR(2);} else {WAIT_BAR(0);} }while(0)
  for(;t+1<NT;t+=2){
    STEP(pB0,pB1,pA0,pA1,t,(t+3<NT),(t+1<NT),(t+1<NT));       ENDW(t);   RESC(); ROT();
    STEP(pA0,pA1,pB0,pB1,t+1,(t+4<NT),(t+2<NT),(t+2<NT));     ENDW(t+1); RESC(); ROT();
  }
  #define DRAIN(Q0,Q1,SL) do{ float sacc=Q0[0]+Q0[1]; _Pragma("unroll") for(int r=2;r<16;++r)sacc+=Q0[r]; _Pragma("unroll") for(int r=0;r<16;++r)sacc+=Q1[r]; l_reg+=sacc; \
    pw0=(u32x4){PKW(Q0,0),PKW(Q0,2),PKW(Q0,4),PKW(Q0,6)};pw1=(u32x4){PKW(Q0,8),PKW(Q0,10),PKW(Q0,12),PKW(Q0,14)};pw2=(u32x4){PKW(Q1,0),PKW(Q1,2),PKW(Q1,4),PKW(Q1,6)};pw3=(u32x4){PKW(Q1,8),PKW(Q1,10),PKW(Q1,12),PKW(Q1,14)}; \
    SBAR(); pv(o,vb0+2*(SL),PAF(0),PAF(1),PAF(2),PAF(3)); pv(o+2,vb0+2*(SL)+SLOTB,PAF(0),PAF(1),PAF(2),PAF(3)); }while(0)
  if constexpr(ODD){ DRAIN(pA0,pA1,sl_prev); }
  else{ STEP(pB0,pB1,pA0,pA1,NT-1,false,false,false); RESC(); DRAIN(pB0,pB1,sl_cur); }
  #undef DRAIN
  #undef PKW
  #undef PAF
  #undef VF4
  #undef PIN
  #undef MX3
  #undef GAPA
  #undef GAPB
  #undef GAPS
  #undef EX
  #undef VRD
  #undef KRD
  #undef STEP
  #undef ENDW
  {auto rr=__builtin_amdgcn_permlane32_swap(__float_as_uint(l_reg),__float_as_uint(l_reg),false,false);l_reg=__uint_as_float(rr[0])+__uint_as_float(rr[1]);}
  if(hi==0)wsf[32+r32]=l_reg;asm volatile("s_waitcnt lgkmcnt(0)":::"memory");
  float rli[16];
  #pragma unroll
  for(int r=0;r<16;++r)rli[r]=__builtin_amdgcn_rcpf(wsf[32+crow(r,hi)]);
  bf16*Ow=O+co;
  { bf16*stg=(bf16*)(shm+LDS_OST)+wid*2048;
    #pragma unroll
    for(int hf=0;hf<2;++hf){
    #pragma unroll
    for(int r=0;r<16;++r){const int orow=crow(r,hi);
      #pragma unroll
      for(int d0=0;d0<2;++d0)stg[orow*64+d0*32+r32]=__float2bfloat16(o[2*hf+d0][r]*rli[r]);}
    asm volatile("s_waitcnt lgkmcnt(0)":::"memory");
    #pragma unroll
    for(int i=0;i<4;++i){const int row=i*8+(lane>>3),ch=lane&7; const u32x4 v=*(const u32x4*)(stg+row*64+ch*8); const int rel=q0+wid*QBLK+row; const long m=(rel>=64)?(long)b*2048+(rel-64):16384L+16*b+(rel-FRONT); if(rel>=FRONT&&rel<RVEND&&(q0!=0||rel<64))ATTN_STORE16(Ow+m*DM+hf*64+ch*8,v);}
    asm volatile("s_waitcnt lgkmcnt(0)":::"memory"); } }
  asm volatile("s_waitcnt lgkmcnt(0)\n\ts_barrier":::"memory");
  #undef DMA_K
  #undef DMA_V
  #undef CMASK
  #undef CM1
  #undef START
  #undef RESC
  #undef ROT
}
constexpr int ATTN_LDS_BYTES=LDS_BYTES;
struct AttnTensors { const bf16* Q; const bf16* K; const bf16* V; bf16* O; bf16* O1; };
template<int THRL=8> __device__ __forceinline__ void attn_phase(char*lds,const AttnTensors&T,int vcu,int G){
  for(int w=vcu;w<256;w+=G){ const int item=w>>1,half=w&1,b=item>>4,hc=item&15,h=hc>>1,c=hc&1;
    const int n=half?4:5;
    for(int i=0;i<n;++i){ const int j=half?((i==0)?6:(i==1)?5:(i==2)?3:1):((i==0)?7:(i==1)?4:(i==2)?2:(i==3)?0:-1);
      if(j<0) attn_unit<THRL,false>(b,(2*h+c)*64,h*128,h*128,0,T.Q,T.K,T.V,c?T.O1:T.O,lds);
      else attn_unit<THRL,true>(b,(2*h+c)*64,h*128,h*128,64+256*j,T.Q,T.K,T.V,c?T.O1:T.O,lds); } }
}
#undef SBAR
#undef WAIT_BAR
}
#include <hip/hip_cooperative_groups.h>
namespace cg = cooperative_groups;
constexpr int NWAVES = 8;
constexpr int DM_ = 1024, DFF = 2816, NGU = 2 * DFF, NB = 8, SEQL = 2048, NMETA = 16, DEPTH_ = 4;
constexpr int MREAL = NB * SEQL;
constexpr int MVALID = MREAL + NB * NMETA;
constexpr int MPAD = 16640;
constexpr int QROWS = NB * 2112 + 256;
constexpr size_t MiB = 1u << 20;
constexpr size_t WS_ROPE = 1 * MiB;
constexpr size_t WS_HMETA = 1 * MiB + 512 * 1024;
constexpr size_t WS_W = 2 * MiB;
constexpr size_t W_GU_E = (size_t)NGU * DM_, W_DN_E = (size_t)DM_ * DFF, W_FFN_E = W_GU_E + W_DN_E;
constexpr size_t W_IN_E = (size_t)3 * DM_ * DM_, W_OUT_E = (size_t)DM_ * DM_, W_MIX_E = W_IN_E + W_OUT_E;
constexpr size_t W_TOTAL_E = 8 * W_FFN_E + 4 * W_MIX_E;
constexpr size_t WS_XN = 168 * MiB;
constexpr size_t WS_F = 201 * MiB;
constexpr size_t WS_BIG = 236 * MiB;
constexpr size_t WS_END = 338 * MiB;
static_assert(WS_W + W_TOTAL_E * 2 <= WS_XN && WS_XN + (size_t)MPAD * 1024 * 2 <= WS_F && WS_F + (size_t)MPAD * 1024 * 2 <= WS_BIG, "ws map");
static_assert(WS_XN + (size_t)QROWS * 2048 * 2 <= WS_BIG && WS_BIG + (size_t)MPAD * 3072 * 2 <= WS_END && WS_BIG + (size_t)3 * QROWS * 1024 * 2 <= WS_END, "ws map 2");
constexpr int RING_BYTES = 131072, LDS_BYTES = 147456;

#define GAS __attribute__((address_space(1)))
#define LAS __attribute__((address_space(3)))
typedef unsigned short bf16;
typedef unsigned v4u __attribute__((ext_vector_type(4)));
typedef float f32x4 __attribute__((ext_vector_type(4)));
#define LDS_WAIT() asm volatile("s_waitcnt lgkmcnt(0)" ::: "memory")
__device__ __forceinline__ unsigned f2bf(float f) { unsigned u = __builtin_bit_cast(unsigned, f); return (u + 0x7fffu + ((u >> 16) & 1u)) >> 16; }
__device__ __forceinline__ unsigned pk2(float lo, float hi) { typedef float f32x2p __attribute__((ext_vector_type(2))); typedef __bf16 bf16x2p __attribute__((ext_vector_type(2))); f32x2p v = {lo, hi}; bf16x2p b = __builtin_convertvector(v, bf16x2p); return __builtin_bit_cast(unsigned, b); }
__device__ __forceinline__ float bflo(unsigned w) { return __builtin_bit_cast(float, w << 16); }
__device__ __forceinline__ float bfhi(unsigned w) { return __builtin_bit_cast(float, w & 0xffff0000u); }
__device__ __forceinline__ float wave_sum(float v) {
#define WS_DPP(x, ctrl) __builtin_bit_cast(float, __builtin_amdgcn_update_dpp(0, __builtin_bit_cast(int, (x)), (ctrl), 0xF, 0xF, true))
    v += WS_DPP(v, 0xB1);
    v += WS_DPP(v, 0x4E);
    v += WS_DPP(v, 0x141);
    v += WS_DPP(v, 0x140);
#undef WS_DPP
    const int b_ = __builtin_bit_cast(int, v);
    const float r0 = __builtin_bit_cast(float, __builtin_amdgcn_readlane(b_, 0)), r1 = __builtin_bit_cast(float, __builtin_amdgcn_readlane(b_, 16));
    const float r2 = __builtin_bit_cast(float, __builtin_amdgcn_readlane(b_, 32)), r3 = __builtin_bit_cast(float, __builtin_amdgcn_readlane(b_, 48));
    return (r0 + r1) + (r2 + r3);
}
#define RLX_AGENT __ATOMIC_RELAXED, __HIP_MEMORY_SCOPE_AGENT
#define XB_TMO      128
#define XB_XCNT(j)  (256  + 64 * (j))
#define XB_XSUB(j)  (1280 + 64 * (j))
#define XB_XGEN(j)  (2304 + 64 * (j))
#define XB_TOP      3328
#define XB_TOPGEN   3392
#define XCD_BAR_WORDS 3456
#define XB_SPIN_CAP (1u << 18)

__device__ __forceinline__ unsigned xb_ld(unsigned* p)              { return __hip_atomic_load(p, __ATOMIC_RELAXED, __HIP_MEMORY_SCOPE_AGENT); }
__device__ __forceinline__ unsigned xb_add(unsigned* p, unsigned v) { return __hip_atomic_fetch_add(p, v, __ATOMIC_RELAXED, __HIP_MEMORY_SCOPE_AGENT); }
__device__ __forceinline__ unsigned xb_xcc_id() { return (unsigned)__builtin_amdgcn_s_getreg((3 << 11) | 20) & 0xFu; }
#define XB_SPIN(cond, bar) do { unsigned _sp = 0; while (cond) { __builtin_amdgcn_s_sleep(1); \
    if ((++_sp & 255u) == 0u) { if (xb_ld(&(bar)[XB_TMO])) break; if (_sp > XB_SPIN_CAP) { atomicAdd(&(bar)[XB_TMO], 1u); break; } } } } while (0)

struct XcdBarrier {
    unsigned* bar; unsigned x;
    volatile LAS unsigned* st;
};

__device__ __forceinline__ XcdBarrier xcd_barrier_post(unsigned* bar, volatile LAS unsigned* st) {
    XcdBarrier b; b.bar = bar; b.x = xb_xcc_id(); b.st = st;
    if (threadIdx.x == 0) (void)xb_add(&bar[XB_XCNT(b.x)], 1u);
    return b;
}
__device__ __forceinline__ void xcd_barrier_complete(unsigned* bar, unsigned x, unsigned& nloc, unsigned& nx) {
    const unsigned G = gridDim.x * gridDim.y * gridDim.z;
    unsigned sum, cnt, mine, sp = 0u;
    for (;;) {
        sum = 0u; cnt = 0u; mine = 0u;
#pragma unroll
        for (unsigned j = 0; j < 16; ++j) { const unsigned c = xb_ld(&bar[XB_XCNT(j)]); sum += c; cnt += (c > 0u) ? 1u : 0u; mine = (j == x) ? c : mine; }
        if (sum == G) break;
        __builtin_amdgcn_s_sleep(1);
        if ((++sp & 255u) == 0u) { if (xb_ld(&bar[XB_TMO])) break; if (sp > XB_SPIN_CAP) { atomicAdd(&bar[XB_TMO], 1u); break; } }
    }
    nloc = mine > 0u ? mine : 1u; nx = cnt > 0u ? cnt : 1u;
}

template <bool LOCAL> __device__ __forceinline__ void xcd_barrier(const XcdBarrier& b) {
    asm volatile("s_waitcnt vmcnt(0)" ::: "memory");
    __syncthreads();
    if (threadIdx.x == 0) {
        unsigned* bar = b.bar;
        __builtin_amdgcn_s_waitcnt(0);
        unsigned nloc = b.st[0], nx = b.st[1];
        if (nloc == 0u) { xcd_barrier_complete(bar, b.x, nloc, nx); b.st[0] = nloc; b.st[1] = nx; }
        const unsigned old = xb_add(&bar[XB_XSUB(b.x)], 1u);
        const unsigned gen = old / nloc;
        if (old + 1u == (gen + 1u) * nloc) {
            __builtin_amdgcn_fence(__ATOMIC_RELEASE, "agent");
            asm volatile("s_waitcnt vmcnt(0)" ::: "memory");
            if (!LOCAL) {
            const unsigned og = xb_add(&bar[XB_TOP], 1u);
            const unsigned tg = og / nx;
            if (og + 1u == (tg + 1u) * nx) xb_add(&bar[XB_TOPGEN], 1u);
            else XB_SPIN(xb_ld(&bar[XB_TOPGEN]) == tg, bar);
            }
            __builtin_amdgcn_fence(__ATOMIC_ACQUIRE, "agent");
            xb_add(&bar[XB_XGEN(b.x)], 1u);
            asm volatile("s_waitcnt vmcnt(0)" ::: "memory");
        } else {
            XB_SPIN(xb_ld(&bar[XB_XGEN(b.x)]) == gen, bar);
            __builtin_amdgcn_fence(__ATOMIC_ACQUIRE, "agent");
            asm volatile("s_waitcnt vmcnt(0)" ::: "memory");
        }
    }
    __syncthreads();
}

struct Args { const float* in[16]; float* out; unsigned char* ws; };
__device__ __forceinline__ const float* in_ptr(int i) { const char __attribute__((address_space(4)))* ka = (const char __attribute__((address_space(4)))*)__builtin_amdgcn_kernarg_segment_ptr(); int off = i * 8; asm volatile("" : "+s"(off)); return *(const float* const __attribute__((address_space(4)))*)(ka + off); }
__device__ __forceinline__ float* out_ptr() { return (float*)in_ptr(16); }
__device__ __forceinline__ unsigned char* ws_ptr() { return (unsigned char*)in_ptr(17); }

__device__ __forceinline__ void p0_transpose_item(const float* W, int K, int N, bf16* WT, int k0, int n0, int drow0, LAS float* scr, int lane) {
#pragma unroll 8
    for (int i = 0; i < 32; ++i) { const int kk = 2 * i + (lane >> 5); scr[kk * 33 + (lane & 31)] = __builtin_nontemporal_load(&W[(size_t)(k0 + kk) * N + n0 + (lane & 31)]); }
    LDS_WAIT(); asm volatile("" ::: "memory");
    const int c = lane & 7;
#pragma unroll
    for (int j = 0; j < 4; ++j) { const int n = (lane >> 3) + 8 * j; const LAS float* s = scr + (8 * c) * 33 + n;
        v4u o; o.x = pk2(s[0 * 33], s[1 * 33]); o.y = pk2(s[2 * 33], s[3 * 33]); o.z = pk2(s[4 * 33], s[5 * 33]); o.w = pk2(s[6 * 33], s[7 * 33]);
        *(GAS v4u*)(WT + (size_t)(drow0 + n) * K + k0 + 8 * c) = o; }
    LDS_WAIT(); asm volatile("" ::: "memory");
}
__device__ __forceinline__ float* hrow_ptr(float* out, float* hmeta, int m) { return m < MREAL ? out + (size_t)m * DM_ : hmeta + (size_t)(m - MREAL) * DM_; }
__device__ __forceinline__ int qkv_row(int m) { return m < MREAL ? (m >> 11) * 2112 + 64 + (m & 2047) : ((m - MREAL) >> 4) * 2112 + 48 + ((m - MREAL) & 15); }
__device__ __forceinline__ int prev_row(int m, int k) {
    if (m < MREAL) { const int t = m & 2047, b = m >> 11; return (t >= k) ? m - k : MREAL + b * 16 + (16 + t - k); }
    const int i = (m - MREAL) & 15; return (i >= k) ? m - k : -1;
}


typedef short tg_bf16x8 __attribute__((ext_vector_type(8)));
template <int MODE, int KW  , int TR  , int TC  >
__device__ __forceinline__ void tail_gemm(LAS unsigned char* lds, const bf16* A, const bf16* Bt, int N, bf16* O, int ldc, const float* rope, float scale0, size_t buf_stride, int cu, int ncu) {
    constexpr int K = KW * 8, NS = KW / 32, NCP = 16 * TC, NRW = 16 * TR, NCO = (MODE == 1) ? NCP / 2 : NCP, NRB = 128 / NRW, WSZ = NRW * NCP;
    const int tid = opaque_tid(), lane = tid & 63, wid = __builtin_amdgcn_readfirstlane(tid >> 6), fr = lane & 15, fq = lane >> 4;
    const int ncolt = ((MODE == 1) ? N / 2 : N) / NCO, ntiles = NRB * ncolt;
    LAS float* red = (LAS float*)lds;
    if (cu < 0) return;
    for (int tile = cu; tile < ntiles; tile += ncu) {
        const int rb = tile % NRB, ct = tile / NRB;
        tg_bf16x8 fa[TR][NS], fb[TC][NS];
#pragma unroll
        for (int ci = 0; ci < TC; ++ci) { int brow;
            if (MODE == 1) { const int oc = ct * NCO, base = 256 * (oc >> 7) + (oc & 127); brow = (ci < TC / 2) ? base + 16 * ci : base + 128 + 16 * (ci - TC / 2); } else brow = ct * NCP + 16 * ci;
            const bf16* bp = Bt + (size_t)(brow + fr) * K + wid * KW + 8 * fq;
#pragma unroll
            for (int i = 0; i < NS; ++i) fb[ci][i] = *(const tg_bf16x8*)(bp + i * 32); }
#pragma unroll
        for (int ri = 0; ri < TR; ++ri) { const bf16* ap = A + (size_t)(rb * NRW + ri * 16 + fr) * K + wid * KW + 8 * fq;
#pragma unroll
            for (int i = 0; i < NS; ++i) fa[ri][i] = *(const tg_bf16x8*)(ap + i * 32); }
        f32x4 c[TR][TC];
#pragma unroll
        for (int ri = 0; ri < TR; ++ri)
#pragma unroll
            for (int ci = 0; ci < TC; ++ci) c[ri][ci] = (f32x4){0.f, 0.f, 0.f, 0.f};
#pragma unroll
        for (int i = 0; i < NS; ++i)
#pragma unroll
            for (int ri = 0; ri < TR; ++ri)
#pragma unroll
                for (int ci = 0; ci < TC; ++ci) c[ri][ci] = __builtin_amdgcn_mfma_f32_16x16x32_bf16(fb[ci][i], fa[ri][i], c[ri][ci], 0, 0, 0);
        LAS float* rw = red + wid * WSZ;
#pragma unroll
        for (int ri = 0; ri < TR; ++ri)
#pragma unroll
            for (int ci = 0; ci < TC; ++ci) *(LAS f32x4*)(rw + (ri * 16 + fr) * NCP + ci * 16 + 4 * fq) = c[ri][ci];
        __syncthreads();
#define TG_RED(rr_, cc_) (((red[0 * WSZ + (rr_) * NCP + (cc_)] + red[1 * WSZ + (rr_) * NCP + (cc_)]) + (red[2 * WSZ + (rr_) * NCP + (cc_)] + red[3 * WSZ + (rr_) * NCP + (cc_)])) + ((red[4 * WSZ + (rr_) * NCP + (cc_)] + red[5 * WSZ + (rr_) * NCP + (cc_)]) + (red[6 * WSZ + (rr_) * NCP + (cc_)] + red[7 * WSZ + (rr_) * NCP + (cc_)])))
#pragma unroll
        for (int e = tid; e < NRW * NCO; e += NWAVES * 64) { const int row = e / NCO, cc = e % NCO, r = rb * NRW + row;
            if (MODE == 0) { O[(size_t)(MREAL + r) * ldc + ct * NCO + cc] = (bf16)f2bf(TG_RED(row, cc)); }
            else if (MODE == 1) { const float g = TG_RED(row, cc), u = TG_RED(row, NCO + cc); O[(size_t)(MREAL + r) * ldc + ct * NCO + cc] = (bf16)f2bf(pg8::EpiSwiGLU::silu_mul(g, u)); }
            else { const int gcol = ct * NCO + cc, t = gcol >> 10, d = gcol & 63; float v0 = TG_RED(row, cc);
                const int orow = (r >> 4) * 2112 + 48 + (r & 15), pos = r & 15;
                if (t < 2 && d < 16) { const int pc = cc + ((gcol ^ 8) - gcol); const float o0 = TG_RED(row, pc); const int j = d & 7; const float sgn = (d < 8) ? -1.f : 1.f;
                    v0 = v0 * rope[pos * 16 + j] + sgn * o0 * rope[pos * 16 + 8 + j]; }
                if (t == 0) v0 *= scale0;
                O[(size_t)t * buf_stride + (size_t)orow * 1024 + (gcol & 1023)] = (bf16)f2bf(v0); } }
#undef TG_RED
        __syncthreads();
    }
}

__device__ __forceinline__ int batch_row(int b, int i) { return i < SEQL ? b * SEQL + i : MREAL + b * NMETA + ((i - SEQL) >> 4); }
__global__ void __launch_bounds__(NWAVES * 64, 2) trunk_fwd(Args args) {
    extern __shared__ __attribute__((aligned(16))) unsigned char lds[];
    cg::grid_group grid = cg::this_grid();
    const int tid = threadIdx.x, lane = tid & 63, wave = __builtin_amdgcn_readfirstlane(tid >> 6);
    const int G = gridDim.x; const int bx = blockIdx.x; const int vcu = (G % 8 == 0) ? (bx % 8) * (G / 8) + bx / 8 : bx;
    const int gw = vcu * NWAVES + wave, NGW = G * NWAVES;
    LAS unsigned char* ldsl = (LAS unsigned char*)lds;
#define WSB(off) (ws_ptr() + (off))
#define P_HMETA ((float*)WSB(WS_HMETA))
#define P_ROPE ((float*)WSB(WS_ROPE))
#define P_WB ((bf16*)WSB(WS_W))
#define P_XN ((bf16*)WSB(WS_XN))
#define P_FB ((bf16*)WSB(WS_F))
#define P_BIG ((bf16*)WSB(WS_BIG))
    for (int u = tid; u < (LDS_BYTES - RING_BYTES) / 4; u += NWAVES * 64) ((LAS unsigned*)(ldsl + RING_BYTES))[u] = 0u;
    __syncthreads();
    XcdBarrier xbar = xcd_barrier_post((unsigned*)ws_ptr(), (volatile LAS unsigned*)(ldsl + RING_BYTES + 352));
#define GSYNC() xcd_barrier<false>(xbar)
#define LSYNC() xcd_barrier<true>(xbar)
#define GSYNC_CG() do { asm volatile("s_waitcnt vmcnt(0) lgkmcnt(0)" ::: "memory"); __builtin_amdgcn_fence(__ATOMIC_RELEASE, "agent"); grid.sync(); __builtin_amdgcn_fence(__ATOMIC_ACQUIRE, "agent"); } while (0)

    if (tid == 0) ((unsigned*)(ws_ptr() + 32768))[bx] = xbar.x + 1u;
    {
        LAS float* scr = (LAS float*)(ldsl + wave * 16384); bf16* const Wb0 = P_WB;
        constexpr int I_GU = (DM_ / 64) * (NGU / 32), I_DN = (DFF / 64) * (DM_ / 32), I_FFN = I_GU + I_DN;
        constexpr int I_IN = (DM_ / 64) * (3 * DM_ / 32), I_OUT = (DM_ / 64) * (DM_ / 32), I_MIX = I_IN + I_OUT;
        constexpr int NITEMS = 8 * I_FFN + 4 * I_MIX;
        for (int it = gw; it < NITEMS; it += NGW) {
            if (it < 8 * I_FFN) { const int fi = it / I_FFN, r = it % I_FFN, l = fi >> 1, which = fi & 1; bf16* dst = Wb0 + (size_t)fi * W_FFN_E;
                if (r < I_GU) { const float* W = (which ? in_ptr(14) : in_ptr(3)) + (size_t)l * DM_ * NGU; const int nblk = NGU / 32, kb = r / nblk, nb = r % nblk, n0 = 32 * nb;
                    const int half = n0 / DFF, within = n0 % DFF, drow0 = 256 * (within / 128) + 128 * half + (within % 128);
                    p0_transpose_item(W, DM_, NGU, dst, 64 * kb, n0, drow0, scr, lane); }
                else { const int r2 = r - I_GU; const float* W = (which ? in_ptr(15) : in_ptr(4)) + (size_t)l * DFF * DM_; const int nblk = DM_ / 32, kb = r2 / nblk, nb = r2 % nblk;
                    p0_transpose_item(W, DFF, DM_, dst + W_GU_E, 64 * kb, 32 * nb, 32 * nb, scr, lane); }
            } else { const int it2 = it - 8 * I_FFN, l = it2 / I_MIX, r = it2 % I_MIX, j = l >> 1, isattn = l & 1; bf16* dst = Wb0 + 8 * W_FFN_E + (size_t)l * W_MIX_E;
                if (r < I_IN) { const float* W = (isattn ? in_ptr(9) : in_ptr(6)) + (size_t)j * DM_ * 3 * DM_; const int nblk = 3 * DM_ / 32, kb = r / nblk, nb = r % nblk;
                    p0_transpose_item(W, DM_, 3 * DM_, dst, 64 * kb, 32 * nb, 32 * nb, scr, lane); }
                else { const int r2 = r - I_IN; const float* W = (isattn ? in_ptr(12) : in_ptr(8)) + (size_t)j * DM_ * DM_; const int nblk = DM_ / 32, kb = r2 / nblk, nb = r2 % nblk;
                    p0_transpose_item(W, DM_, DM_, dst + W_IN_E, 64 * kb, 32 * nb, 32 * nb, scr, lane); }
            }
        }
        float* const rope0 = P_ROPE;
        for (int e = gw * 64 + lane; e < 2064 * 8; e += NGW * 64) { const int pos = e >> 3, j = e & 7;
            const float inv = (float)exp2(-(double)j * (18.931568569324174 / 8.0));
            const float ang = (float)pos * inv; const double rev = (double)ang * 0.15915494309189535; const float fr = (float)(rev - floor(rev));
            rope0[pos * 16 + j] = __builtin_amdgcn_cosf(fr); rope0[pos * 16 + 8 + j] = __builtin_amdgcn_sinf(fr); }
        { const v4u z = {0u, 0u, 0u, 0u}; bf16* const xn0 = P_XN; bf16* const big0 = P_BIG;
          for (int e = gw * 64 + lane; e < (MPAD - MVALID) * 128; e += NGW * 64) *(v4u*)(xn0 + (size_t)MVALID * 1024 + (size_t)e * 8) = z;
          for (int e = gw * 64 + lane; e < 3 * (8 * 48 + 256) * 128; e += NGW * 64) { const int bufi = e / ((8 * 48 + 256) * 128), r = (e / 128) % (8 * 48 + 256), c = e % 128;
              const int row = r < 384 ? (r / 48) * 2112 + (r % 48) : 8 * 2112 + (r - 384);
              *(v4u*)(big0 + (size_t)bufi * QROWS * 1024 + (size_t)row * 1024 + c * 8) = z; } }
    }
    { float* const hp_out = out_ptr(); float* const hp_meta = P_HMETA; const float* const xin = in_ptr(0); const float* const min_ = in_ptr(1); const float* const g = in_ptr(2); bf16* const xn0 = P_XN;
    for (int m = gw; m < MVALID; m += NGW) {
        const float* src = m < MREAL ? xin + (size_t)m * DM_ : min_ + (size_t)((m - MREAL) & 15) * DM_;
        float* hr = hrow_ptr(hp_out, hp_meta, m);
        f32x4 v[4]; float s = 0.f;
#pragma unroll
        for (int q = 0; q < 4; ++q) { v[q] = *(const f32x4*)(src + (q >> 1) * 512 + lane * 8 + (q & 1) * 4); s += (v[q][0] * v[q][0] + v[q][1] * v[q][1]) + (v[q][2] * v[q][2] + v[q][3] * v[q][3]); }
        const float r2 = __builtin_amdgcn_rsqf(wave_sum(s) * (1.f / DM_) + 1e-6f);
        if (m >= MREAL) {
#pragma unroll
        for (int q = 0; q < 4; ++q) *(f32x4*)(hr + (q >> 1) * 512 + lane * 8 + (q & 1) * 4) = v[q]; }
#pragma unroll
        for (int hh = 0; hh < 2; ++hh) { const f32x4 g0 = *(const f32x4*)(g + hh * 512 + lane * 8), g1 = *(const f32x4*)(g + hh * 512 + lane * 8 + 4); const f32x4 a = v[2 * hh] * r2 * g0, b = v[2 * hh + 1] * r2 * g1;
            v4u o; o.x = pk2(a[0], a[1]); o.y = pk2(a[2], a[3]); o.z = pk2(b[0], b[1]); o.w = pk2(b[2], b[3]); *(v4u*)(xn0 + (size_t)m * 1024 + hh * 512 + lane * 8) = o; }
    } }
    GSYNC();
    if (G == 0x7fffff) GSYNC_CG();
    int fastsync;
    { int ok = 1; const unsigned* xt = (const unsigned*)(ws_ptr() + 32768);
      if (G != 256) ok = 0; else if (tid < 256) ok = (xt[tid] != 0u) && (xt[tid] == xt[tid & 7]);
      fastsync = __syncthreads_and(ok); }

    enum { K_GU = 0, K_PLAIN = 1, K_NORM = 2, K_CONV = 3, K_QKV = 4, K_ATTN = 5, K_COMB = 6 };
    for (int l = 0; l < DEPTH_; ++l) {
        const int nsteps = (l & 1) ? 11 : 10;
        for (int s = 0; s < nsteps; ++s) {
            int lq = l; asm volatile("" : "+s"(lq));
            const int isattn = lq & 1, jm = lq >> 1;
            const bf16* Wmix = P_WB + 8 * W_FFN_E + (size_t)lq * W_MIX_E;
            int kind; const bf16* gA = P_XN; const bf16* gB = P_WB; int gN = 1024, gK = 1024; bf16* gO = P_FB;
            float coef = 0.5f; const float* gpost = in_ptr(2); const float* gnext = in_ptr(2); int wnext = 1;
            int ffn_i = 0;
            const int sm = (isattn && s >= 5) ? s - 1 : s;
            if (s == 0 || sm == 7) { kind = K_GU; ffn_i = (s == 0) ? 0 : 1; }
            else if (s == 1 || sm == 8) { kind = K_PLAIN; ffn_i = (s == 1) ? 0 : 1; gA = P_BIG; gB = P_WB + (size_t)(2 * lq + ffn_i) * W_FFN_E + W_GU_E; gN = 1024; gK = DFF; gO = P_FB; }
            else if (s == 2) { kind = K_NORM; coef = 0.5f; gpost = in_ptr(2) + (size_t)(lq * 2 + 1) * DM_; gnext = in_ptr(5) + (size_t)(lq * 2) * DM_; }
            else if (s == 3) { if (isattn) kind = K_QKV; else { kind = K_PLAIN; gA = P_XN; gB = Wmix; gN = 3 * DM_; gK = DM_; gO = P_BIG; } }
            else if (s == 4) { kind = isattn ? K_ATTN : K_CONV; }
            else if (isattn && s == 5) { kind = K_COMB; }
            else if (sm == 5) { kind = K_PLAIN; gA = P_XN; gB = Wmix + W_IN_E; gN = 1024; gK = 1024; gO = P_FB; }
            else if (sm == 6) { kind = K_NORM; coef = 1.0f; gpost = in_ptr(5) + (size_t)(lq * 2 + 1) * DM_; gnext = in_ptr(13) + (size_t)(lq * 2) * DM_; }
            else { kind = K_NORM; coef = 0.5f; gpost = in_ptr(13) + (size_t)(lq * 2 + 1) * DM_; wnext = (lq < DEPTH_ - 1); gnext = in_ptr(2) + (size_t)((lq < DEPTH_ - 1 ? lq + 1 : lq) * 2) * DM_; }

            const bool meta_live = !(lq == DEPTH_ - 1 && s >= 5);
            const int lane = opaque_tid() & 63;
            const bool ral = (G == 256); const int ri0 = ral ? (gw & 255) : gw, rin = ral ? ((meta_live && (gw & 15) == 0) ? SEQL + 256 : SEQL) : (meta_live ? MVALID : MREAL),        ris = ral ? 256 : NGW, rbt = gw >> 8;
#define ROWMAP(i_) (ral ? batch_row(rbt, (i_)) : (i_))
            if (kind == K_GU) {
                pg8::Gemm g{P_XN, P_WB + (size_t)(2 * lq + ffn_i) * W_FFN_E, MREAL, NGU, DM_}; pg8::StaticOrder S; S.init(MREAL, NGU, G, bx);
                pg8::EpiSwiGLU E{P_BIG, DFF};
                pg8::gemm_phase<pg8::EpiSwiGLU, pg8::StaticOrder, true, true>(ldsl, g, S, E);
                { const int lo = (G == 256) ? 128 : 0;
                  tail_gemm<1, 128, 1, 8>(ldsl, P_XN + (size_t)MREAL * DM_, P_WB + (size_t)(2 * lq + ffn_i) * W_FFN_E, NGU, P_BIG, DFF, nullptr, 1.f, 0, meta_live ? bx - lo : -1, G - lo); }
            } else if (kind == K_PLAIN) {
                pg8::Gemm g{gA, gB, MREAL, gN, gK}; pg8::StaticOrder S; S.init(MREAL, gN, G, bx);
                pg8::EpiBf16<0> E{gO, gN, nullptr, 0, 0, 1.f};
                pg8::gemm_phase<pg8::EpiBf16<0>, pg8::StaticOrder, true, true>(ldsl, g, S, E);
                if (gK == DM_) { if (gN == DM_) tail_gemm<0, 128, 1, 2>(ldsl, gA + (size_t)MREAL * DM_, gB, gN, gO, gN, nullptr, 1.f, 0, meta_live ? bx : -1, G); else tail_gemm<0, 128, 1, 6>(ldsl, gA + (size_t)MREAL * DM_, gB, gN, gO, gN, nullptr, 1.f, 0, bx, G); }
                else tail_gemm<0, 352, 1, 2>(ldsl, gA + (size_t)MREAL * DFF, gB, gN, gO, gN, nullptr, 1.f, 0, meta_live ? bx : -1, G);
            } else if (kind == K_QKV) {
                pg8::Gemm g{P_XN, Wmix, MREAL, 3 * DM_, DM_}; pg8::StaticOrder S; S.init(MREAL, 3 * DM_, G, bx);
                pg8::EpiQKV E{P_BIG, (size_t)QROWS * 1024, P_ROPE, attn_body::C2};
                pg8::gemm_phase<pg8::EpiQKV, pg8::StaticOrder, true, true>(ldsl, g, S, E);
                tail_gemm<2, 128, 1, 6>(ldsl, P_XN + (size_t)MREAL * DM_, Wmix, 3 * DM_, P_BIG, 1024, P_ROPE, attn_body::C2, (size_t)QROWS * 1024, bx, G);
            } else if (kind == K_NORM) {
                float* const hp_out = out_ptr(); float* const hp_meta = P_HMETA; const bf16* const fb0 = P_FB; bf16* const xn0 = P_XN;
                f32x4 nv[4]; v4u nw[2];
#define NORM_LOAD(mm) do { const float* hq_ = hrow_ptr(hsrc0, hp_meta, (mm)); const bf16* fq_ = fb0 + (size_t)(mm) * 1024; \
                    nw[0] = __builtin_nontemporal_load((const v4u*)(fq_ + lane * 8)); nw[1] = __builtin_nontemporal_load((const v4u*)(fq_ + 512 + lane * 8)); \
                    _Pragma("unroll") for (int q = 0; q < 4; ++q) nv[q] = *(const f32x4*)(hq_ + (q >> 1) * 512 + lane * 8 + (q & 1) * 4); } while (0)
                float* const hsrc0 = (lq == 0 && s == 2) ? (float*)in_ptr(0) : hp_out;
                NORM_LOAD(ROWMAP(ri0 < rin ? ri0 : 0));
                for (int ri = ri0; ri < rin; ri += ris) { const int m = ROWMAP(ri);
                    float* hr = hrow_ptr(hp_out, hp_meta, m);
                    f32x4 v[4]; float fv[16]; float s1 = 0.f;
#pragma unroll
                    for (int hh = 0; hh < 2; ++hh) { const v4u w = nw[hh];
                        fv[hh * 8 + 0] = bflo(w.x); fv[hh * 8 + 1] = bfhi(w.x); fv[hh * 8 + 2] = bflo(w.y); fv[hh * 8 + 3] = bfhi(w.y); fv[hh * 8 + 4] = bflo(w.z); fv[hh * 8 + 5] = bfhi(w.z); fv[hh * 8 + 6] = bflo(w.w); fv[hh * 8 + 7] = bfhi(w.w); }
#pragma unroll
                    for (int q = 0; q < 4; ++q) v[q] = nv[q];
                    if (ri + ris < rin) NORM_LOAD(ROWMAP(ri + ris));
#pragma unroll
                    for (int e = 0; e < 16; ++e) s1 += fv[e] * fv[e];
                    const float r1 = coef * __builtin_amdgcn_rsqf(wave_sum(s1) * (1.f / DM_) + 1e-6f); float s2 = 0.f;
#pragma unroll
                    for (int q = 0; q < 4; ++q) { const f32x4 gp = *(const f32x4*)(gpost + (q >> 1) * 512 + lane * 8 + (q & 1) * 4);
#pragma unroll
                        for (int i = 0; i < 4; ++i) { v[q][i] += fv[q * 4 + i] * r1 * gp[i]; s2 += v[q][i] * v[q][i]; } }
                    const float r2 = __builtin_amdgcn_rsqf(wave_sum(s2) * (1.f / DM_) + 1e-6f);
#pragma unroll
                    for (int q = 0; q < 4; ++q) *(f32x4*)(hr + (q >> 1) * 512 + lane * 8 + (q & 1) * 4) = v[q];
                    if (wnext) {
#pragma unroll
                        for (int hh = 0; hh < 2; ++hh) { const f32x4 g0 = *(const f32x4*)(gnext + hh * 512 + lane * 8), g1 = *(const f32x4*)(gnext + hh * 512 + lane * 8 + 4); const f32x4 a = v[2 * hh] * r2 * g0, b = v[2 * hh + 1] * r2 * g1;
                            v4u o; o.x = pk2(a[0], a[1]); o.y = pk2(a[2], a[3]); o.z = pk2(b[0], b[1]); o.w = pk2(b[2], b[3]); *(v4u*)(xn0 + (size_t)m * 1024 + hh * 512 + lane * 8) = o; }
                    }
                }
#undef NORM_LOAD
            } else if (kind == K_CONV) {
                const float* cw = in_ptr(7) + (size_t)jm * 3 * DM_; const bf16* const big0 = P_BIG; bf16* const xn0 = P_XN;
                for (int ri = ri0; ri < rin; ri += ris) { const int m = ROWMAP(ri);
                    const int m1 = prev_row(m, 1), m2 = prev_row(m, 2);
#pragma unroll
                    for (int hh = 0; hh < 2; ++hh) { const int d0 = hh * 512 + lane * 8; float acc8[8];
#pragma unroll
                        for (int k = 0; k < 3; ++k) { const int mr = (k == 2) ? m : (k == 1 ? m1 : m2); v4u cc = {0u, 0u, 0u, 0u}, xx = cc;
                            if (mr >= 0) { cc = *(const v4u*)(big0 + (size_t)mr * 3072 + 1024 + d0); xx = *(const v4u*)(big0 + (size_t)mr * 3072 + 2048 + d0); }
                            const f32x4 w0 = *(const f32x4*)(cw + k * DM_ + d0), w1 = *(const f32x4*)(cw + k * DM_ + d0 + 4);
                            const float u0 = bflo(cc.x) * bflo(xx.x), u1 = bfhi(cc.x) * bfhi(xx.x), u2 = bflo(cc.y) * bflo(xx.y), u3 = bfhi(cc.y) * bfhi(xx.y);
                            const float u4 = bflo(cc.z) * bflo(xx.z), u5 = bfhi(cc.z) * bfhi(xx.z), u6 = bflo(cc.w) * bflo(xx.w), u7 = bfhi(cc.w) * bfhi(xx.w);
                            if (k == 0) { acc8[0] = w0[0] * u0; acc8[1] = w0[1] * u1; acc8[2] = w0[2] * u2; acc8[3] = w0[3] * u3; acc8[4] = w1[0] * u4; acc8[5] = w1[1] * u5; acc8[6] = w1[2] * u6; acc8[7] = w1[3] * u7; }
                            else { acc8[0] += w0[0] * u0; acc8[1] += w0[1] * u1; acc8[2] += w0[2] * u2; acc8[3] += w0[3] * u3; acc8[4] += w1[0] * u4; acc8[5] += w1[1] * u5; acc8[6] += w1[2] * u6; acc8[7] += w1[3] * u7; } }
                        const v4u bb = __builtin_nontemporal_load((const v4u*)(big0 + (size_t)m * 3072 + d0));
                        v4u o; o.x = pk2(bflo(bb.x) * acc8[0], bfhi(bb.x) * acc8[1]); o.y = pk2(bflo(bb.y) * acc8[2], bfhi(bb.y) * acc8[3]); o.z = pk2(bflo(bb.z) * acc8[4], bfhi(bb.z) * acc8[5]); o.w = pk2(bflo(bb.w) * acc8[6], bfhi(bb.w) * acc8[7]);
                        *(v4u*)(xn0 + (size_t)m * 1024 + d0) = o; }
                }
            } else if (kind == K_ATTN) {
                bf16* const big0 = P_BIG; const attn_body::AttnTensors AT{(const attn_body::bf16*)big0, (const attn_body::bf16*)(big0 + (size_t)QROWS * 1024), (const attn_body::bf16*)(big0 + (size_t)2 * QROWS * 1024), (attn_body::bf16*)P_XN, (attn_body::bf16*)P_FB};
                attn_body::attn_phase<8>((char*)lds, AT, vcu, G);
            } else {
                const float linit = 0.8f - 0.6f * expf(-0.3f * (float)lq);
                const float* lp = in_ptr(10) + (size_t)jm * 4 * 64;
                const float lam = expf(wave_sum(lp[lane] * lp[64 + lane])) - expf(wave_sum(lp[128 + lane] * lp[192 + lane])) + linit;
                const float* sg = in_ptr(11) + (size_t)jm * 128; const int hd = lane >> 3, dv0 = (lane & 7) * 16;
                float gs[16];
#pragma unroll
                for (int q = 0; q < 4; ++q) { const f32x4 t4 = *(const f32x4*)(sg + dv0 + q * 4); gs[q * 4 + 0] = t4[0] * (1.f - linit); gs[q * 4 + 1] = t4[1] * (1.f - linit); gs[q * 4 + 2] = t4[2] * (1.f - linit); gs[q * 4 + 3] = t4[3] * (1.f - linit); }
                bf16* const ob0 = P_XN; const bf16* const ob1 = P_FB;
                for (int ri = ri0; ri < rin; ri += ris) { const int m = ROWMAP(ri);
                    bf16* orow = ob0 + (size_t)m * 1024 + hd * 128 + dv0; const bf16* orow1 = ob1 + (size_t)m * 1024 + hd * 128 + dv0;
                    const v4u a0 = *(const v4u*)(orow), a1 = *(const v4u*)(orow + 8), b0 = __builtin_nontemporal_load((const v4u*)(orow1)), b1 = __builtin_nontemporal_load((const v4u*)(orow1 + 8));
                    float d[16];
                    d[0] = bflo(a0.x) - lam * bflo(b0.x); d[1] = bfhi(a0.x) - lam * bfhi(b0.x); d[2] = bflo(a0.y) - lam * bflo(b0.y); d[3] = bfhi(a0.y) - lam * bfhi(b0.y);
                    d[4] = bflo(a0.z) - lam * bflo(b0.z); d[5] = bfhi(a0.z) - lam * bfhi(b0.z); d[6] = bflo(a0.w) - lam * bflo(b0.w); d[7] = bfhi(a0.w) - lam * bfhi(b0.w);
                    d[8] = bflo(a1.x) - lam * bflo(b1.x); d[9] = bfhi(a1.x) - lam * bfhi(b1.x); d[10] = bflo(a1.y) - lam * bflo(b1.y); d[11] = bfhi(a1.y) - lam * bfhi(b1.y);
                    d[12] = bflo(a1.z) - lam * bflo(b1.z); d[13] = bfhi(a1.z) - lam * bfhi(b1.z); d[14] = bflo(a1.w) - lam * bflo(b1.w); d[15] = bfhi(a1.w) - lam * bfhi(b1.w);
                    float ss = 0.f;
#pragma unroll
                    for (int e = 0; e < 16; ++e) ss += d[e] * d[e];
                    ss += __builtin_bit_cast(float, __builtin_amdgcn_update_dpp(0, __builtin_bit_cast(int, ss), 0xB1, 0xF, 0xF, true)); ss += __builtin_bit_cast(float, __builtin_amdgcn_update_dpp(0, __builtin_bit_cast(int, ss), 0x4E, 0xF, 0xF, true)); ss += __builtin_bit_cast(float, __builtin_amdgcn_update_dpp(0, __builtin_bit_cast(int, ss), 0x141, 0xF, 0xF, true));
                    const float rr = __builtin_amdgcn_rsqf(ss * (1.f / 128.f) + 1e-5f);
                    v4u o0, o1;
                    o0.x = pk2(d[0] * rr * gs[0], d[1] * rr * gs[1]); o0.y = pk2(d[2] * rr * gs[2], d[3] * rr * gs[3]); o0.z = pk2(d[4] * rr * gs[4], d[5] * rr * gs[5]); o0.w = pk2(d[6] * rr * gs[6], d[7] * rr * gs[7]);
                    o1.x = pk2(d[8] * rr * gs[8], d[9] * rr * gs[9]); o1.y = pk2(d[10] * rr * gs[10], d[11] * rr * gs[11]); o1.z = pk2(d[12] * rr * gs[12], d[13] * rr * gs[13]); o1.w = pk2(d[14] * rr * gs[14], d[15] * rr * gs[15]);
                    *(v4u*)orow = o0; *(v4u*)(orow + 8) = o1;
                }
            }
#undef ROWMAP
            {
              const int arrive_s = (s == 1) ? 0 : (s == 4) ? 1 : -1;
              const int wait_s = isattn ? ((s == 2) ? 0 : (s == 7) ? 1 : -1) : ((s == 2) ? 0 : (s == 6) ? 1 : -1);
              const bool full = false;
              unsigned* const splitc = (unsigned*)(ws_ptr() + 40960) + 64 * (2 * lq + (arrive_s >= 0 ? arrive_s : (wait_s >= 0 ? wait_s : 0)));
              if (lq == DEPTH_ - 1 && s == nsteps - 1) {   }
              else if (!fastsync || full) GSYNC();
              else { LSYNC();
                     if (arrive_s >= 0) { if (opaque_tid() == 0) __hip_atomic_fetch_add(splitc, 1u, __ATOMIC_RELAXED, __HIP_MEMORY_SCOPE_AGENT); }
                     if (wait_s >= 0) { if (opaque_tid() == 0) { unsigned sp_ = 0; while (__hip_atomic_load(splitc, __ATOMIC_RELAXED, __HIP_MEMORY_SCOPE_AGENT) < (unsigned)G && ++sp_ < (1u << 22)) __builtin_amdgcn_s_sleep(1); }
                                        __syncthreads(); } } }
        }
    }
}

extern "C" void kernel_launch(void* const* d_in, const int* in_sizes, int n_in, void* d_out, int out_size, void* d_ws, size_t ws_size, hipStream_t stream) {
    static int grid = 0;
    if (grid == 0) {
        if (n_in != 16 || out_size != MREAL * DM_ || ws_size < WS_END) { fprintf(stderr, "kernel_launch: unexpected shapes: n_in %d out %d ws %zu (need %zu)\n", n_in, out_size, ws_size, (size_t)WS_END); grid = -1; return; }
        int dev = 0, cus = 0, per_cu = 0;
        if (hipGetDevice(&dev) != hipSuccess || hipDeviceGetAttribute(&cus, hipDeviceAttributeMultiprocessorCount, dev) != hipSuccess) { grid = -1; return; }
        if (hipFuncSetAttribute((const void*)trunk_fwd, hipFuncAttributeMaxDynamicSharedMemorySize, LDS_BYTES) != hipSuccess) { fprintf(stderr, "kernel_launch: hipFuncSetAttribute failed\n"); grid = -1; return; }
        if (hipOccupancyMaxActiveBlocksPerMultiprocessor(&per_cu, (const void*)trunk_fwd, NWAVES * 64, LDS_BYTES) != hipSuccess || per_cu < 1) { fprintf(stderr, "kernel_launch: occupancy query says %d\n", per_cu); per_cu = 1; }
        (void)hipGetLastError();
        grid = cus * per_cu;
    }
    if (grid < 0) return;
    if (hipMemsetAsync(d_ws, 0, 65536, stream) != hipSuccess) { fprintf(stderr, "kernel_launch: memset failed\n"); return; }
    Args a{};
    for (int i = 0; i < 16; ++i) a.in[i] = (const float*)d_in[i];
    a.out = (float*)d_out; a.ws = (unsigned char*)d_ws;
    void* kargs[] = {&a};
    hipError_t e = hipLaunchCooperativeKernel((const void*)trunk_fwd, dim3(grid), dim3(NWAVES * 64), kargs, LDS_BYTES, stream);
    if (e != hipSuccess) fprintf(stderr, "kernel_launch: cooperative launch failed: %s (grid %d)\n", hipGetErrorString(e), grid);
}
```

```cpp
#include <hip/hip_runtime.h>
#include <cstdio>
#include <cstdint>
__device__ __forceinline__ int opaque_tid() { int t = threadIdx.x; asm volatile("" : "+v"(t)); return t; }
namespace pg8 {
#define PG8_LAS __attribute__((address_space(3)))
typedef unsigned short bf16_t;
typedef short bf16x8 __attribute__((ext_vector_type(8)));
typedef float f32x4 __attribute__((ext_vector_type(4)));
typedef unsigned u32x4 __attribute__((ext_vector_type(4)));
constexpr int BM = 256, BK = 64, HALF = 128, HTB = HALF * BK * 2  , STAGE_BYTES = 8 * HTB, NXCD = 8, WGM = 4;

__host__ __device__ __forceinline__ int lds_byte(int r, int c) { const int st = (r >> 4) * 2 + (c >> 5), rr = r & 15, cc = c & 31, ob = rr * 64 + cc * 2; return st * 1024 + (ob ^ (((ob >> 9) & 1) << 5)); }
__host__ __device__ __forceinline__ void stage_rc(int b, int& R, int& C) { const int st = b / 1024, sb = b % 1024, swz = sb ^ (((sb >> 9) & 1) << 5); R = (st >> 1) * 16 + swz / 64; C = (st & 1) * 32 + (swz % 64) / 2; }
__host__ __device__ __forceinline__ int perm32(int rho) { const int n = rho >> 4, i = rho & 15; return 8 * (i >> 2) + 4 * n + (i & 3); }

struct Unit { int pm, pn; };
struct Gemm { const bf16_t* A; const bf16_t* Bt; int M, N, K; };

struct StaticOrder {
    int nM, nN, nwg, G, c;
    __host__ __device__ void init(int M, int N, int G_, int c_) { nM = M / BM; nN = N / BM; nwg = nM * nN; G = G_; c = c_; }
    __host__ __device__ bool next(int i, Unit& u) const {
        const long L = (long)i * G + c; if (L >= nwg) return false;
        int wgid = (int)L; { const int q = nwg / NXCD, r = nwg % NXCD, xcd = wgid % NXCD, off = wgid / NXCD; wgid = (xcd < r ? xcd * (q + 1) : r * (q + 1) + (xcd - r) * q) + off; }
        const int nig = WGM * nN, gid = wgid / nig, fm = gid * WGM, gsz = (nM - fm) < WGM ? (nM - fm) : WGM;
        u.pm = fm + ((wgid % nig) % gsz); u.pn = (wgid % nig) / gsz; return true;
    }
    __device__ __forceinline__ void a_ready(const Unit&) const {}
    __device__ __forceinline__ void done(const Unit&) const {}
};

__device__ __forceinline__ unsigned cvt_pk_bf16(float lo, float hi) { unsigned r; asm volatile("v_cvt_pk_bf16_f32 %0, %1, %2" : "=v"(r) : "v"(lo), "v"(hi)); return r; }
typedef float f32x2 __attribute__((ext_vector_type(2)));
__device__ __forceinline__ f32x2 gelu_pk(f32x2 v) {
    const f32x2 av = __builtin_elementwise_abs(v), d = av * 0.2316418882f + 1.0f;
    f32x2 t; t.x = __builtin_amdgcn_rcpf(d.x); t.y = __builtin_amdgcn_rcpf(d.y);
    f32x2 q = t * 0.5307027145f + (-0.7265760135f); q = q * t + 0.7107068705f; q = q * t + (-0.142248368f); q = q * t + 0.127414796f; q = q * t;
    const f32x2 s = (v * v) * (-0.72134752044f);
    f32x2 e; e.x = __builtin_amdgcn_exp2f(s.x); e.y = __builtin_amdgcn_exp2f(s.y);
    const f32x2 m = v * (q * e), r = v - m;
    f32x2 o; o.x = v.x < 0.f ? m.x : r.x; o.y = v.y < 0.f ? m.y : r.y; return o;
}

template <int ACT  > struct EpiBf16 {
    static constexpr bool PERM = true, AFTER_DRAIN = false; static_assert(ACT == 0 || ACT == 1, "EpiBf16: ACT is 0 (none) or 1 (gelu_pk)");
    bf16_t* O; int ldc; const float* bias; int split_cols; size_t split_stride; float scale0;
    __device__ __forceinline__ void operator()(const f32x4 (&acc)[2][2][4][2], const Unit& u, int wr, int wc, int fr, int fq) const {
        const int row0 = u.pm * BM + wr * 64 + fr; int colt = u.pn * BM; bf16_t* base = O;
        float sc = 1.f; if (split_cols) { const int t = colt / split_cols; base += (size_t)t * split_stride; colt -= t * split_cols; if (t == 0) sc = scale0; }
        const int col0 = colt + wc * 32 + 8 * fq, bcol0 = u.pn * BM + wc * 32 + 8 * fq;
        f32x4 bv[2][2];
#pragma unroll
        for (int bj = 0; bj < 2; ++bj)
#pragma unroll
            for (int n = 0; n < 2; ++n) bv[bj][n] = bias ? *(const f32x4*)(bias + bcol0 + bj * HALF + 4 * n) : (f32x4){0.f, 0.f, 0.f, 0.f};
#pragma unroll
        for (int ai = 0; ai < 2; ++ai)
#pragma unroll
            for (int m = 0; m < 4; ++m) { bf16_t* rowp = base + (size_t)(row0 + ai * HALF + m * 16) * ldc + col0;
#pragma unroll
                for (int bj = 0; bj < 2; ++bj) { f32x4 v0 = acc[ai][bj][m][0] + bv[bj][0], v1 = acc[ai][bj][m][1] + bv[bj][1];
                    if (ACT == 1) { f32x2 a = gelu_pk((f32x2){v0[0], v0[1]}), b = gelu_pk((f32x2){v0[2], v0[3]}), c = gelu_pk((f32x2){v1[0], v1[1]}), d = gelu_pk((f32x2){v1[2], v1[3]});
                        v0 = (f32x4){a.x, a.y, b.x, b.y}; v1 = (f32x4){c.x, c.y, d.x, d.y}; }
                    v0 = v0 * sc; v1 = v1 * sc; u32x4 w; w.x = cvt_pk_bf16(v0[0], v0[1]); w.y = cvt_pk_bf16(v0[2], v0[3]); w.z = cvt_pk_bf16(v1[0], v1[1]); w.w = cvt_pk_bf16(v1[2], v1[3]);
                    *(u32x4*)(rowp + bj * HALF) = w; } }
    }
};

struct PanelStats {
    unsigned* xbuf;
    unsigned* cnt;
    unsigned* tmo;
    int ntn; float eps;
    unsigned code;
    __device__ __forceinline__ bool run(const f32x4 (&v)[2][2][4][2], const Unit& u, int wr, int wc, int fr, int fq, PG8_LAS unsigned char* lds, int wid, int lane) const {
        typedef float f32x2v __attribute__((ext_vector_type(2)));
        PG8_LAS f32x2v* P = (PG8_LAS f32x2v*)lds;
        PG8_LAS f32x2v* S = (PG8_LAS f32x2v*)(lds + 8192);
        PG8_LAS unsigned* flag = (PG8_LAS unsigned*)(lds + 8192 + 2048);
#pragma unroll
        for (int ai = 0; ai < 2; ++ai)
#pragma unroll
            for (int m = 0; m < 4; ++m) {
                float s = 0.f;
#pragma unroll
                for (int bj = 0; bj < 2; ++bj)
#pragma unroll
                    for (int n = 0; n < 2; ++n) { const f32x4 x = v[ai][bj][m][n]; s += (x[0] + x[1]) + (x[2] + x[3]); }
                s += __shfl_xor(s, 16); s += __shfl_xor(s, 32);
                const float mw = s * (1.0f / 64.0f); float q = 0.f;
#pragma unroll
                for (int bj = 0; bj < 2; ++bj)
#pragma unroll
                    for (int n = 0; n < 2; ++n) { const f32x4 d = v[ai][bj][m][n] - mw; q += (d[0] * d[0] + d[1] * d[1]) + (d[2] * d[2] + d[3] * d[3]); }
                q += __shfl_xor(q, 16); q += __shfl_xor(q, 32);
                if (fq == 0) P[(ai * HALF + wr * 64 + m * 16 + fr) * 4 + wc] = (f32x2v){mw, q};
            }
        asm volatile("s_waitcnt lgkmcnt(0)" ::: "memory"); __builtin_amdgcn_s_barrier(); asm volatile("" ::: "memory");
#if defined(BROKEN_EXCHANGE_NO_WAIT)
#warning BROKEN CONTROL BUILD: the row-statistics exchange does not wait; results are wrong by design
        if (blockIdx.x >= 64) { const long long t0_ = clock64(); while (clock64() - t0_ < 60000) __builtin_amdgcn_s_sleep(8); }
#endif
        const int row = wid * 32 + (lane & 31);
        if (lane < 32) {
            const f32x2v a = P[row * 4 + 0], b = P[row * 4 + 1], c = P[row * 4 + 2], d = P[row * 4 + 3];
            const float mt = (a.x + b.x + c.x + d.x) * 0.25f;
            const float da = a.x - mt, db = b.x - mt, dc = c.x - mt, dd = d.x - mt;
            const float m2 = (a.y + b.y) + (c.y + d.y) + 64.0f * ((da * da + db * db) + (dc * dc + dd * dd));
            unsigned long long* slot = (unsigned long long*)xbuf + ((size_t)(u.pm * BM + row) * 4 + u.pn);
            __hip_atomic_store(slot, ((unsigned long long)__float_as_uint(m2) << 32) | __float_as_uint(mt), __ATOMIC_RELAXED, __HIP_MEMORY_SCOPE_AGENT);
        }
        asm volatile("s_waitcnt vmcnt(0)" ::: "memory");
        if (lane == 0) __hip_atomic_fetch_add(cnt + 64 * u.pm, 1u, __ATOMIC_RELAXED, __HIP_MEMORY_SCOPE_AGENT);
        if (wid == 0) {
            bool dead = false; const unsigned long long t0 = __builtin_amdgcn_s_memrealtime(); const unsigned want = 8u * (unsigned)ntn;
            for (;;) {
#if defined(BROKEN_EXCHANGE_NO_WAIT)
                break;
#endif
                if ((unsigned)__builtin_amdgcn_readfirstlane(__hip_atomic_load(cnt + 64 * u.pm, __ATOMIC_RELAXED, __HIP_MEMORY_SCOPE_AGENT)) >= want) break;
                if (__builtin_amdgcn_s_memrealtime() - t0 > 2000000ull) {
                    if (lane == 0) { unsigned expect = 0u; __hip_atomic_compare_exchange_strong(tmo + 1, &expect, code | (unsigned)(u.pm & 0xff), __ATOMIC_RELAXED, __ATOMIC_RELAXED, __HIP_MEMORY_SCOPE_AGENT);
                                     __hip_atomic_store(tmo, 1u, __ATOMIC_RELAXED, __HIP_MEMORY_SCOPE_AGENT); }
                    dead = true; break; }
                __builtin_amdgcn_s_sleep(2);
            }
            __builtin_amdgcn_fence(__ATOMIC_ACQUIRE, "agent");
            if (lane == 0) flag[0] = dead ? 1u : 0u;
        }
        asm volatile("s_waitcnt vmcnt(0) lgkmcnt(0)" ::: "memory"); __builtin_amdgcn_s_barrier(); asm volatile("" ::: "memory");
        const bool bad = flag[0] != 0u;
        if (lane < 32) {
            const unsigned long long* slot = (const unsigned long long*)xbuf + (size_t)(u.pm * BM + row) * 4; float mt[4], m2[4]; float ms = 0.f;
#pragma unroll
            for (int t = 0; t < 4; ++t) { if (t < ntn) { const unsigned long long w = __hip_atomic_load(slot + t, __ATOMIC_RELAXED, __HIP_MEMORY_SCOPE_AGENT); mt[t] = __uint_as_float((unsigned)w); m2[t] = __uint_as_float((unsigned)(w >> 32)); } else { mt[t] = 0.f; m2[t] = 0.f; } ms += mt[t]; }
            const float mean = ms / (float)ntn; float q = 0.f;
#pragma unroll
            for (int t = 0; t < 4; ++t) if (t < ntn) { const float dm = mt[t] - mean; q += m2[t] + 256.0f * dm * dm; }
            S[row] = (f32x2v){mean, 1.0f / sqrtf(q / (256.0f * (float)ntn) + eps)};
        }
        asm volatile("s_waitcnt lgkmcnt(0)" ::: "memory"); __builtin_amdgcn_s_barrier(); asm volatile("" ::: "memory");
        return bad;
    }
};
struct EpiLnRes {
    static constexpr bool PERM = false, AFTER_DRAIN = true;
    const float* base; float* out; int ldc; const float* bias; PanelStats st; unsigned poison;
    __device__ __forceinline__ void fused(f32x4 (&acc)[2][2][4][2], const Unit& u, int wr, int wc, int fr, int fq, PG8_LAS unsigned char* lds, int wid, int lane) const {
        typedef float f32x2v __attribute__((ext_vector_type(2)));
        const PG8_LAS f32x2v* S = (const PG8_LAS f32x2v*)(lds + 8192);
        const int col0 = u.pn * BM + wc * 32 + 4 * fq;
#pragma unroll
        for (int bj = 0; bj < 2; ++bj)
#pragma unroll
            for (int n = 0; n < 2; ++n) { const f32x4 bv = bias ? *(const f32x4*)(bias + col0 + bj * HALF + n * 16) : (f32x4){0.f, 0.f, 0.f, 0.f};
#pragma unroll
                for (int ai = 0; ai < 2; ++ai)
#pragma unroll
                    for (int m = 0; m < 4; ++m) acc[ai][bj][m][n] += bv; }
        f32x4 pre[4][2][2];
#pragma unroll
        for (int m = 0; m < 4; ++m) { const size_t off = (size_t)(u.pm * BM + wr * 64 + m * 16 + fr) * ldc + col0;
#pragma unroll
            for (int bj = 0; bj < 2; ++bj)
#pragma unroll
                for (int n = 0; n < 2; ++n) pre[m][bj][n] = *(const f32x4*)(base + off + bj * HALF + n * 16); }
        const bool bad = st.run(acc, u, wr, wc, fr, fq, lds, wid, lane) || poison != 0u;
        const float qnan = __builtin_nanf("");
#pragma unroll
        for (int ai = 0; ai < 2; ++ai)
#pragma unroll
            for (int m = 0; m < 4; ++m) { const int r = ai * HALF + wr * 64 + m * 16 + fr; const f32x2v sr = S[r]; const size_t off = (size_t)(u.pm * BM + r) * ldc + col0;
#pragma unroll
                for (int bj = 0; bj < 2; ++bj)
#pragma unroll
                    for (int n = 0; n < 2; ++n) { const f32x4 bs = ai == 0 ? pre[m][bj][n] : *(const f32x4*)(base + off + bj * HALF + n * 16); f32x4 o = bs + (acc[ai][bj][m][n] - sr.x) * sr.y;
                        if (bad) o = (f32x4){qnan, qnan, qnan, qnan}; *(f32x4*)(out + off + bj * HALF + n * 16) = o; }
                if (m & 1) asm volatile("" ::: "memory"); }
    }
};
struct EpiLnResLn {
    static constexpr bool PERM = false, AFTER_DRAIN = true;
    const float* base; float* out; bf16_t* xn; int ldc; const float* bias; PanelStats st1, st2; unsigned poison;
    __device__ __forceinline__ void fused(f32x4 (&acc)[2][2][4][2], const Unit& u, int wr, int wc, int fr, int fq, PG8_LAS unsigned char* lds, int wid, int lane) const {
        typedef float f32x2v __attribute__((ext_vector_type(2))); typedef unsigned u32x2v __attribute__((ext_vector_type(2)));
        const PG8_LAS f32x2v* S = (const PG8_LAS f32x2v*)(lds + 8192);
        const int col0 = u.pn * BM + wc * 32 + 4 * fq;
#pragma unroll
        for (int bj = 0; bj < 2; ++bj)
#pragma unroll
            for (int n = 0; n < 2; ++n) { const f32x4 bv = bias ? *(const f32x4*)(bias + col0 + bj * HALF + n * 16) : (f32x4){0.f, 0.f, 0.f, 0.f};
#pragma unroll
                for (int ai = 0; ai < 2; ++ai)
#pragma unroll
                    for (int m = 0; m < 4; ++m) acc[ai][bj][m][n] += bv; }
        bool bad = st1.run(acc, u, wr, wc, fr, fq, lds, wid, lane) || poison != 0u;
        const float qnan = __builtin_nanf("");
#pragma unroll
        for (int ai = 0; ai < 2; ++ai)
#pragma unroll
            for (int m = 0; m < 4; ++m) { const int r = ai * HALF + wr * 64 + m * 16 + fr; const f32x2v sr = S[r]; const size_t off = (size_t)(u.pm * BM + r) * ldc + col0;
#pragma unroll
                for (int bj = 0; bj < 2; ++bj)
#pragma unroll
                    for (int n = 0; n < 2; ++n) { const f32x4 bs = *(const f32x4*)(base + off + bj * HALF + n * 16); acc[ai][bj][m][n] = bs + (acc[ai][bj][m][n] - sr.x) * sr.y; }
                asm volatile("" : "+v"(acc[ai][0][m][0]), "+v"(acc[ai][0][m][1]), "+v"(acc[ai][1][m][0]), "+v"(acc[ai][1][m][1]));
                if (m & 1) asm volatile("" ::: "memory"); }
        const bool bad1 = bad;
        bad = st2.run(acc, u, wr, wc, fr, fq, lds, wid, lane) || bad;
#pragma unroll
        for (int ai = 0; ai < 2; ++ai)
#pragma unroll
            for (int m = 0; m < 4; ++m) { const int r = ai * HALF + wr * 64 + m * 16 + fr; const f32x2v sr = S[r]; const size_t off = (size_t)(u.pm * BM + r) * ldc + col0;
#pragma unroll
                for (int bj = 0; bj < 2; ++bj)
#pragma unroll
                    for (int n = 0; n < 2; ++n) { const f32x4 x1 = acc[ai][bj][m][n]; *(f32x4*)(out + off + bj * HALF + n * 16) = bad1 ? (f32x4){qnan, qnan, qnan, qnan} : x1;
                        const f32x4 o = (x1 - sr.x) * sr.y; u32x2v w; w.x = cvt_pk_bf16(o[0], o[1]); w.y = cvt_pk_bf16(o[2], o[3]);
                        if (bad) { w.x = 0x7fc07fc0u; w.y = 0x7fc07fc0u; } *(u32x2v*)(xn + off + bj * HALF + n * 16) = w; }
                asm volatile("" ::: "memory"); }
    }
};

template <class Epi, class Sched, bool ALIGN_EPI = false, bool SP2 = false>
__device__ __forceinline__ void gemm_phase(PG8_LAS unsigned char* lds, const Gemm g, const Sched& S, const Epi& E) {
    const int tid = opaque_tid(), wid = __builtin_amdgcn_readfirstlane(tid >> 6), lane = tid & 63, wr = wid >> 2, wc = wid & 3, fr = lane & 15, fq = lane >> 4;
    const int K = g.K, nt = K / BK;
    unsigned voffA[2], voffB[2];
#pragma unroll
    for (int i = 0; i < 2; ++i) { int R, C; stage_rc(tid * 16 + i * 8192, R, C); const int Rb = Epi::PERM ? ((R & ~31) + perm32(R & 31)) : R;
        voffA[i] = (unsigned)(R * K + C) * 2u; voffB[i] = (unsigned)(Rb * K + C) * 2u; }
    const size_t kstep = (size_t)(BK * 2);
    const size_t hstep = (size_t)HALF * K * 2;
    const size_t tstep = 2 * hstep;
    const unsigned ldsw = (unsigned)wid * 1024u;
    const int aoff = lds_byte(wr * 64 + fr, fq * 8), boff = lds_byte(wc * 32 + fr, fq * 8);
#define PG8_SA(b, h) (((b) * 2 + (h)) * HTB)
#define PG8_SB(b, h) ((4 + (b) * 2 + (h)) * HTB)
#define PG8_STAGE(bufoff, gbase, voff) do { _Pragma("unroll") for (int _i = 0; _i < 2; ++_i) \
        __builtin_amdgcn_global_load_lds((const unsigned*)((const char*)(gbase) + (voff)[_i]), (PG8_LAS unsigned*)(lds + (bufoff) + ldsw + _i * 8192), 16, 0, 0); } while (0)
#define PG8_LDA(dst, b, h) do { _Pragma("unroll") for (int m = 0; m < 4; ++m) _Pragma("unroll") for (int k = 0; k < 2; ++k) dst[m][k] = *(const PG8_LAS bf16x8*)(lds + PG8_SA(b, h) + aoff + m * 2048 + k * 1024); } while (0)
#define PG8_LDB(dst, b, h) do { _Pragma("unroll") for (int n = 0; n < 2; ++n) _Pragma("unroll") for (int k = 0; k < 2; ++k) dst[n][k] = *(const PG8_LAS bf16x8*)(lds + PG8_SB(b, h) + boff + n * 2048 + k * 1024); } while (0)
#define PG8_MMA(ai, bj, At, Bt) do { __builtin_amdgcn_s_setprio(1); _Pragma("unroll") for (int m = 0; m < 4; ++m) _Pragma("unroll") for (int n = 0; n < 2; ++n) _Pragma("unroll") for (int k = 0; k < 2; ++k) \
        acc[ai][bj][m][n] = __builtin_amdgcn_mfma_f32_16x16x32_bf16(Bt[n][k], At[m][k], acc[ai][bj][m][n], 0, 0, 0); __builtin_amdgcn_s_setprio(0); } while (0)
#define PG8_WAIT_V(n) asm volatile("s_waitcnt vmcnt(" #n ")" ::: "memory")
#define PG8_WAIT_L(n) asm volatile("s_waitcnt lgkmcnt(" #n ")" ::: "memory")
#define PG8_BAR __builtin_amdgcn_s_barrier()
#define PG8_SCHED __builtin_amdgcn_sched_barrier(0)
    Unit cur, nxt; int ui = 0;
    if (!S.next(0, cur)) return;
    f32x4 acc[2][2][4][2];
#pragma unroll
    for (int a = 0; a < 2; ++a)
#pragma unroll
        for (int b = 0; b < 2; ++b)
#pragma unroll
            for (int m = 0; m < 4; ++m)
#pragma unroll
                for (int n = 0; n < 2; ++n) acc[a][b][m][n] = (f32x4){0.f, 0.f, 0.f, 0.f};
    bf16x8 At[4][2], B0[2][2], B1[2][2];
    const char* cA = (const char*)g.A + (size_t)cur.pm * tstep; const char* cB = (const char*)g.Bt + (size_t)cur.pn * tstep;
    S.a_ready(cur);
    if constexpr (SP2) {
        PG8_STAGE(PG8_SB(0, 0), cB, voffB); PG8_STAGE(PG8_SB(0, 1), cB + hstep, voffB); PG8_STAGE(PG8_SA(0, 0), cA, voffA); PG8_STAGE(PG8_SA(0, 1), cA + hstep, voffA);
        if (wr == 1) PG8_BAR;
        PG8_WAIT_V(2); PG8_BAR;
        PG8_STAGE(PG8_SB(1, 0), cB + kstep, voffB); PG8_STAGE(PG8_SA(1, 0), cA + kstep, voffA); PG8_STAGE(PG8_SB(1, 1), cB + hstep + kstep, voffB);
        PG8_WAIT_V(6); PG8_BAR;
    } else {
        PG8_STAGE(PG8_SB(0, 0), cB, voffB); PG8_STAGE(PG8_SA(0, 0), cA, voffA); PG8_STAGE(PG8_SB(0, 1), cB + hstep, voffB); PG8_STAGE(PG8_SA(0, 1), cA + hstep, voffA);
        if (wr == 1) PG8_BAR;
        PG8_WAIT_V(4); PG8_BAR;
        PG8_STAGE(PG8_SB(1, 0), cB + kstep, voffB); PG8_STAGE(PG8_SA(1, 0), cA + kstep, voffA); PG8_STAGE(PG8_SB(1, 1), cB + hstep + kstep, voffB);
        PG8_WAIT_V(6); PG8_BAR;
    }
    for (;;) {
        const bool has_next = S.next(ui + 1, nxt);
        const char* nA = has_next ? (const char*)g.A + (size_t)nxt.pm * tstep : cA; const char* nB = has_next ? (const char*)g.Bt + (size_t)nxt.pn * tstep : cB;
        for (int t = 0; t < nt; t += 2) {
            const bool last = (t == nt - 2);
            const char* a1 = cA + (size_t)(t + 1) * kstep;
            const char* a2 = last ? nA : cA + (size_t)(t + 2) * kstep; const char* b2 = last ? nB : cB + (size_t)(t + 2) * kstep;
            const char* a3 = a2 + kstep; const char* b3 = b2 + kstep;
            if (last && has_next) S.a_ready(nxt);
            if constexpr (SP2) {
            PG8_LDB(B0, 0, 0); PG8_LDB(B1, 0, 1); PG8_SCHED; PG8_LDA(At, 0, 0); PG8_STAGE(PG8_SA(1, 1), a1 + hstep, voffA);
            PG8_WAIT_V(8); PG8_WAIT_L(0); PG8_BAR; PG8_MMA(0, 0, At, B0); PG8_MMA(0, 1, At, B1); PG8_BAR; PG8_SCHED;
            PG8_LDA(At, 0, 1); PG8_STAGE(PG8_SB(0, 0), b2, voffB); PG8_STAGE(PG8_SB(0, 1), b2 + hstep, voffB); PG8_STAGE(PG8_SA(0, 0), a2, voffA);
            PG8_WAIT_V(8); PG8_WAIT_L(0); PG8_BAR; PG8_MMA(1, 0, At, B0); PG8_MMA(1, 1, At, B1); PG8_BAR; PG8_SCHED;
            PG8_LDB(B0, 1, 0); PG8_LDB(B1, 1, 1); PG8_SCHED; PG8_LDA(At, 1, 0); PG8_STAGE(PG8_SA(0, 1), a2 + hstep, voffA);
            PG8_WAIT_V(8); PG8_WAIT_L(0); PG8_BAR; PG8_MMA(0, 0, At, B0); PG8_MMA(0, 1, At, B1); PG8_BAR; PG8_SCHED;
            PG8_LDA(At, 1, 1); PG8_STAGE(PG8_SB(1, 0), b3, voffB); PG8_STAGE(PG8_SB(1, 1), b3 + hstep, voffB); PG8_STAGE(PG8_SA(1, 0), a3, voffA);
            PG8_WAIT_V(8); PG8_WAIT_L(0); PG8_BAR; PG8_MMA(1, 0, At, B0); PG8_MMA(1, 1, At, B1); PG8_BAR; PG8_SCHED;
            } else {
            PG8_LDB(B0, 0, 0); PG8_SCHED; PG8_LDA(At, 0, 0); PG8_STAGE(PG8_SA(1, 1), a1 + hstep, voffA);
            PG8_WAIT_L(8); PG8_BAR; PG8_WAIT_L(0); PG8_MMA(0, 0, At, B0); PG8_BAR; PG8_SCHED;
            PG8_LDB(B1, 0, 1); PG8_STAGE(PG8_SB(0, 0), b2, voffB);
            PG8_BAR; PG8_WAIT_L(0); PG8_MMA(0, 1, At, B1); PG8_BAR;
            PG8_LDA(At, 0, 1); PG8_STAGE(PG8_SA(0, 0), a2, voffA);
            PG8_BAR; PG8_WAIT_L(0); PG8_MMA(1, 0, At, B0); PG8_BAR; PG8_SCHED;
            PG8_STAGE(PG8_SB(0, 1), b2 + hstep, voffB);
            PG8_WAIT_V(6); PG8_BAR; PG8_MMA(1, 1, At, B1); PG8_BAR;
            PG8_LDB(B0, 1, 0); PG8_SCHED; PG8_LDA(At, 1, 0); PG8_STAGE(PG8_SA(0, 1), a2 + hstep, voffA);
            PG8_WAIT_L(8); PG8_BAR; PG8_WAIT_L(0); PG8_MMA(0, 0, At, B0); PG8_BAR; PG8_SCHED;
            PG8_LDB(B1, 1, 1); PG8_STAGE(PG8_SB(1, 0), b3, voffB);
            PG8_BAR; PG8_WAIT_L(0); PG8_MMA(0, 1, At, B1); PG8_BAR;
            PG8_LDA(At, 1, 1); PG8_STAGE(PG8_SA(1, 0), a3, voffA);
            PG8_BAR; PG8_WAIT_L(0); PG8_MMA(1, 0, At, B0); PG8_BAR; PG8_SCHED;
            PG8_STAGE(PG8_SB(1, 1), b3 + hstep, voffB);
            PG8_WAIT_V(6); PG8_BAR; PG8_MMA(1, 1, At, B1); PG8_BAR;
            }
        }
        if constexpr (ALIGN_EPI) { if (wr == 0) PG8_BAR; }
        if constexpr (!Epi::AFTER_DRAIN) { E(acc, cur, wr, wc, fr, fq); S.done(cur); }
        if (!has_next) break;
#pragma unroll
        for (int a = 0; a < 2; ++a)
#pragma unroll
            for (int b = 0; b < 2; ++b)
#pragma unroll
                for (int m = 0; m < 4; ++m)
#pragma unroll
                    for (int n = 0; n < 2; ++n) acc[a][b][m][n] = (f32x4){0.f, 0.f, 0.f, 0.f};
        cur = nxt; cA = nA; cB = nB; ++ui;
        if constexpr (ALIGN_EPI) { if (wr == 1) PG8_BAR; }
    }
    PG8_WAIT_V(0);
    if constexpr (!ALIGN_EPI) { if (wr == 0) PG8_BAR; }
    PG8_BAR;
    if constexpr (Epi::AFTER_DRAIN) { E.fused(acc, cur, wr, wc, fr, fq, lds, wid, lane); S.done(cur); }
#undef PG8_SA
#undef PG8_SB
#undef PG8_STAGE
#undef PG8_LDA
#undef PG8_LDB
#undef PG8_MMA
#undef PG8_WAIT_V
#undef PG8_WAIT_L
#undef PG8_BAR
#undef PG8_SCHED
}
}
namespace pg8 {
struct EpiSwiGLU {
    static constexpr bool PERM = true, AFTER_DRAIN = false;
    bf16_t* O; int ldc;
    static __device__ __forceinline__ float silu_mul(float g, float u) { const float e = __builtin_amdgcn_exp2f(-1.4426950408889634f * g); return g * __builtin_amdgcn_rcpf(1.0f + e) * u; }
    __device__ __forceinline__ void operator()(const f32x4 (&acc)[2][2][4][2], const Unit& u, int wr, int wc, int fr, int fq) const {
        const int row0 = u.pm * BM + wr * 64 + fr, col0 = u.pn * HALF + wc * 32 + 8 * fq;
#pragma unroll
        for (int ai = 0; ai < 2; ++ai)
#pragma unroll
            for (int m = 0; m < 4; ++m) { bf16_t* rowp = O + (size_t)(row0 + ai * HALF + m * 16) * ldc + col0;
                const f32x4 g0 = acc[ai][0][m][0], g1 = acc[ai][0][m][1], u0 = acc[ai][1][m][0], u1 = acc[ai][1][m][1];
                u32x4 w; w.x = cvt_pk_bf16(silu_mul(g0[0], u0[0]), silu_mul(g0[1], u0[1])); w.y = cvt_pk_bf16(silu_mul(g0[2], u0[2]), silu_mul(g0[3], u0[3]));
                w.z = cvt_pk_bf16(silu_mul(g1[0], u1[0]), silu_mul(g1[1], u1[1])); w.w = cvt_pk_bf16(silu_mul(g1[2], u1[2]), silu_mul(g1[3], u1[3]));
                *(u32x4*)rowp = w; }
    }
};
struct EpiQKV {
    static constexpr bool PERM = true, AFTER_DRAIN = false;
    bf16_t* Q; size_t buf_stride; const float* rope; float scale0;
    __device__ __forceinline__ void operator()(const f32x4 (&acc)[2][2][4][2], const Unit& u, int wr, int wc, int fr, int fq) const {
        const int t = u.pn >> 2; bf16_t* base = Q + (size_t)t * buf_stride; const float sc = (t == 0) ? scale0 : 1.f;
        const int col0 = (u.pn & 3) * BM + wc * 32 + 8 * fq;
        const bool rot = (t < 2) && ((wc & 1) == 0);
        const float sgn = (fq == 0) ? -1.f : 1.f;
#pragma unroll
        for (int ai = 0; ai < 2; ++ai)
#pragma unroll
            for (int m = 0; m < 4; ++m) { const int r = ai * HALF + wr * 64 + m * 16 + fr; int orow, pos; bool valid = true;
                if (u.pm < 64) { orow = (u.pm >> 3) * 2112 + 64 + (u.pm & 7) * 256 + r; pos = 16 + (u.pm & 7) * 256 + r; }
                else { valid = r < 128; orow = (r >> 4) * 2112 + 48 + (r & 15); pos = r & 15; }
                f32x4 cs0 = {1.f, 1.f, 1.f, 1.f}, cs1 = cs0, sn0 = {0.f, 0.f, 0.f, 0.f}, sn1 = sn0;
                if (rot && fq < 2) { const f32x4* rp = (const f32x4*)(rope + (size_t)pos * 16); cs0 = rp[0]; cs1 = rp[1]; sn0 = rp[2]; sn1 = rp[3]; }
#pragma unroll
                for (int bj = 0; bj < 2; ++bj) { f32x4 v0 = acc[ai][bj][m][0], v1 = acc[ai][bj][m][1];
                    if (rot) { f32x4 o0, o1;
#pragma unroll
                        for (int i = 0; i < 4; ++i) { o0[i] = __shfl_xor(v0[i], 16); o1[i] = __shfl_xor(v1[i], 16); }
                        v0 = v0 * cs0 + (o0 * sn0) * sgn; v1 = v1 * cs1 + (o1 * sn1) * sgn; }
                    v0 = v0 * sc; v1 = v1 * sc; u32x4 w; w.x = cvt_pk_bf16(v0[0], v0[1]); w.y = cvt_pk_bf16(v0[2], v0[3]); w.z = cvt_pk_bf16(v1[0], v1[1]); w.w = cvt_pk_bf16(v1[2], v1[3]);
                    if (valid) *(u32x4*)(base + (size_t)orow * 1024 + col0 + bj * HALF) = w; } }
    }
};
}
#include <hip/hip_bf16.h>
#include <cmath>
namespace attn_body {
using bf16=__hip_bfloat16;
using bf16x8=__attribute__((ext_vector_type(8)))short;
using s16x4=__attribute__((ext_vector_type(4)))short;
using f32x16=__attribute__((ext_vector_type(16)))float;
using u32x4=__attribute__((ext_vector_type(4)))unsigned;
constexpr int D=64,DM=1024,OPITCH=2048,BSTRIDE=2112,FRONT=48,RVEND=2112;
constexpr int NW=8,QBLK=32,QB=QBLK*NW,KVBLK=64,NQB=9;
constexpr int ATTN_PITCH=DM, ATTN_UNIT_ROWS=QB;
__device__ __forceinline__ int crow(int r,int hi){return (r&3)+8*(r>>2)+4*hi;}
#define SBAR() __builtin_amdgcn_sched_barrier(0)
__device__ __forceinline__ void cmask(f32x16&p0,f32x16&p1,int jb,int qrel,int hi){
  const float NEG=-INFINITY; int kb=64*jb+4*hi;
  #pragma unroll
  for(int r=0;r<16;++r){int kv=kb+(r&3)+8*(r>>2); if(kv>qrel)p0[r]=NEG; if(kv+32>qrel)p1[r]=NEG;}
}

constexpr int NSLOT=3, SLOTB=8192;
constexpr int LDS_K=0, LDS_V=NSLOT*SLOTB, LDS_WS=3*NSLOT*SLOTB, LDS_OST=LDS_WS+NW*64*4, LDS_BYTES=LDS_OST+NW*4096;
constexpr float C2=0.125f*1.4426950408889634f;
__device__ __forceinline__ void glds16(const void*gsrc,unsigned lds_dst){unsigned keep;
  asm volatile("s_mov_b32 %0, m0\n\ts_mov_b32 m0, %2\n\ts_nop 0\n\tglobal_load_lds_dwordx4 %1, off\n\ts_mov_b32 m0, %0":"=&s"(keep):"v"(gsrc),"s"(lds_dst):"memory");}
__device__ __forceinline__ float max3f(float a,float b,float c){float r;asm("v_max3_f32 %0, %1, %2, %3":"=v"(r):"v"(a),"v"(b),"v"(c));return r;}
__device__ __forceinline__ float max2f(float a,float b){float r;asm("v_max_f32_e32 %0, %1, %2":"=v"(r):"v"(a),"v"(b));return r;}
__device__ __forceinline__ float fadd_s(float a,float b){float r;asm("v_add_f32_e32 %0, %1, %2":"=v"(r):"v"(a),"v"(b));return r;}
__device__ __forceinline__ float fsub_s(float a,float b){float r;asm("v_sub_f32_e32 %0, %1, %2":"=v"(r):"v"(a),"v"(b));return r;}
typedef float f32x2_t __attribute__((ext_vector_type(2))); typedef __bf16 bf16x2_t __attribute__((ext_vector_type(2)));
__device__ __forceinline__ unsigned cvtpk_s(float lo,float hi){f32x2_t v={lo,hi};bf16x2_t b=__builtin_convertvector(v,bf16x2_t);return __builtin_bit_cast(unsigned,b);}
#define WAIT_BAR(N) asm volatile("s_waitcnt vmcnt(" #N ") lgkmcnt(0)\n\ts_barrier":::"memory")

__device__ __forceinline__ void qkt(f32x16&p0,f32x16&p1,const char*Kslot,const bf16x8*qr,const f32x16&negm,int r32,int hi){
  const char*kb=Kslot+hi*1024+r32*16;
  #pragma unroll
  for(int d0=0;d0<4;++d0){
    const bf16x8 b0=*reinterpret_cast<const bf16x8*>(kb+d0*2048);
    const bf16x8 b1=*reinterpret_cast<const bf16x8*>(kb+d0*2048+512);
    if(d0==0){p0=__builtin_amdgcn_mfma_f32_32x32x16_bf16(b0,qr[0],negm,0,0,0);p1=__builtin_amdgcn_mfma_f32_32x32x16_bf16(b1,qr[0],negm,0,0,0);}
    else{p0=__builtin_amdgcn_mfma_f32_32x32x16_bf16(b0,qr[d0],p0,0,0,0);p1=__builtin_amdgcn_mfma_f32_32x32x16_bf16(b1,qr[d0],p1,0,0,0);}}
}
typedef __attribute__((address_space(3))) const char* lds_cptr;
typedef short v4i16_t __attribute__((ext_vector_type(4)));
__device__ __forceinline__ void kload8(bf16x8*kf,lds_cptr kp){
  kf[0]=*(const __attribute__((address_space(3))) bf16x8*)(kp);      kf[1]=*(const __attribute__((address_space(3))) bf16x8*)(kp+512);
  kf[2]=*(const __attribute__((address_space(3))) bf16x8*)(kp+2048); kf[3]=*(const __attribute__((address_space(3))) bf16x8*)(kp+2560);
  kf[4]=*(const __attribute__((address_space(3))) bf16x8*)(kp+4096); kf[5]=*(const __attribute__((address_space(3))) bf16x8*)(kp+4608);
  kf[6]=*(const __attribute__((address_space(3))) bf16x8*)(kp+6144); kf[7]=*(const __attribute__((address_space(3))) bf16x8*)(kp+6656);
}
__device__ __forceinline__ void kload2(bf16x8*kf,lds_cptr kp,int j){ kf[2*j]=*(const __attribute__((address_space(3))) bf16x8*)(kp+j*2048); kf[2*j+1]=*(const __attribute__((address_space(3))) bf16x8*)(kp+j*2048+512); }
__device__ __forceinline__ s16x4 vtr(lds_cptr p){ return __builtin_bit_cast(s16x4,__builtin_amdgcn_ds_read_tr16_b64_v4i16((__attribute__((address_space(3))) v4i16_t*)p)); }
__device__ __forceinline__ float rowmax(const f32x16&p0,const f32x16&p1){
  float a=max3f(p0[0],p0[1],p1[0]),b=max3f(p0[2],p0[3],p1[1]);a=max3f(a,p1[2],p1[3]);
  #pragma unroll
  for(int r=4;r<16;r+=4){a=max3f(a,p0[r],p0[r+1]);b=max3f(b,p0[r+2],p0[r+3]);a=max3f(a,p1[r],p1[r+1]);b=max3f(b,p1[r+2],p1[r+3]);}
  const float m=max2f(a,b);
  auto rr=__builtin_amdgcn_permlane32_swap(__float_as_uint(m),__float_as_uint(m),false,false);
  return max2f(__uint_as_float(rr[0]),__uint_as_float(rr[1]));
}
__device__ __forceinline__ void pv(f32x16*o,int vb,bf16x8 pa0,bf16x8 pa1,bf16x8 pa2,bf16x8 pa3){
  #pragma unroll
  for(int d0=0;d0<2;++d0){s16x4 lo[4],hi[4];
    #pragma unroll
    for(int ks=0;ks<4;++ks){
      asm volatile("ds_read_b64_tr_b16 %0,%1 offset:%c2":"=&v"(lo[ks]):"v"(vb),"i"(d0*4096+ks*1024):"memory");
      asm volatile("ds_read_b64_tr_b16 %0,%1 offset:%c2":"=&v"(hi[ks]):"v"(vb),"i"(d0*4096+ks*1024+512):"memory");}
    asm volatile("s_waitcnt lgkmcnt(0)":::"memory");SBAR();
    #define PK(k) (bf16x8){lo[k][0],lo[k][1],lo[k][2],lo[k][3],hi[k][0],hi[k][1],hi[k][2],hi[k][3]}
    o[d0]=__builtin_amdgcn_mfma_f32_32x32x16_bf16(pa0,PK(0),o[d0],0,0,0);
    o[d0]=__builtin_amdgcn_mfma_f32_32x32x16_bf16(pa1,PK(1),o[d0],0,0,0);
    o[d0]=__builtin_amdgcn_mfma_f32_32x32x16_bf16(pa2,PK(2),o[d0],0,0,0);
    o[d0]=__builtin_amdgcn_mfma_f32_32x32x16_bf16(pa3,PK(3),o[d0],0,0,0);
    #undef PK
  }
}

#ifndef ATTN_STORE16
#define ATTN_STORE16(p,v) (*(u32x4*)(p)=(v))
#endif
template<int THRL,bool ODD> __device__ __forceinline__ void attn_unit(int b,int cq,int cv,int co,int q0,const bf16*Q,const bf16*__restrict__ K,const bf16*__restrict__ V,bf16*O,char*shm){
  const int tid=opaque_tid(),lane=tid&63,r32=lane&31,hi=lane>>5; const int wid=__builtin_amdgcn_readfirstlane(tid>>6);
  const long rowbase=(long)b*BSTRIDE;
  const bf16*Qw=Q+(rowbase+q0+wid*QBLK)*DM+cq;
  const bf16*Kh=K+rowbase*DM+cq,*Vh=V+rowbase*DM+cv;
  const unsigned lds0=(unsigned)(uintptr_t)shm;
  float*wsf=(float*)(shm+LDS_WS)+wid*64;
  const bf16*ksrc=Kh+(long)lane*DM+wid*8;
  const bf16*vsrc=Vh+(long)(16*(wid&3)+(lane>>2))*DM+(wid>>2)*32+(lane&3)*8;
  const unsigned kdst=lds0+LDS_K+wid*1024, vdst=lds0+LDS_V+wid*1024;
  #define DMA_K(t,slot) glds16(ksrc+(long)(t)*KVBLK*DM,(unsigned)__builtin_amdgcn_readfirstlane(kdst+(slot)))
  #define DMA_V(t,slot) do{ glds16(vsrc+(long)(t)*KVBLK*DM,(unsigned)__builtin_amdgcn_readfirstlane(vdst+2*(slot))); glds16(vsrc+(long)(t)*KVBLK*DM+64,(unsigned)__builtin_amdgcn_readfirstlane(vdst+2*(slot)+SLOTB)); }while(0)
  const int vb0=(int)(lds0+LDS_V)+((lane>>4)&1)*32+(lane&3)*8+(4*hi+((lane&15)>>2))*64;
  const char*Kbase=shm+LDS_K; bf16x8 kf[8];
  const lds_cptr shm3=(lds_cptr)shm; const lds_cptr kp0=shm3+LDS_K+hi*1024+r32*16; const lds_cptr vp0=shm3+LDS_V+((lane>>4)&1)*32+(lane&3)*8+(4*hi+((lane&15)>>2))*64;
  const int NT=(q0+QB)/KVBLK;
  DMA_K(0,0);DMA_V(0,0);DMA_K(1,SLOTB);
  bf16x8 qr[4];
  #pragma unroll
  for(int d0=0;d0<4;++d0)qr[d0]=*reinterpret_cast<const bf16x8*>(&Qw[(long)r32*DM+d0*16+hi*8]);
  float mhat=0.f,l_reg=0.f;f32x16 o[4];o[0]=f32x16{};o[1]=f32x16{};o[2]=f32x16{};o[3]=f32x16{};const f32x16 zero16=f32x16{};
  const int qrel=wid*QBLK+r32;
  #define CMASK(P0,P1,t) do{int jb_=(t)-(NT-4); if(jb_>=0)cmask(P0,P1,jb_,qrel,hi);}while(0)
  #define CM1(P0,P1,t,r) do{int jb_=(t)-(NT-4); if(jb_>=0){ const int kv_=64*jb_+4*hi+((r)&3)+8*((r)>>2); if(kv_>qrel)P0[r]=-INFINITY; if(kv_+32>qrel)P1[r]=-INFINITY; } }while(0)
  bool resc=false;
  #define START(P0,P1) do{ const float rm=rowmax(P0,P1); resc=false; \
    { const float dl=rm; mhat=fadd_s(mhat,dl); \
      _Pragma("unroll") for(int r=0;r<16;++r){P0[r]=fsub_s(P0[r],dl);P1[r]=fsub_s(P1[r],dl);} \
      } \
    _Pragma("unroll") for(int r=0;r<16;++r)P0[r]=__builtin_amdgcn_exp2f(P0[r]); }while(0)
  #define RESC() do{ if(resc){ asm volatile("s_waitcnt lgkmcnt(0)":::"memory"); \
      _Pragma("unroll") for(int d_=0;d_<4;++d_) _Pragma("unroll") for(int r=0;r<16;++r)o[d_][r]*=wsf[crow(r,hi)]; } }while(0)
  f32x16 pA0,pA1,pB0,pB1;
  int sl_prev=0,sl_cur=0,sl_next=SLOTB;
  #define ROT() do{sl_prev=sl_cur;sl_cur=sl_next;sl_next=(sl_next==(NSLOT-1)*SLOTB)?0:sl_next+SLOTB;}while(0)
  DMA_K(2,2*SLOTB);
  WAIT_BAR(3);
  qkt(pA0,pA1,Kbase,qr,zero16,r32,hi);asm volatile("s_nop 15\n\ts_nop 7":"+v"(pA0),"+v"(pA1));CMASK(pA0,pA1,0);
  if(q0+qrel>=FRONT){ _Pragma("unroll") for(int r=0;r<16;++r)pA0[r]=-INFINITY; _Pragma("unroll") for(int r=0;r<8;++r)pA1[r]=-INFINITY; }
  START(pA0,pA1);
  _Pragma("unroll") for(int r=0;r<16;++r)pA1[r]=__builtin_amdgcn_exp2f(pA1[r]);
  WAIT_BAR(0);
  DMA_K(3,0);DMA_V(1,SLOTB);
  ROT();
  kload8(kf,kp0+sl_cur);
  WAIT_BAR(3);
  s16x4 vlo[8],vhi[8]; u32x4 pw0,pw1,pw2,pw3;
  #define PKW(P,B) cvtpk_s(P[B],P[B+1])
  #define PAF(k) __builtin_bit_cast(bf16x8,pw##k)
  #define PIN(x) asm volatile("":"+v"(x))
  #define MX3(a,b,c) __builtin_fmaxf(__builtin_fmaxf((a),(b)),(c))
  #define GAPA(MF,A0,A1,A2,A3,W0,W1,PW) do{ MF; sacc+=A0; sacc+=A1; sacc+=A2; sacc+=A3; PIN(sacc); W0; W1; PIN(PW); SBAR(); }while(0)
  #define EX(v) __builtin_amdgcn_exp2f(v)
  #define GAPS(MF,X0,X1,t,R) do{ MF; X0[R]-=mhat; X0[(R)+1]-=mhat; X1[R]-=mhat; X1[(R)+1]-=mhat; CM1(X0,X1,t,R); CM1(X0,X1,t,(R)+1); mxa=MX3(mxa,X0[R],X0[(R)+1]); mxb=MX3(mxb,X1[R],X1[(R)+1]); PIN(mxa); PIN(mxb); SBAR(); }while(0)
  #define GAPB(MF,X,B) do{ MF; X[B]=EX(X[B]); X[B+1]=EX(X[B+1]); X[B+2]=EX(X[B+2]); X[B+3]=EX(X[B+3]); PIN(X); SBAR(); }while(0)
  #define VRD(i,hf) do{ vlo[(i)&7]=vtr(vp_+((hf)*8192+((i)>>2)*4096+((i)&3)*1024)); vhi[(i)&7]=vtr(vp_+((hf)*8192+((i)>>2)*4096+((i)&3)*1024+512)); }while(0)
  #define KRD(G,j) do{ if(G){ kload2(kf,kp0+sl_next,j); SBAR(); } }while(0)
  #define VF4(i) (bf16x8){vlo[i][0],vlo[i][1],vlo[i][2],vlo[i][3],vhi[i][0],vhi[i][1],vhi[i][2],vhi[i][3]}
  #define STEP(C0,C1,P0,P1,t,GK,GV,GL) do{ SBAR(); \
      \
    if(GV){DMA_V((t)+1,sl_next);} if(GK){DMA_K((t)+3,sl_cur);} \
    const lds_cptr vp_=vp0+2*sl_prev; \
    float sacc=(P0[0]+P0[1]); \
    GAPA(C0=__builtin_amdgcn_mfma_f32_32x32x16_bf16(kf[0],qr[0],zero16,0,0,0), P0[2],P0[3],P0[4],P0[5],     pw0[0]=PKW(P0,0), pw0[1]=PKW(P0,2), pw0); \
    GAPA(C1=__builtin_amdgcn_mfma_f32_32x32x16_bf16(kf[1],qr[0],zero16,0,0,0), P0[6],P0[7],P0[8],P0[9],     pw0[2]=PKW(P0,4), pw0[3]=PKW(P0,6), pw0); \
    GAPA(C0=__builtin_amdgcn_mfma_f32_32x32x16_bf16(kf[2],qr[1],C0,0,0,0),   P0[10],P0[11],P0[12],P0[13], pw1[0]=PKW(P0,8), pw1[1]=PKW(P0,10), pw1); \
    GAPA(C1=__builtin_amdgcn_mfma_f32_32x32x16_bf16(kf[3],qr[1],C1,0,0,0),   P0[14],P0[15],P1[0],P1[1],   pw1[2]=PKW(P0,12),pw1[3]=PKW(P0,14), pw1); \
    GAPA(C0=__builtin_amdgcn_mfma_f32_32x32x16_bf16(kf[4],qr[2],C0,0,0,0),   P1[2],P1[3],P1[4],P1[5],     pw2[0]=PKW(P1,0), pw2[1]=PKW(P1,2), pw2); \
    GAPA(C1=__builtin_amdgcn_mfma_f32_32x32x16_bf16(kf[5],qr[2],C1,0,0,0),   P1[6],P1[7],P1[8],P1[9],     pw2[2]=PKW(P1,4), pw2[3]=PKW(P1,6), pw2); \
    GAPA(C0=__builtin_amdgcn_mfma_f32_32x32x16_bf16(kf[6],qr[3],C0,0,0,0),   P1[10],P1[11],P1[12],P1[13], pw3[0]=PKW(P1,8), pw3[1]=PKW(P1,10), pw3); \
    VRD(0,0); VRD(1,0); VRD(2,0); VRD(3,0); SBAR(); \
    GAPA(C1=__builtin_amdgcn_mfma_f32_32x32x16_bf16(kf[7],qr[3],C1,0,0,0),   P1[14],P1[15],0.f,0.f,       pw3[2]=PKW(P1,12),pw3[3]=PKW(P1,14), pw3); \
    l_reg+=sacc; \
      \
      \
    VRD(4,0); VRD(5,0); VRD(6,0); VRD(7,0); SBAR(); \
    float mxa=-INFINITY,mxb=-INFINITY; \
    GAPS(o[0]=__builtin_amdgcn_mfma_f32_32x32x16_bf16(PAF(0),VF4(0),o[0],0,0,0), C0,C1,t,0); \
    GAPS(o[0]=__builtin_amdgcn_mfma_f32_32x32x16_bf16(PAF(1),VF4(1),o[0],0,0,0), C0,C1,t,2); \
    GAPS(o[0]=__builtin_amdgcn_mfma_f32_32x32x16_bf16(PAF(2),VF4(2),o[0],0,0,0), C0,C1,t,4); \
    GAPS(o[0]=__builtin_amdgcn_mfma_f32_32x32x16_bf16(PAF(3),VF4(3),o[0],0,0,0), C0,C1,t,6); \
    VRD(0,1); VRD(1,1); VRD(2,1); VRD(3,1); KRD(GL,0); SBAR(); \
    GAPS(o[1]=__builtin_amdgcn_mfma_f32_32x32x16_bf16(PAF(0),VF4(4),o[1],0,0,0), C0,C1,t,8); \
    GAPS(o[1]=__builtin_amdgcn_mfma_f32_32x32x16_bf16(PAF(1),VF4(5),o[1],0,0,0), C0,C1,t,10); \
    GAPS(o[1]=__builtin_amdgcn_mfma_f32_32x32x16_bf16(PAF(2),VF4(6),o[1],0,0,0), C0,C1,t,12); \
    GAPS(o[1]=__builtin_amdgcn_mfma_f32_32x32x16_bf16(PAF(3),VF4(7),o[1],0,0,0), C0,C1,t,14); \
    { float rm=__builtin_fmaxf(mxa,mxb); { auto rr=__builtin_amdgcn_permlane32_swap(__float_as_uint(rm),__float_as_uint(rm),false,false); rm=__builtin_fmaxf(__uint_as_float(rr[0]),__uint_as_float(rr[1])); } \
      resc=false; \
      if(__builtin_expect(__any(rm>(float)THRL),0)){ const float dl=__builtin_fmaxf(rm,0.f); mhat+=dl; \
        _Pragma("unroll") for(int r=0;r<16;++r){C0[r]-=dl;C1[r]-=dl;} \
        const float f=__builtin_amdgcn_exp2f(-dl); l_reg*=f; if(hi==0)wsf[r32]=f; resc=true; } } \
    SBAR(); \
    VRD(4,1); VRD(5,1); VRD(6,1); VRD(7,1); KRD(GL,1); SBAR(); \
    GAPB(o[2]=__builtin_amdgcn_mfma_f32_32x32x16_bf16(PAF(0),VF4(0),o[2],0,0,0), C0,0); \
    GAPB(o[2]=__builtin_amdgcn_mfma_f32_32x32x16_bf16(PAF(1),VF4(1),o[2],0,0,0), C0,4); \
    GAPB(o[2]=__builtin_amdgcn_mfma_f32_32x32x16_bf16(PAF(2),VF4(2),o[2],0,0,0), C0,8); \
    GAPB(o[2]=__builtin_amdgcn_mfma_f32_32x32x16_bf16(PAF(3),VF4(3),o[2],0,0,0), C0,12); \
    KRD(GL,2); \
    GAPB(o[3]=__builtin_amdgcn_mfma_f32_32x32x16_bf16(PAF(0),VF4(4),o[3],0,0,0), C1,0); \
    GAPB(o[3]=__builtin_amdgcn_mfma_f32_32x32x16_bf16(PAF(1),VF4(5),o[3],0,0,0), C1,4); \
    KRD(GL,3); \
    GAPB(o[3]=__builtin_amdgcn_mfma_f32_32x32x16_bf16(PAF(2),VF4(6),o[3],0,0,0), C1,8); \
    GAPB(o[3]=__builtin_amdgcn_mfma_f32_32x32x16_bf16(PAF(3),VF4(7),o[3],0,0,0), C1,12); \
    }while(0)
  int t=1;
  #undef CMASK
  #define CMASK(P0,P1,t) do{}while(0)
  #undef CM1
  #define CM1(P0,P1,t,r) do{}while(0)
  for(;t+5<NT;t+=2){
    STEP(pB0,pB1,pA0,pA1,t,true,true,true);     WAIT_BAR(3); RESC(); ROT();
    STEP(pA0,pA1,pB0,pB1,t+1,true,true,true);   WAIT_BAR(3); RESC(); ROT();
  }
  #undef CMASK
  #define CMASK(P0,P1,t) do{int jb_=(t)-(NT-4); if(jb_>=0)cmask(P0,P1,jb_,qrel,hi);}while(0)
  #undef CM1
  #define CM1(P0,P1,t,r) do{int jb_=(t)-(NT-4); if(jb_>=0){ const int kv_=64*jb_+4*hi+((r)&3)+8*((r)>>2); if(kv_>qrel)P0[r]=-INFINITY; if(kv_+32>qrel)P1[r]=-INFINITY; } }while(0)
  #define ENDW(tt) do{ if((tt)+3<NT){WAIT_BAR(3);} else if((tt)+2<NT){WAIT_BAR(2);} else {WAIT_BAR(0);} }while(0)
  for(;t+1<NT;t+=2){
    STEP(pB0,pB1,pA0,pA1,t,(t+3<NT),(t+1<NT),(t+1<NT));       ENDW(t);   RESC(); ROT();
    STEP(pA0,pA1,pB0,pB1,t+1,(t+4<NT),(t+2<NT),(t+2<NT));     ENDW(t+1); RESC(); ROT();
  }
  #define DRAIN(Q0,Q1,SL) do{ float sacc=Q0[0]+Q0[1]; _Pragma("unroll") for(int r=2;r<16;++r)sacc+=Q0[r]; _Pragma("unroll") for(int r=0;r<16;++r)sacc+=Q1[r]; l_reg+=sacc; \
    pw0=(u32x4){PKW(Q0,0),PKW(Q0,2),PKW(Q0,4),PKW(Q0,6)};pw1=(u32x4){PKW(Q0,8),PKW(Q0,10),PKW(Q0,12),PKW(Q0,14)};pw2=(u32x4){PKW(Q1,0),PKW(Q1,2),PKW(Q1,4),PKW(Q1,6)};pw3=(u32x4){PKW(Q1,8),PKW(Q1,10),PKW(Q1,12),PKW(Q1,14)}; \
    SBAR(); pv(o,vb0+2*(SL),PAF(0),PAF(1),PAF(2),PAF(3)); pv(o+2,vb0+2*(SL)+SLOTB,PAF(0),PAF(1),PAF(2),PAF(3)); }while(0)
  if constexpr(ODD){ DRAIN(pA0,pA1,sl_prev); }
  else{ STEP(pB0,pB1,pA0,pA1,NT-1,false,false,false); RESC(); DRAIN(pB0,pB1,sl_cur); }
  #undef DRAIN
  #undef PKW
  #undef PAF
  #undef VF4
  #undef PIN
  #undef MX3
  #undef GAPA
  #undef GAPB
  #undef GAPS
  #undef EX
  #undef VRD
  #undef KRD
  #undef STEP
  #undef ENDW
  {auto rr=__builtin_amdgcn_permlane32_swap(__float_as_uint(l_reg),__float_as_uint(l_reg),false,false);l_reg=__uint_as_float(rr[0])+__uint_as_float(rr[1]);}
  if(hi==0)wsf[32+r32]=l_reg;asm volatile("s_waitcnt lgkmcnt(0)":::"memory");
  float rli[16];
  #pragma unroll
  for(int r=0;r<16;++r)rli[r]=__builtin_amdgcn_rcpf(wsf[32+crow(r,hi)]);
  bf16*Ow=O+co;
  { bf16*stg=(bf16*)(shm+LDS_OST)+wid*2048;
    #pragma unroll
    for(int hf=0;hf<2;++hf){
    #pragma unroll
    for(int r=0;r<16;++r){const int orow=crow(r,hi);
      #pragma unroll
      for(int d0=0;d0<2;++d0)stg[orow*64+d0*32+r32]=__float2bfloat16(o[2*hf+d0][r]*rli[r]);}
    asm volatile("s_waitcnt lgkmcnt(0)":::"memory");
    #pragma unroll
    for(int i=0;i<4;++i){const int row=i*8+(lane>>3),ch=lane&7; const u32x4 v=*(const u32x4*)(stg+row*64+ch*8); const int rel=q0+wid*QBLK+row; const long m=(rel>=64)?(long)b*2048+(rel-64):16384L+16*b+(rel-FRONT); if(rel>=FRONT&&rel<RVEND&&(q0!=0||rel<64))ATTN_STORE16(Ow+m*DM+hf*64+ch*8,v);}
    asm volatile("s_waitcnt lgkmcnt(0)":::"memory"); } }
  asm volatile("s_waitcnt lgkmcnt(0)\n\ts_barrier":::"memory");
  #undef DMA_K
  #undef DMA_V
  #undef CMASK
  #undef CM1
  #undef START
  #undef RESC
  #undef ROT
}
constexpr int ATTN_LDS_BYTES=LDS_BYTES;
struct AttnTensors { const bf16* Q; const bf16* K; const bf16* V; bf16* O; bf16* O1; };
template<int THRL=8> __device__ __forceinline__ void attn_phase(char*lds,const AttnTensors&T,int vcu,int G){
  for(int w=vcu;w<256;w+=G){ const int item=w>>1,half=w&1,b=item>>4,hc=item&15,h=hc>>1,c=hc&1;
    const int n=half?4:5;
    for(int i=0;i<n;++i){ const int j=half?((i==0)?6:(i==1)?5:(i==2)?3:1):((i==0)?7:(i==1)?4:(i==2)?2:(i==3)?0:-1);
      if(j<0) attn_unit<THRL,false>(b,(2*h+c)*64,h*128,h*128,0,T.Q,T.K,T.V,c?T.O1:T.O,lds);
      else attn_unit<THRL,true>(b,(2*h+c)*64,h*128,h*128,64+256*j,T.Q,T.K,T.V,c?T.O1:T.O,lds); } }
}
#undef SBAR
#undef WAIT_BAR
}
#include <hip/hip_cooperative_groups.h>
namespace cg = cooperative_groups;
constexpr int NWAVES = 8;
constexpr int DM_ = 1024, DFF = 2816, NGU = 2 * DFF, NB = 8, SEQL = 2048, NMETA = 16, DEPTH_ = 4;
constexpr int MREAL = NB * SEQL;
constexpr int MVALID = MREAL + NB * NMETA;
constexpr int MPAD = 16640;
constexpr int QROWS = NB * 2112 + 256;
constexpr size_t MiB = 1u << 20;
constexpr size_t WS_ROPE = 1 * MiB;
constexpr size_t WS_HMETA = 1 * MiB + 512 * 1024;
constexpr size_t WS_W = 2 * MiB;
constexpr size_t W_GU_E = (size_t)NGU * DM_, W_DN_E = (size_t)DM_ * DFF, W_FFN_E = W_GU_E + W_DN_E;
constexpr size_t W_IN_E = (size_t)3 * DM_ * DM_, W_OUT_E = (size_t)DM_ * DM_, W_MIX_E = W_IN_E + W_OUT_E;
constexpr size_t W_TOTAL_E = 8 * W_FFN_E + 4 * W_MIX_E;
constexpr size_t WS_XN = 168 * MiB;
constexpr size_t WS_F = 201 * MiB;
constexpr size_t WS_BIG = 236 * MiB;
constexpr size_t WS_END = 338 * MiB;
static_assert(WS_W + W_TOTAL_E * 2 <= WS_XN && WS_XN + (size_t)MPAD * 1024 * 2 <= WS_F && WS_F + (size_t)MPAD * 1024 * 2 <= WS_BIG, "ws map");
static_assert(WS_XN + (size_t)QROWS * 2048 * 2 <= WS_BIG && WS_BIG + (size_t)MPAD * 3072 * 2 <= WS_END && WS_BIG + (size_t)3 * QROWS * 1024 * 2 <= WS_END, "ws map 2");
constexpr int RING_BYTES = 131072, LDS_BYTES = 147456;

#define GAS __attribute__((address_space(1)))
#define LAS __attribute__((address_space(3)))
typedef unsigned short bf16;
typedef unsigned v4u __attribute__((ext_vector_type(4)));
typedef float f32x4 __attribute__((ext_vector_type(4)));
#define LDS_WAIT() asm volatile("s_waitcnt lgkmcnt(0)" ::: "memory")
__device__ __forceinline__ unsigned f2bf(float f) { unsigned u = __builtin_bit_cast(unsigned, f); return (u + 0x7fffu + ((u >> 16) & 1u)) >> 16; }
__device__ __forceinline__ unsigned pk2(float lo, float hi) { typedef float f32x2p __attribute__((ext_vector_type(2))); typedef __bf16 bf16x2p __attribute__((ext_vector_type(2))); f32x2p v = {lo, hi}; bf16x2p b = __builtin_convertvector(v, bf16x2p); return __builtin_bit_cast(unsigned, b); }
__device__ __forceinline__ float bflo(unsigned w) { return __builtin_bit_cast(float, w << 16); }
__device__ __forceinline__ float bfhi(unsigned w) { return __builtin_bit_cast(float, w & 0xffff0000u); }
__device__ __forceinline__ float wave_sum(float v) {
#define WS_DPP(x, ctrl) __builtin_bit_cast(float, __builtin_amdgcn_update_dpp(0, __builtin_bit_cast(int, (x)), (ctrl), 0xF, 0xF, true))
    v += WS_DPP(v, 0xB1);
    v += WS_DPP(v, 0x4E);
    v += WS_DPP(v, 0x141);
    v += WS_DPP(v, 0x140);
#undef WS_DPP
    const int b_ = __builtin_bit_cast(int, v);
    const float r0 = __builtin_bit_cast(float, __builtin_amdgcn_readlane(b_, 0)), r1 = __builtin_bit_cast(float, __builtin_amdgcn_readlane(b_, 16));
    const float r2 = __builtin_bit_cast(float, __builtin_amdgcn_readlane(b_, 32)), r3 = __builtin_bit_cast(float, __builtin_amdgcn_readlane(b_, 48));
    return (r0 + r1) + (r2 + r3);
}
#define RLX_AGENT __ATOMIC_RELAXED, __HIP_MEMORY_SCOPE_AGENT
#define XB_TMO      128
#define XB_XCNT(j)  (256  + 64 * (j))
#define XB_XSUB(j)  (1280 + 64 * (j))
#define XB_XGEN(j)  (2304 + 64 * (j))
#define XB_TOP      3328
#define XB_TOPGEN   3392
#define XCD_BAR_WORDS 3456
#define XB_SPIN_CAP (1u << 18)

__device__ __forceinline__ unsigned xb_ld(unsigned* p)              { return __hip_atomic_load(p, __ATOMIC_RELAXED, __HIP_MEMORY_SCOPE_AGENT); }
__device__ __forceinline__ unsigned xb_add(unsigned* p, unsigned v) { return __hip_atomic_fetch_add(p, v, __ATOMIC_RELAXED, __HIP_MEMORY_SCOPE_AGENT); }
__device__ __forceinline__ unsigned xb_xcc_id() { return (unsigned)__builtin_amdgcn_s_getreg((3 << 11) | 20) & 0xFu; }
#define XB_SPIN(cond, bar) do { unsigned _sp = 0; while (cond) { __builtin_amdgcn_s_sleep(1); \
    if ((++_sp & 255u) == 0u) { if (xb_ld(&(bar)[XB_TMO])) break; if (_sp > XB_SPIN_CAP) { atomicAdd(&(bar)[XB_TMO], 1u); break; } } } } while (0)

struct XcdBarrier {
    unsigned* bar; unsigned x;
    volatile LAS unsigned* st;
};

__device__ __forceinline__ XcdBarrier xcd_barrier_post(unsigned* bar, volatile LAS unsigned* st) {
    XcdBarrier b; b.bar = bar; b.x = xb_xcc_id(); b.st = st;
    if (threadIdx.x == 0) (void)xb_add(&bar[XB_XCNT(b.x)], 1u);
    return b;
}
__device__ __forceinline__ void xcd_barrier_complete(unsigned* bar, unsigned x, unsigned& nloc, unsigned& nx) {
    const unsigned G = gridDim.x * gridDim.y * gridDim.z;
    unsigned sum, cnt, mine, sp = 0u;
    for (;;) {
        sum = 0u; cnt = 0u; mine = 0u;
#pragma unroll
        for (unsigned j = 0; j < 16; ++j) { const unsigned c = xb_ld(&bar[XB_XCNT(j)]); sum += c; cnt += (c > 0u) ? 1u : 0u; mine = (j == x) ? c : mine; }
        if (sum == G) break;
        __builtin_amdgcn_s_sleep(1);
        if ((++sp & 255u) == 0u) { if (xb_ld(&bar[XB_TMO])) break; if (sp > XB_SPIN_CAP) { atomicAdd(&bar[XB_TMO], 1u); break; } }
    }
    nloc = mine > 0u ? mine : 1u; nx = cnt > 0u ? cnt : 1u;
}

template <bool LOCAL> __device__ __forceinline__ void xcd_barrier(const XcdBarrier& b) {
    asm volatile("s_waitcnt vmcnt(0)" ::: "memory");
    __syncthreads();
    if (threadIdx.x == 0) {
        unsigned* bar = b.bar;
        __builtin_amdgcn_s_waitcnt(0);
        unsigned nloc = b.st[0], nx = b.st[1];
        if (nloc == 0u) { xcd_barrier_complete(bar, b.x, nloc, nx); b.st[0] = nloc; b.st[1] = nx; }
        const unsigned old = xb_add(&bar[XB_XSUB(b.x)], 1u);
        const unsigned gen = old / nloc;
        if (old + 1u == (gen + 1u) * nloc) {
            __builtin_amdgcn_fence(__ATOMIC_RELEASE, "agent");
            asm volatile("s_waitcnt vmcnt(0)" ::: "memory");
            if (!LOCAL) {
            const unsigned og = xb_add(&bar[XB_TOP], 1u);
            const unsigned tg = og / nx;
            if (og + 1u == (tg + 1u) * nx) xb_add(&bar[XB_TOPGEN], 1u);
            else XB_SPIN(xb_ld(&bar[XB_TOPGEN]) == tg, bar);
            }
            __builtin_amdgcn_fence(__ATOMIC_ACQUIRE, "agent");
            xb_add(&bar[XB_XGEN(b.x)], 1u);
            asm volatile("s_waitcnt vmcnt(0)" ::: "memory");
        } else {
            XB_SPIN(xb_ld(&bar[XB_XGEN(b.x)]) == gen, bar);
            __builtin_amdgcn_fence(__ATOMIC_ACQUIRE, "agent");
            asm volatile("s_waitcnt vmcnt(0)" ::: "memory");
        }
    }
    __syncthreads();
}

struct Args { const float* in[16]; float* out; unsigned char* ws; };
__device__ __forceinline__ const float* in_ptr(int i) { const char __attribute__((address_space(4)))* ka = (const char __attribute__((address_space(4)))*)__builtin_amdgcn_kernarg_segment_ptr(); int off = i * 8; asm volatile("" : "+s"(off)); return *(const float* const __attribute__((address_space(4)))*)(ka + off); }
__device__ __forceinline__ float* out_ptr() { return (float*)in_ptr(16); }
__device__ __forceinline__ unsigned char* ws_ptr() { return (unsigned char*)in_ptr(17); }

__device__ __forceinline__ void p0_transpose_item(const float* W, int K, int N, bf16* WT, int k0, int n0, int drow0, LAS float* scr, int lane) {
#pragma unroll 8
    for (int i = 0; i < 32; ++i) { const int kk = 2 * i + (lane >> 5); scr[kk * 33 + (lane & 31)] = __builtin_nontemporal_load(&W[(size_t)(k0 + kk) * N + n0 + (lane & 31)]); }
    LDS_WAIT(); asm volatile("" ::: "memory");
    const int c = lane & 7;
#pragma unroll
    for (int j = 0; j < 4; ++j) { const int n = (lane >> 3) + 8 * j; const LAS float* s = scr + (8 * c) * 33 + n;
        v4u o; o.x = pk2(s[0 * 33], s[1 * 33]); o.y = pk2(s[2 * 33], s[3 * 33]); o.z = pk2(s[4 * 33], s[5 * 33]); o.w = pk2(s[6 * 33], s[7 * 33]);
        *(GAS v4u*)(WT + (size_t)(drow0 + n) * K + k0 + 8 * c) = o; }
    LDS_WAIT(); asm volatile("" ::: "memory");
}
__device__ __forceinline__ float* hrow_ptr(float* out, float* hmeta, int m) { return m < MREAL ? out + (size_t)m * DM_ : hmeta + (size_t)(m - MREAL) * DM_; }
__device__ __forceinline__ int qkv_row(int m) { return m < MREAL ? (m >> 11) * 2112 + 64 + (m & 2047) : ((m - MREAL) >> 4) * 2112 + 48 + ((m - MREAL) & 15); }
__device__ __forceinline__ int prev_row(int m, int k) {
    if (m < MREAL) { const int t = m & 2047, b = m >> 11; return (t >= k) ? m - k : MREAL + b * 16 + (16 + t - k); }
    const int i = (m - MREAL) & 15; return (i >= k) ? m - k : -1;
}


typedef short tg_bf16x8 __attribute__((ext_vector_type(8)));
template <int MODE, int KW  , int TR  , int TC  >
__device__ __forceinline__ void tail_gemm(LAS unsigned char* lds, const bf16* A, const bf16* Bt, int N, bf16* O, int ldc, const float* rope, float scale0, size_t buf_stride, int cu, int ncu) {
    constexpr int K = KW * 8, NS = KW / 32, NCP = 16 * TC, NRW = 16 * TR, NCO = (MODE == 1) ? NCP / 2 : NCP, NRB = 128 / NRW, WSZ = NRW * NCP;
    const int tid = opaque_tid(), lane = tid & 63, wid = __builtin_amdgcn_readfirstlane(tid >> 6), fr = lane & 15, fq = lane >> 4;
    const int ncolt = ((MODE == 1) ? N / 2 : N) / NCO, ntiles = NRB * ncolt;
    LAS float* red = (LAS float*)lds;
    if (cu < 0) return;
    for (int tile = cu; tile < ntiles; tile += ncu) {
        const int rb = tile % NRB, ct = tile / NRB;
        tg_bf16x8 fa[TR][NS], fb[TC][NS];
#pragma unroll
        for (int ci = 0; ci < TC; ++ci) { int brow;
            if (MODE == 1) { const int oc = ct * NCO, base = 256 * (oc >> 7) + (oc & 127); brow = (ci < TC / 2) ? base + 16 * ci : base + 128 + 16 * (ci - TC / 2); } else brow = ct * NCP + 16 * ci;
            const bf16* bp = Bt + (size_t)(brow + fr) * K + wid * KW + 8 * fq;
#pragma unroll
            for (int i = 0; i < NS; ++i) fb[ci][i] = *(const tg_bf16x8*)(bp + i * 32); }
#pragma unroll
        for (int ri = 0; ri < TR; ++ri) { const bf16* ap = A + (size_t)(rb * NRW + ri * 16 + fr) * K + wid * KW + 8 * fq;
#pragma unroll
            for (int i = 0; i < NS; ++i) fa[ri][i] = *(const tg_bf16x8*)(ap + i * 32); }
        f32x4 c[TR][TC];
#pragma unroll
        for (int ri = 0; ri < TR; ++ri)
#pragma unroll
            for (int ci = 0; ci < TC; ++ci) c[ri][ci] = (f32x4){0.f, 0.f, 0.f, 0.f};
#pragma unroll
        for (int i = 0; i < NS; ++i)
#pragma unroll
            for (int ri = 0; ri < TR; ++ri)
#pragma unroll
                for (int ci = 0; ci < TC; ++ci) c[ri][ci] = __builtin_amdgcn_mfma_f32_16x16x32_bf16(fb[ci][i], fa[ri][i], c[ri][ci], 0, 0, 0);
        LAS float* rw = red + wid * WSZ;
#pragma unroll
        for (int ri = 0; ri < TR; ++ri)
#pragma unroll
            for (int ci = 0; ci < TC; ++ci) *(LAS f32x4*)(rw + (ri * 16 + fr) * NCP + ci * 16 + 4 * fq) = c[ri][ci];
        __syncthreads();
#define TG_RED(rr_, cc_) (((red[0 * WSZ + (rr_) * NCP + (cc_)] + red[1 * WSZ + (rr_) * NCP + (cc_)]) + (red[2 * WSZ + (rr_) * NCP + (cc_)] + red[3 * WSZ + (rr_) * NCP + (cc_)])) + ((red[4 * WSZ + (rr_) * NCP + (cc_)] + red[5 * WSZ + (rr_) * NCP + (cc_)]) + (red[6 * WSZ + (rr_) * NCP + (cc_)] + red[7 * WSZ + (rr_) * NCP + (cc_)])))
#pragma unroll
        for (int e = tid; e < NRW * NCO; e += NWAVES * 64) { const int row = e / NCO, cc = e % NCO, r = rb * NRW + row;
            if (MODE == 0) { O[(size_t)(MREAL + r) * ldc + ct * NCO + cc] = (bf16)f2bf(TG_RED(row, cc)); }
            else if (MODE == 1) { const float g = TG_RED(row, cc), u = TG_RED(row, NCO + cc); O[(size_t)(MREAL + r) * ldc + ct * NCO + cc] = (bf16)f2bf(pg8::EpiSwiGLU::silu_mul(g, u)); }
            else { const int gcol = ct * NCO + cc, t = gcol >> 10, d = gcol & 63; float v0 = TG_RED(row, cc);
                const int orow = (r >> 4) * 2112 + 48 + (r & 15), pos = r & 15;
                if (t < 2 && d < 16) { const int pc = cc + ((gcol ^ 8) - gcol); const float o0 = TG_RED(row, pc); const int j = d & 7; const float sgn = (d < 8) ? -1.f : 1.f;
                    v0 = v0 * rope[pos * 16 + j] + sgn * o0 * rope[pos * 16 + 8 + j]; }
                if (t == 0) v0 *= scale0;
                O[(size_t)t * buf_stride + (size_t)orow * 1024 + (gcol & 1023)] = (bf16)f2bf(v0); } }
#undef TG_RED
        __syncthreads();
    }
}

__device__ __forceinline__ int batch_row(int b, int i) { return i < SEQL ? b * SEQL + i : MREAL + b * NMETA + ((i - SEQL) >> 4); }
__global__ void __launch_bounds__(NWAVES * 64, 2) trunk_fwd(Args args) {
    extern __shared__ __attribute__((aligned(16))) unsigned char lds[];
    cg::grid_group grid = cg::this_grid();
    const int tid = threadIdx.x, lane = tid & 63, wave = __builtin_amdgcn_readfirstlane(tid >> 6);
    const int G = gridDim.x; const int bx = blockIdx.x; const int vcu = (G % 8 == 0) ? (bx % 8) * (G / 8) + bx / 8 : bx;
    const int gw = vcu * NWAVES + wave, NGW = G * NWAVES;
    LAS unsigned char* ldsl = (LAS unsigned char*)lds;
#define WSB(off) (ws_ptr() + (off))
#define P_HMETA ((float*)WSB(WS_HMETA))
#define P_ROPE ((float*)WSB(WS_ROPE))
#define P_WB ((bf16*)WSB(WS_W))
#define P_XN ((bf16*)WSB(WS_XN))
#define P_FB ((bf16*)WSB(WS_F))
#define P_BIG ((bf16*)WSB(WS_BIG))
    for (int u = tid; u < (LDS_BYTES - RING_BYTES) / 4; u += NWAVES * 64) ((LAS unsigned*)(ldsl + RING_BYTES))[u] = 0u;
    __syncthreads();
    XcdBarrier xbar = xcd_barrier_post((unsigned*)ws_ptr(), (volatile LAS unsigned*)(ldsl + RING_BYTES + 352));
#define GSYNC() xcd_barrier<false>(xbar)
#define LSYNC() xcd_barrier<true>(xbar)
#define GSYNC_CG() do { asm volatile("s_waitcnt vmcnt(0) lgkmcnt(0)" ::: "memory"); __builtin_amdgcn_fence(__ATOMIC_RELEASE, "agent"); grid.sync(); __builtin_amdgcn_fence(__ATOMIC_ACQUIRE, "agent"); } while (0)

    if (tid == 0) ((unsigned*)(ws_ptr() + 32768))[bx] = xbar.x + 1u;
    {
        LAS float* scr = (LAS float*)(ldsl + wave * 16384); bf16* const Wb0 = P_WB;
        constexpr int I_GU = (DM_ / 64) * (NGU / 32), I_DN = (DFF / 64) * (DM_ / 32), I_FFN = I_GU + I_DN;
        constexpr int I_IN = (DM_ / 64) * (3 * DM_ / 32), I_OUT = (DM_ / 64) * (DM_ / 32), I_MIX = I_IN + I_OUT;
        constexpr int NITEMS = 8 * I_FFN + 4 * I_MIX;
        for (int it = gw; it < NITEMS; it += NGW) {
            if (it < 8 * I_FFN) { const int fi = it / I_FFN, r = it % I_FFN, l = fi >> 1, which = fi & 1; bf16* dst = Wb0 + (size_t)fi * W_FFN_E;
                if (r < I_GU) { const float* W = (which ? in_ptr(14) : in_ptr(3)) + (size_t)l * DM_ * NGU; const int nblk = NGU / 32, kb = r / nblk, nb = r % nblk, n0 = 32 * nb;
                    const int half = n0 / DFF, within = n0 % DFF, drow0 = 256 * (within / 128) + 128 * half + (within % 128);
                    p0_transpose_item(W, DM_, NGU, dst, 64 * kb, n0, drow0, scr, lane); }
                else { const int r2 = r - I_GU; const float* W = (which ? in_ptr(15) : in_ptr(4)) + (size_t)l * DFF * DM_; const int nblk = DM_ / 32, kb = r2 / nblk, nb = r2 % nblk;
                    p0_transpose_item(W, DFF, DM_, dst + W_GU_E, 64 * kb, 32 * nb, 32 * nb, scr, lane); }
            } else { const int it2 = it - 8 * I_FFN, l = it2 / I_MIX, r = it2 % I_MIX, j = l >> 1, isattn = l & 1; bf16* dst = Wb0 + 8 * W_FFN_E + (size_t)l * W_MIX_E;
                if (r < I_IN) { const float* W = (isattn ? in_ptr(9) : in_ptr(6)) + (size_t)j * DM_ * 3 * DM_; const int nblk = 3 * DM_ / 32, kb = r / nblk, nb = r % nblk;
                    p0_transpose_item(W, DM_, 3 * DM_, dst, 64 * kb, 32 * nb, 32 * nb, scr, lane); }
                else { const int r2 = r - I_IN; const float* W = (isattn ? in_ptr(12) : in_ptr(8)) + (size_t)j * DM_ * DM_; const int nblk = DM_ / 32, kb = r2 / nblk, nb = r2 % nblk;
                    p0_transpose_item(W, DM_, DM_, dst + W_IN_E, 64 * kb, 32 * nb, 32 * nb, scr, lane); }
            }
        }
        float* const rope0 = P_ROPE;
        for (int e = gw * 64 + lane; e < 2064 * 8; e += NGW * 64) { const int pos = e >> 3, j = e & 7;
            const float inv = (float)exp2(-(double)j * (18.931568569324174 / 8.0));
            const float ang = (float)pos * inv; const double rev = (double)ang * 0.15915494309189535; const float fr = (float)(rev - floor(rev));
            rope0[pos * 16 + j] = __builtin_amdgcn_cosf(fr); rope0[pos * 16 + 8 + j] = __builtin_amdgcn_sinf(fr); }
        { const v4u z = {0u, 0u, 0u, 0u}; bf16* const xn0 = P_XN; bf16* const big0 = P_BIG;
          for (int e = gw * 64 + lane; e < (MPAD - MVALID) * 128; e += NGW * 64) *(v4u*)(xn0 + (size_t)MVALID * 1024 + (size_t)e * 8) = z;
          for (int e = gw * 64 + lane; e < 3 * (8 * 48 + 256) * 128; e += NGW * 64) { const int bufi = e / ((8 * 48 + 256) * 128), r = (e / 128) % (8 * 48 + 256), c = e % 128;
              const int row = r < 384 ? (r / 48) * 2112 + (r % 48) : 8 * 2112 + (r - 384);
              *(v4u*)(big0 + (size_t)bufi * QROWS * 1024 + (size_t)row * 1024 + c * 8) = z; } }
    }
    { float* const hp_out = out_ptr(); float* const hp_meta = P_HMETA; const float* const xin = in_ptr(0); const float* const min_ = in_ptr(1); const float* const g = in_ptr(2); bf16* const xn0 = P_XN;
    for (int m = gw; m < MVALID; m += NGW) {
        const float* src = m < MREAL ? xin + (size_t)m * DM_ : min_ + (size_t)((m - MREAL) & 15) * DM_;
        float* hr = hrow_ptr(hp_out, hp_meta, m);
        f32x4 v[4]; float s = 0.f;
#pragma unroll
        for (int q = 0; q < 4; ++q) { v[q] = *(const f32x4*)(src + (q >> 1) * 512 + lane * 8 + (q & 1) * 4); s += (v[q][0] * v[q][0] + v[q][1] * v[q][1]) + (v[q][2] * v[q][2] + v[q][3] * v[q][3]); }
        const float r2 = __builtin_amdgcn_rsqf(wave_sum(s) * (1.f / DM_) + 1e-6f);
        if (m >= MREAL) {
#pragma unroll
        for (int q = 0; q < 4; ++q) *(f32x4*)(hr + (q >> 1) * 512 + lane * 8 + (q & 1) * 4) = v[q]; }
#pragma unroll
        for (int hh = 0; hh < 2; ++hh) { const f32x4 g0 = *(const f32x4*)(g + hh * 512 + lane * 8), g1 = *(const f32x4*)(g + hh * 512 + lane * 8 + 4); const f32x4 a = v[2 * hh] * r2 * g0, b = v[2 * hh + 1] * r2 * g1;
            v4u o; o.x = pk2(a[0], a[1]); o.y = pk2(a[2], a[3]); o.z = pk2(b[0], b[1]); o.w = pk2(b[2], b[3]); *(v4u*)(xn0 + (size_t)m * 1024 + hh * 512 + lane * 8) = o; }
    } }
    GSYNC();
    if (G == 0x7fffff) GSYNC_CG();
    int fastsync;
    { int ok = 1; const unsigned* xt = (const unsigned*)(ws_ptr() + 32768);
      if (G != 256) ok = 0; else if (tid < 256) ok = (xt[tid] != 0u) && (xt[tid] == xt[tid & 7]);
      fastsync = __syncthreads_and(ok); }

    enum { K_GU = 0, K_PLAIN = 1, K_NORM = 2, K_CONV = 3, K_QKV = 4, K_ATTN = 5, K_COMB = 6 };
    for (int l = 0; l < DEPTH_; ++l) {
        const int nsteps = (l & 1) ? 11 : 10;
        for (int s = 0; s < nsteps; ++s) {
            int lq = l; asm volatile("" : "+s"(lq));
            const int isattn = lq & 1, jm = lq >> 1;
            const bf16* Wmix = P_WB + 8 * W_FFN_E + (size_t)lq * W_MIX_E;
            int kind; const bf16* gA = P_XN; const bf16* gB = P_WB; int gN = 1024, gK = 1024; bf16* gO = P_FB;
            float coef = 0.5f; const float* gpost = in_ptr(2); const float* gnext = in_ptr(2); int wnext = 1;
            int ffn_i = 0;
            const int sm = (isattn && s >= 5) ? s - 1 : s;
            if (s == 0 || sm == 7) { kind = K_GU; ffn_i = (s == 0) ? 0 : 1; }
            else if (s == 1 || sm == 8) { kind = K_PLAIN; ffn_i = (s == 1) ? 0 : 1; gA = P_BIG; gB = P_WB + (size_t)(2 * lq + ffn_i) * W_FFN_E + W_GU_E; gN = 1024; gK = DFF; gO = P_FB; }
            else if (s == 2) { kind = K_NORM; coef = 0.5f; gpost = in_ptr(2) + (size_t)(lq * 2 + 1) * DM_; gnext = in_ptr(5) + (size_t)(lq * 2) * DM_; }
            else if (s == 3) { if (isattn) kind = K_QKV; else { kind = K_PLAIN; gA = P_XN; gB = Wmix; gN = 3 * DM_; gK = DM_; gO = P_BIG; } }
            else if (s == 4) { kind = isattn ? K_ATTN : K_CONV; }
            else if (isattn && s == 5) { kind = K_COMB; }
            else if (sm == 5) { kind = K_PLAIN; gA = P_XN; gB = Wmix + W_IN_E; gN = 1024; gK = 1024; gO = P_FB; }
            else if (sm == 6) { kind = K_NORM; coef = 1.0f; gpost = in_ptr(5) + (size_t)(lq * 2 + 1) * DM_; gnext = in_ptr(13) + (size_t)(lq * 2) * DM_; }
            else { kind = K_NORM; coef = 0.5f; gpost = in_ptr(13) + (size_t)(lq * 2 + 1) * DM_; wnext = (lq < DEPTH_ - 1); gnext = in_ptr(2) + (size_t)((lq < DEPTH_ - 1 ? lq + 1 : lq) * 2) * DM_; }

            const bool meta_live = !(lq == DEPTH_ - 1 && s >= 5);
            const int lane = opaque_tid() & 63;
            const bool ral = (G == 256); const int ri0 = ral ? (gw & 255) : gw, rin = ral ? ((meta_live && (gw & 15) == 0) ? SEQL + 256 : SEQL) : (meta_live ? MVALID : MREAL),        ris = ral ? 256 : NGW, rbt = gw >> 8;
#define ROWMAP(i_) (ral ? batch_row(rbt, (i_)) : (i_))
            if (kind == K_GU) {
                pg8::Gemm g{P_XN, P_WB + (size_t)(2 * lq + ffn_i) * W_FFN_E, MREAL, NGU, DM_}; pg8::StaticOrder S; S.init(MREAL, NGU, G, bx);
                pg8::EpiSwiGLU E{P_BIG, DFF};
                pg8::gemm_phase<pg8::EpiSwiGLU, pg8::StaticOrder, true, true>(ldsl, g, S, E);
                { const int lo = (G == 256) ? 128 : 0;
                  tail_gemm<1, 128, 1, 8>(ldsl, P_XN + (size_t)MREAL * DM_, P_WB + (size_t)(2 * lq + ffn_i) * W_FFN_E, NGU, P_BIG, DFF, nullptr, 1.f, 0, meta_live ? bx - lo : -1, G - lo); }
            } else if (kind == K_PLAIN) {
                pg8::Gemm g{gA, gB, MREAL, gN, gK}; pg8::StaticOrder S; S.init(MREAL, gN, G, bx);
                pg8::EpiBf16<0> E{gO, gN, nullptr, 0, 0, 1.f};
                pg8::gemm_phase<pg8::EpiBf16<0>, pg8::StaticOrder, true, true>(ldsl, g, S, E);
                if (gK == DM_) { if (gN == DM_) tail_gemm<0, 128, 1, 2>(ldsl, gA + (size_t)MREAL * DM_, gB, gN, gO, gN, nullptr, 1.f, 0, meta_live ? bx : -1, G); else tail_gemm<0, 128, 1, 6>(ldsl, gA + (size_t)MREAL * DM_, gB, gN, gO, gN, nullptr, 1.f, 0, bx, G); }
                else tail_gemm<0, 352, 1, 2>(ldsl, gA + (size_t)MREAL * DFF, gB, gN, gO, gN, nullptr, 1.f, 0, meta_live ? bx : -1, G);
            } else if (kind == K_QKV) {
                pg8::Gemm g{P_XN, Wmix, MREAL, 3 * DM_, DM_}; pg8::StaticOrder S; S.init(MREAL, 3 * DM_, G, bx);
                pg8::EpiQKV E{P_BIG, (size_t)QROWS * 1024, P_ROPE, attn_body::C2};
                pg8::gemm_phase<pg8::EpiQKV, pg8::StaticOrder, true, true>(ldsl, g, S, E);
                tail_gemm<2, 128, 1, 6>(ldsl, P_XN + (size_t)MREAL * DM_, Wmix, 3 * DM_, P_BIG, 1024, P_ROPE, attn_body::C2, (size_t)QROWS * 1024, bx, G);
            } else if (kind == K_NORM) {
                float* const hp_out = out_ptr(); float* const hp_meta = P_HMETA; const bf16* const fb0 = P_FB; bf16* const xn0 = P_XN;
                f32x4 nv[4]; v4u nw[2];
#define NORM_LOAD(mm) do { const float* hq_ = hrow_ptr(hsrc0, hp_meta, (mm)); const bf16* fq_ = fb0 + (size_t)(mm) * 1024; \
                    nw[0] = __builtin_nontemporal_load((const v4u*)(fq_ + lane * 8)); nw[1] = __builtin_nontemporal_load((const v4u*)(fq_ + 512 + lane * 8)); \
                    _Pragma("unroll") for (int q = 0; q < 4; ++q) nv[q] = *(const f32x4*)(hq_ + (q >> 1) * 512 + lane * 8 + (q & 1) * 4); } while (0)
                float* const hsrc0 = (lq == 0 && s == 2) ? (float*)in_ptr(0) : hp_out;
                f32x4 gpv[4], gnv[4];
#pragma unroll
                for (int q = 0; q < 4; ++q) { gpv[q] = *(const f32x4*)(gpost + (q >> 1) * 512 + lane * 8 + (q & 1) * 4); gnv[q] = *(const f32x4*)(gnext + (q >> 1) * 512 + lane * 8 + (q & 1) * 4); }
                NORM_LOAD(ROWMAP(ri0 < rin ? ri0 : 0));
                for (int ri = ri0; ri < rin; ri += ris) { const int m = ROWMAP(ri);
                    float* hr = hrow_ptr(hp_out, hp_meta, m);
                    f32x4 v[4]; float fv[16]; float s1 = 0.f;
#pragma unroll
                    for (int hh = 0; hh < 2; ++hh) { const v4u w = nw[hh];
                        fv[hh * 8 + 0] = bflo(w.x); fv[hh * 8 + 1] = bfhi(w.x); fv[hh * 8 + 2] = bflo(w.y); fv[hh * 8 + 3] = bfhi(w.y); fv[hh * 8 + 4] = bflo(w.z); fv[hh * 8 + 5] = bfhi(w.z); fv[hh * 8 + 6] = bflo(w.w); fv[hh * 8 + 7] = bfhi(w.w); }
#pragma unroll
                    for (int q = 0; q < 4; ++q) v[q] = nv[q];
                    if (ri + ris < rin) NORM_LOAD(ROWMAP(ri + ris));
#pragma unroll
                    for (int e = 0; e < 16; ++e) s1 += fv[e] * fv[e];
                    const float r1 = coef * __builtin_amdgcn_rsqf(wave_sum(s1) * (1.f / DM_) + 1e-6f); float s2 = 0.f;
#pragma unroll
                    for (int q = 0; q < 4; ++q) { const f32x4 gp = gpv[q];
#pragma unroll
                        for (int i = 0; i < 4; ++i) { v[q][i] += fv[q * 4 + i] * r1 * gp[i]; s2 += v[q][i] * v[q][i]; } }
                    const float r2 = __builtin_amdgcn_rsqf(wave_sum(s2) * (1.f / DM_) + 1e-6f);
#pragma unroll
                    for (int q = 0; q < 4; ++q) *(f32x4*)(hr + (q >> 1) * 512 + lane * 8 + (q & 1) * 4) = v[q];
                    if (wnext) {
#pragma unroll
                        for (int hh = 0; hh < 2; ++hh) { const f32x4 g0 = gnv[2 * hh], g1 = gnv[2 * hh + 1]; const f32x4 a = v[2 * hh] * r2 * g0, b = v[2 * hh + 1] * r2 * g1;
                            v4u o; o.x = pk2(a[0], a[1]); o.y = pk2(a[2], a[3]); o.z = pk2(b[0], b[1]); o.w = pk2(b[2], b[3]); *(v4u*)(xn0 + (size_t)m * 1024 + hh * 512 + lane * 8) = o; }
                    }
                }
#undef NORM_LOAD
            } else if (kind == K_CONV) {
                const float* cw = in_ptr(7) + (size_t)jm * 3 * DM_; const bf16* const big0 = P_BIG; bf16* const xn0 = P_XN;
                for (int ri = ri0; ri < rin; ri += ris) { const int m = ROWMAP(ri);
                    const int m1 = prev_row(m, 1), m2 = prev_row(m, 2);
#pragma unroll
                    for (int hh = 0; hh < 2; ++hh) { const int d0 = hh * 512 + lane * 8; float acc8[8];
#pragma unroll
                        for (int k = 0; k < 3; ++k) { const int mr = (k == 2) ? m : (k == 1 ? m1 : m2); v4u cc = {0u, 0u, 0u, 0u}, xx = cc;
                            if (mr >= 0) { cc = *(const v4u*)(big0 + (size_t)mr * 3072 + 1024 + d0); xx = *(const v4u*)(big0 + (size_t)mr * 3072 + 2048 + d0); }
                            const f32x4 w0 = *(const f32x4*)(cw + k * DM_ + d0), w1 = *(const f32x4*)(cw + k * DM_ + d0 + 4);
                            const float u0 = bflo(cc.x) * bflo(xx.x), u1 = bfhi(cc.x) * bfhi(xx.x), u2 = bflo(cc.y) * bflo(xx.y), u3 = bfhi(cc.y) * bfhi(xx.y);
                            const float u4 = bflo(cc.z) * bflo(xx.z), u5 = bfhi(cc.z) * bfhi(xx.z), u6 = bflo(cc.w) * bflo(xx.w), u7 = bfhi(cc.w) * bfhi(xx.w);
                            if (k == 0) { acc8[0] = w0[0] * u0; acc8[1] = w0[1] * u1; acc8[2] = w0[2] * u2; acc8[3] = w0[3] * u3; acc8[4] = w1[0] * u4; acc8[5] = w1[1] * u5; acc8[6] = w1[2] * u6; acc8[7] = w1[3] * u7; }
                            else { acc8[0] += w0[0] * u0; acc8[1] += w0[1] * u1; acc8[2] += w0[2] * u2; acc8[3] += w0[3] * u3; acc8[4] += w1[0] * u4; acc8[5] += w1[1] * u5; acc8[6] += w1[2] * u6; acc8[7] += w1[3] * u7; } }
                        const v4u bb = __builtin_nontemporal_load((const v4u*)(big0 + (size_t)m * 3072 + d0));
                        v4u o; o.x = pk2(bflo(bb.x) * acc8[0], bfhi(bb.x) * acc8[1]); o.y = pk2(bflo(bb.y) * acc8[2], bfhi(bb.y) * acc8[3]); o.z = pk2(bflo(bb.z) * acc8[4], bfhi(bb.z) * acc8[5]); o.w = pk2(bflo(bb.w) * acc8[6], bfhi(bb.w) * acc8[7]);
                        *(v4u*)(xn0 + (size_t)m * 1024 + d0) = o; }
                }
            } else if (kind == K_ATTN) {
                bf16* const big0 = P_BIG; const attn_body::AttnTensors AT{(const attn_body::bf16*)big0, (const attn_body::bf16*)(big0 + (size_t)QROWS * 1024), (const attn_body::bf16*)(big0 + (size_t)2 * QROWS * 1024), (attn_body::bf16*)P_XN, (attn_body::bf16*)P_FB};
                attn_body::attn_phase<8>((char*)lds, AT, vcu, G);
            } else {
                const float linit = 0.8f - 0.6f * expf(-0.3f * (float)lq);
                const float* lp = in_ptr(10) + (size_t)jm * 4 * 64;
                const float lam = expf(wave_sum(lp[lane] * lp[64 + lane])) - expf(wave_sum(lp[128 + lane] * lp[192 + lane])) + linit;
                const float* sg = in_ptr(11) + (size_t)jm * 128; const int hd = lane >> 3, dv0 = (lane & 7) * 16;
                float gs[16];
#pragma unroll
                for (int q = 0; q < 4; ++q) { const f32x4 t4 = *(const f32x4*)(sg + dv0 + q * 4); gs[q * 4 + 0] = t4[0] * (1.f - linit); gs[q * 4 + 1] = t4[1] * (1.f - linit); gs[q * 4 + 2] = t4[2] * (1.f - linit); gs[q * 4 + 3] = t4[3] * (1.f - linit); }
                bf16* const ob0 = P_XN; const bf16* const ob1 = P_FB;
                for (int ri = ri0; ri < rin; ri += ris) { const int m = ROWMAP(ri);
                    bf16* orow = ob0 + (size_t)m * 1024 + hd * 128 + dv0; const bf16* orow1 = ob1 + (size_t)m * 1024 + hd * 128 + dv0;
                    const v4u a0 = *(const v4u*)(orow), a1 = *(const v4u*)(orow + 8), b0 = __builtin_nontemporal_load((const v4u*)(orow1)), b1 = __builtin_nontemporal_load((const v4u*)(orow1 + 8));
                    float d[16];
                    d[0] = bflo(a0.x) - lam * bflo(b0.x); d[1] = bfhi(a0.x) - lam * bfhi(b0.x); d[2] = bflo(a0.y) - lam * bflo(b0.y); d[3] = bfhi(a0.y) - lam * bfhi(b0.y);
                    d[4] = bflo(a0.z) - lam * bflo(b0.z); d[5] = bfhi(a0.z) - lam * bfhi(b0.z); d[6] = bflo(a0.w) - lam * bflo(b0.w); d[7] = bfhi(a0.w) - lam * bfhi(b0.w);
                    d[8] = bflo(a1.x) - lam * bflo(b1.x); d[9] = bfhi(a1.x) - lam * bfhi(b1.x); d[10] = bflo(a1.y) - lam * bflo(b1.y); d[11] = bfhi(a1.y) - lam * bfhi(b1.y);
                    d[12] = bflo(a1.z) - lam * bflo(b1.z); d[13] = bfhi(a1.z) - lam * bfhi(b1.z); d[14] = bflo(a1.w) - lam * bflo(b1.w); d[15] = bfhi(a1.w) - lam * bfhi(b1.w);
                    float ss = 0.f;
#pragma unroll
                    for (int e = 0; e < 16; ++e) ss += d[e] * d[e];
                    ss += __builtin_bit_cast(float, __builtin_amdgcn_update_dpp(0, __builtin_bit_cast(int, ss), 0xB1, 0xF, 0xF, true)); ss += __builtin_bit_cast(float, __builtin_amdgcn_update_dpp(0, __builtin_bit_cast(int, ss), 0x4E, 0xF, 0xF, true)); ss += __builtin_bit_cast(float, __builtin_amdgcn_update_dpp(0, __builtin_bit_cast(int, ss), 0x141, 0xF, 0xF, true));
                    const float rr = __builtin_amdgcn_rsqf(ss * (1.f / 128.f) + 1e-5f);
                    v4u o0, o1;
                    o0.x = pk2(d[0] * rr * gs[0], d[1] * rr * gs[1]); o0.y = pk2(d[2] * rr * gs[2], d[3] * rr * gs[3]); o0.z = pk2(d[4] * rr * gs[4], d[5] * rr * gs[5]); o0.w = pk2(d[6] * rr * gs[6], d[7] * rr * gs[7]);
                    o1.x = pk2(d[8] * rr * gs[8], d[9] * rr * gs[9]); o1.y = pk2(d[10] * rr * gs[10], d[11] * rr * gs[11]); o1.z = pk2(d[12] * rr * gs[12], d[13] * rr * gs[13]); o1.w = pk2(d[14] * rr * gs[14], d[15] * rr * gs[15]);
                    *(v4u*)orow = o0; *(v4u*)(orow + 8) = o1;
                }
            }
#undef ROWMAP
            {
              const int arrive_s = (s == 1) ? 0 : (s == 4) ? 1 : -1;
              const int wait_s = isattn ? ((s == 2) ? 0 : (s == 7) ? 1 : -1) : ((s == 2) ? 0 : (s == 6) ? 1 : -1);
              const bool full = false;
              unsigned* const splitc = (unsigned*)(ws_ptr() + 40960) + 64 * (2 * lq + (arrive_s >= 0 ? arrive_s : (wait_s >= 0 ? wait_s : 0)));
              if (lq == DEPTH_ - 1 && s == nsteps - 1) {   }
              else if (!fastsync || full) GSYNC();
              else { LSYNC();
                     if (arrive_s >= 0) { if (opaque_tid() == 0) __hip_atomic_fetch_add(splitc, 1u, __ATOMIC_RELAXED, __HIP_MEMORY_SCOPE_AGENT); }
                     if (wait_s >= 0) { if (opaque_tid() == 0) { unsigned sp_ = 0; while (__hip_atomic_load(splitc, __ATOMIC_RELAXED, __HIP_MEMORY_SCOPE_AGENT) < (unsigned)G && ++sp_ < (1u << 22)) __builtin_amdgcn_s_sleep(1); }
                                        __syncthreads(); } } }
        }
    }
}

extern "C" void kernel_launch(void* const* d_in, const int* in_sizes, int n_in, void* d_out, int out_size, void* d_ws, size_t ws_size, hipStream_t stream) {
    static int grid = 0;
    if (grid == 0) {
        if (n_in != 16 || out_size != MREAL * DM_ || ws_size < WS_END) { fprintf(stderr, "kernel_launch: unexpected shapes: n_in %d out %d ws %zu (need %zu)\n", n_in, out_size, ws_size, (size_t)WS_END); grid = -1; return; }
        int dev = 0, cus = 0, per_cu = 0;
        if (hipGetDevice(&dev) != hipSuccess || hipDeviceGetAttribute(&cus, hipDeviceAttributeMultiprocessorCount, dev) != hipSuccess) { grid = -1; return; }
        if (hipFuncSetAttribute((const void*)trunk_fwd, hipFuncAttributeMaxDynamicSharedMemorySize, LDS_BYTES) != hipSuccess) { fprintf(stderr, "kernel_launch: hipFuncSetAttribute failed\n"); grid = -1; return; }
        if (hipOccupancyMaxActiveBlocksPerMultiprocessor(&per_cu, (const void*)trunk_fwd, NWAVES * 64, LDS_BYTES) != hipSuccess || per_cu < 1) { fprintf(stderr, "kernel_launch: occupancy query says %d\n", per_cu); per_cu = 1; }
        (void)hipGetLastError();
        grid = cus * per_cu;
    }
    if (grid < 0) return;
    if (hipMemsetAsync(d_ws, 0, 65536, stream) != hipSuccess) { fprintf(stderr, "kernel_launch: memset failed\n"); return; }
    Args a{};
    for (int i = 0; i < 16; ++i) a.in[i] = (const float*)d_in[i];
    a.out = (float*)d_out; a.ws = (unsigned char*)d_ws;
    void* kargs[] = {&a};
    hipError_t e = hipLaunchCooperativeKernel((const void*)trunk_fwd, dim3(grid), dim3(NWAVES * 64), kargs, LDS_BYTES, stream);
    if (e != hipSuccess) fprintf(stderr, "kernel_launch: cooperative launch failed: %s (grid %d)\n", hipGetErrorString(e), grid);
}
```

```cpp
#include <hip/hip_runtime.h>
#include <cstdio>
#include <cstdint>
__device__ __forceinline__ int opaque_tid() { int t = threadIdx.x; asm volatile("" : "+v"(t)); return t; }
namespace pg8 {
#define PG8_LAS __attribute__((address_space(3)))
typedef unsigned short bf16_t;
typedef short bf16x8 __attribute__((ext_vector_type(8)));
typedef float f32x4 __attribute__((ext_vector_type(4)));
typedef unsigned u32x4 __attribute__((ext_vector_type(4)));
constexpr int BM = 256, BK = 64, HALF = 128, HTB = HALF * BK * 2  , STAGE_BYTES = 8 * HTB, NXCD = 8, WGM = 4;

__host__ __device__ __forceinline__ int lds_byte(int r, int c) { const int st = (r >> 4) * 2 + (c >> 5), rr = r & 15, cc = c & 31, ob = rr * 64 + cc * 2; return st * 1024 + (ob ^ (((ob >> 9) & 1) << 5)); }
__host__ __device__ __forceinline__ void stage_rc(int b, int& R, int& C) { const int st = b / 1024, sb = b % 1024, swz = sb ^ (((sb >> 9) & 1) << 5); R = (st >> 1) * 16 + swz / 64; C = (st & 1) * 32 + (swz % 64) / 2; }
__host__ __device__ __forceinline__ int perm32(int rho) { const int n = rho >> 4, i = rho & 15; return 8 * (i >> 2) + 4 * n + (i & 3); }

struct Unit { int pm, pn; };
struct Gemm { const bf16_t* A; const bf16_t* Bt; int M, N, K; };

struct StaticOrder {
    int nM, nN, nwg, G, c;
    __host__ __device__ void init(int M, int N, int G_, int c_) { nM = M / BM; nN = N / BM; nwg = nM * nN; G = G_; c = c_; }
    __host__ __device__ bool next(int i, Unit& u) const {
        const long L = (long)i * G + c; if (L >= nwg) return false;
        int wgid = (int)L; { const int q = nwg / NXCD, r = nwg % NXCD, xcd = wgid % NXCD, off = wgid / NXCD; wgid = (xcd < r ? xcd * (q + 1) : r * (q + 1) + (xcd - r) * q) + off; }
        const int nig = WGM * nN, gid = wgid / nig, fm = gid * WGM, gsz = (nM - fm) < WGM ? (nM - fm) : WGM;
        u.pm = fm + ((wgid % nig) % gsz); u.pn = (wgid % nig) / gsz; return true;
    }
    __device__ __forceinline__ void a_ready(const Unit&) const {}
    __device__ __forceinline__ void done(const Unit&) const {}
};

__device__ __forceinline__ unsigned cvt_pk_bf16(float lo, float hi) { unsigned r; asm volatile("v_cvt_pk_bf16_f32 %0, %1, %2" : "=v"(r) : "v"(lo), "v"(hi)); return r; }
typedef float f32x2 __attribute__((ext_vector_type(2)));
__device__ __forceinline__ f32x2 gelu_pk(f32x2 v) {
    const f32x2 av = __builtin_elementwise_abs(v), d = av * 0.2316418882f + 1.0f;
    f32x2 t; t.x = __builtin_amdgcn_rcpf(d.x); t.y = __builtin_amdgcn_rcpf(d.y);
    f32x2 q = t * 0.5307027145f + (-0.7265760135f); q = q * t + 0.7107068705f; q = q * t + (-0.142248368f); q = q * t + 0.127414796f; q = q * t;
    const f32x2 s = (v * v) * (-0.72134752044f);
    f32x2 e; e.x = __builtin_amdgcn_exp2f(s.x); e.y = __builtin_amdgcn_exp2f(s.y);
    const f32x2 m = v * (q * e), r = v - m;
    f32x2 o; o.x = v.x < 0.f ? m.x : r.x; o.y = v.y < 0.f ? m.y : r.y; return o;
}

template <int ACT  > struct EpiBf16 {
    static constexpr bool PERM = true, AFTER_DRAIN = false; static_assert(ACT == 0 || ACT == 1, "EpiBf16: ACT is 0 (none) or 1 (gelu_pk)");
    bf16_t* O; int ldc; const float* bias; int split_cols; size_t split_stride; float scale0;
    __device__ __forceinline__ void operator()(const f32x4 (&acc)[2][2][4][2], const Unit& u, int wr, int wc, int fr, int fq) const {
        const int row0 = u.pm * BM + wr * 64 + fr; int colt = u.pn * BM; bf16_t* base = O;
        float sc = 1.f; if (split_cols) { const int t = colt / split_cols; base += (size_t)t * split_stride; colt -= t * split_cols; if (t == 0) sc = scale0; }
        const int col0 = colt + wc * 32 + 8 * fq, bcol0 = u.pn * BM + wc * 32 + 8 * fq;
        f32x4 bv[2][2];
#pragma unroll
        for (int bj = 0; bj < 2; ++bj)
#pragma unroll
            for (int n = 0; n < 2; ++n) bv[bj][n] = bias ? *(const f32x4*)(bias + bcol0 + bj * HALF + 4 * n) : (f32x4){0.f, 0.f, 0.f, 0.f};
#pragma unroll
        for (int ai = 0; ai < 2; ++ai)
#pragma unroll
            for (int m = 0; m < 4; ++m) { bf16_t* rowp = base + (size_t)(row0 + ai * HALF + m * 16) * ldc + col0;
#pragma unroll
                for (int bj = 0; bj < 2; ++bj) { f32x4 v0 = acc[ai][bj][m][0] + bv[bj][0], v1 = acc[ai][bj][m][1] + bv[bj][1];
                    if (ACT == 1) { f32x2 a = gelu_pk((f32x2){v0[0], v0[1]}), b = gelu_pk((f32x2){v0[2], v0[3]}), c = gelu_pk((f32x2){v1[0], v1[1]}), d = gelu_pk((f32x2){v1[2], v1[3]});
                        v0 = (f32x4){a.x, a.y, b.x, b.y}; v1 = (f32x4){c.x, c.y, d.x, d.y}; }
                    v0 = v0 * sc; v1 = v1 * sc; u32x4 w; w.x = cvt_pk_bf16(v0[0], v0[1]); w.y = cvt_pk_bf16(v0[2], v0[3]); w.z = cvt_pk_bf16(v1[0], v1[1]); w.w = cvt_pk_bf16(v1[2], v1[3]);
                    *(u32x4*)(rowp + bj * HALF) = w; } }
    }
};

struct PanelStats {
    unsigned* xbuf;
    unsigned* cnt;
    unsigned* tmo;
    int ntn; float eps;
    unsigned code;
    __device__ __forceinline__ bool run(const f32x4 (&v)[2][2][4][2], const Unit& u, int wr, int wc, int fr, int fq, PG8_LAS unsigned char* lds, int wid, int lane) const {
        typedef float f32x2v __attribute__((ext_vector_type(2)));
        PG8_LAS f32x2v* P = (PG8_LAS f32x2v*)lds;
        PG8_LAS f32x2v* S = (PG8_LAS f32x2v*)(lds + 8192);
        PG8_LAS unsigned* flag = (PG8_LAS unsigned*)(lds + 8192 + 2048);
#pragma unroll
        for (int ai = 0; ai < 2; ++ai)
#pragma unroll
            for (int m = 0; m < 4; ++m) {
                float s = 0.f;
#pragma unroll
                for (int bj = 0; bj < 2; ++bj)
#pragma unroll
                    for (int n = 0; n < 2; ++n) { const f32x4 x = v[ai][bj][m][n]; s += (x[0] + x[1]) + (x[2] + x[3]); }
                s += __shfl_xor(s, 16); s += __shfl_xor(s, 32);
                const float mw = s * (1.0f / 64.0f); float q = 0.f;
#pragma unroll
                for (int bj = 0; bj < 2; ++bj)
#pragma unroll
                    for (int n = 0; n < 2; ++n) { const f32x4 d = v[ai][bj][m][n] - mw; q += (d[0] * d[0] + d[1] * d[1]) + (d[2] * d[2] + d[3] * d[3]); }
                q += __shfl_xor(q, 16); q += __shfl_xor(q, 32);
                if (fq == 0) P[(ai * HALF + wr * 64 + m * 16 + fr) * 4 + wc] = (f32x2v){mw, q};
            }
        asm volatile("s_waitcnt lgkmcnt(0)" ::: "memory"); __builtin_amdgcn_s_barrier(); asm volatile("" ::: "memory");
#if defined(BROKEN_EXCHANGE_NO_WAIT)
#warning BROKEN CONTROL BUILD: the row-statistics exchange does not wait; results are wrong by design
        if (blockIdx.x >= 64) { const long long t0_ = clock64(); while (clock64() - t0_ < 60000) __builtin_amdgcn_s_sleep(8); }
#endif
        const int row = wid * 32 + (lane & 31);
        if (lane < 32) {
            const f32x2v a = P[row * 4 + 0], b = P[row * 4 + 1], c = P[row * 4 + 2], d = P[row * 4 + 3];
            const float mt = (a.x + b.x + c.x + d.x) * 0.25f;
            const float da = a.x - mt, db = b.x - mt, dc = c.x - mt, dd = d.x - mt;
            const float m2 = (a.y + b.y) + (c.y + d.y) + 64.0f * ((da * da + db * db) + (dc * dc + dd * dd));
            unsigned long long* slot = (unsigned long long*)xbuf + ((size_t)(u.pm * BM + row) * 4 + u.pn);
            __hip_atomic_store(slot, ((unsigned long long)__float_as_uint(m2) << 32) | __float_as_uint(mt), __ATOMIC_RELAXED, __HIP_MEMORY_SCOPE_AGENT);
        }
        asm volatile("s_waitcnt vmcnt(0)" ::: "memory");
        if (lane == 0) __hip_atomic_fetch_add(cnt + 64 * u.pm, 1u, __ATOMIC_RELAXED, __HIP_MEMORY_SCOPE_AGENT);
        if (wid == 0) {
            bool dead = false; const unsigned long long t0 = __builtin_amdgcn_s_memrealtime(); const unsigned want = 8u * (unsigned)ntn;
            for (;;) {
#if defined(BROKEN_EXCHANGE_NO_WAIT)
                break;
#endif
                if ((unsigned)__builtin_amdgcn_readfirstlane(__hip_atomic_load(cnt + 64 * u.pm, __ATOMIC_RELAXED, __HIP_MEMORY_SCOPE_AGENT)) >= want) break;
                if (__builtin_amdgcn_s_memrealtime() - t0 > 2000000ull) {
                    if (lane == 0) { unsigned expect = 0u; __hip_atomic_compare_exchange_strong(tmo + 1, &expect, code | (unsigned)(u.pm & 0xff), __ATOMIC_RELAXED, __ATOMIC_RELAXED, __HIP_MEMORY_SCOPE_AGENT);
                                     __hip_atomic_store(tmo, 1u, __ATOMIC_RELAXED, __HIP_MEMORY_SCOPE_AGENT); }
                    dead = true; break; }
                __builtin_amdgcn_s_sleep(2);
            }
            __builtin_amdgcn_fence(__ATOMIC_ACQUIRE, "agent");
            if (lane == 0) flag[0] = dead ? 1u : 0u;
        }
        asm volatile("s_waitcnt vmcnt(0) lgkmcnt(0)" ::: "memory"); __builtin_amdgcn_s_barrier(); asm volatile("" ::: "memory");
        const bool bad = flag[0] != 0u;
        if (lane < 32) {
            const unsigned long long* slot = (const unsigned long long*)xbuf + (size_t)(u.pm * BM + row) * 4; float mt[4], m2[4]; float ms = 0.f;
#pragma unroll
            for (int t = 0; t < 4; ++t) { if (t < ntn) { const unsigned long long w = __hip_atomic_load(slot + t, __ATOMIC_RELAXED, __HIP_MEMORY_SCOPE_AGENT); mt[t] = __uint_as_float((unsigned)w); m2[t] = __uint_as_float((unsigned)(w >> 32)); } else { mt[t] = 0.f; m2[t] = 0.f; } ms += mt[t]; }
            const float mean = ms / (float)ntn; float q = 0.f;
#pragma unroll
            for (int t = 0; t < 4; ++t) if (t < ntn) { const float dm = mt[t] - mean; q += m2[t] + 256.0f * dm * dm; }
            S[row] = (f32x2v){mean, 1.0f / sqrtf(q / (256.0f * (float)ntn) + eps)};
        }
        asm volatile("s_waitcnt lgkmcnt(0)" ::: "memory"); __builtin_amdgcn_s_barrier(); asm volatile("" ::: "memory");
        return bad;
    }
};
struct EpiLnRes {
    static constexpr bool PERM = false, AFTER_DRAIN = true;
    const float* base; float* out; int ldc; const float* bias; PanelStats st; unsigned poison;
    __device__ __forceinline__ void fused(f32x4 (&acc)[2][2][4][2], const Unit& u, int wr, int wc, int fr, int fq, PG8_LAS unsigned char* lds, int wid, int lane) const {
        typedef float f32x2v __attribute__((ext_vector_type(2)));
        const PG8_LAS f32x2v* S = (const PG8_LAS f32x2v*)(lds + 8192);
        const int col0 = u.pn * BM + wc * 32 + 4 * fq;
#pragma unroll
        for (int bj = 0; bj < 2; ++bj)
#pragma unroll
            for (int n = 0; n < 2; ++n) { const f32x4 bv = bias ? *(const f32x4*)(bias + col0 + bj * HALF + n * 16) : (f32x4){0.f, 0.f, 0.f, 0.f};
#pragma unroll
                for (int ai = 0; ai < 2; ++ai)
#pragma unroll
                    for (int m = 0; m < 4; ++m) acc[ai][bj][m][n] += bv; }
        f32x4 pre[4][2][2];
#pragma unroll
        for (int m = 0; m < 4; ++m) { const size_t off = (size_t)(u.pm * BM + wr * 64 + m * 16 + fr) * ldc + col0;
#pragma unroll
            for (int bj = 0; bj < 2; ++bj)
#pragma unroll
                for (int n = 0; n < 2; ++n) pre[m][bj][n] = *(const f32x4*)(base + off + bj * HALF + n * 16); }
        const bool bad = st.run(acc, u, wr, wc, fr, fq, lds, wid, lane) || poison != 0u;
        const float qnan = __builtin_nanf("");
#pragma unroll
        for (int ai = 0; ai < 2; ++ai)
#pragma unroll
            for (int m = 0; m < 4; ++m) { const int r = ai * HALF + wr * 64 + m * 16 + fr; const f32x2v sr = S[r]; const size_t off = (size_t)(u.pm * BM + r) * ldc + col0;
#pragma unroll
                for (int bj = 0; bj < 2; ++bj)
#pragma unroll
                    for (int n = 0; n < 2; ++n) { const f32x4 bs = ai == 0 ? pre[m][bj][n] : *(const f32x4*)(base + off + bj * HALF + n * 16); f32x4 o = bs + (acc[ai][bj][m][n] - sr.x) * sr.y;
                        if (bad) o = (f32x4){qnan, qnan, qnan, qnan}; *(f32x4*)(out + off + bj * HALF + n * 16) = o; }
                if (m & 1) asm volatile("" ::: "memory"); }
    }
};
struct EpiLnResLn {
    static constexpr bool PERM = false, AFTER_DRAIN = true;
    const float* base; float* out; bf16_t* xn; int ldc; const float* bias; PanelStats st1, st2; unsigned poison;
    __device__ __forceinline__ void fused(f32x4 (&acc)[2][2][4][2], const Unit& u, int wr, int wc, int fr, int fq, PG8_LAS unsigned char* lds, int wid, int lane) const {
        typedef float f32x2v __attribute__((ext_vector_type(2))); typedef unsigned u32x2v __attribute__((ext_vector_type(2)));
        const PG8_LAS f32x2v* S = (const PG8_LAS f32x2v*)(lds + 8192);
        const int col0 = u.pn * BM + wc * 32 + 4 * fq;
#pragma unroll
        for (int bj = 0; bj < 2; ++bj)
#pragma unroll
            for (int n = 0; n < 2; ++n) { const f32x4 bv = bias ? *(const f32x4*)(bias + col0 + bj * HALF + n * 16) : (f32x4){0.f, 0.f, 0.f, 0.f};
#pragma unroll
                for (int ai = 0; ai < 2; ++ai)
#pragma unroll
                    for (int m = 0; m < 4; ++m) acc[ai][bj][m][n] += bv; }
        bool bad = st1.run(acc, u, wr, wc, fr, fq, lds, wid, lane) || poison != 0u;
        const float qnan = __builtin_nanf("");
#pragma unroll
        for (int ai = 0; ai < 2; ++ai)
#pragma unroll
            for (int m = 0; m < 4; ++m) { const int r = ai * HALF + wr * 64 + m * 16 + fr; const f32x2v sr = S[r]; const size_t off = (size_t)(u.pm * BM + r) * ldc + col0;
#pragma unroll
                for (int bj = 0; bj < 2; ++bj)
#pragma unroll
                    for (int n = 0; n < 2; ++n) { const f32x4 bs = *(const f32x4*)(base + off + bj * HALF + n * 16); acc[ai][bj][m][n] = bs + (acc[ai][bj][m][n] - sr.x) * sr.y; }
                asm volatile("" : "+v"(acc[ai][0][m][0]), "+v"(acc[ai][0][m][1]), "+v"(acc[ai][1][m][0]), "+v"(acc[ai][1][m][1]));
                if (m & 1) asm volatile("" ::: "memory"); }
        const bool bad1 = bad;
        bad = st2.run(acc, u, wr, wc, fr, fq, lds, wid, lane) || bad;
#pragma unroll
        for (int ai = 0; ai < 2; ++ai)
#pragma unroll
            for (int m = 0; m < 4; ++m) { const int r = ai * HALF + wr * 64 + m * 16 + fr; const f32x2v sr = S[r]; const size_t off = (size_t)(u.pm * BM + r) * ldc + col0;
#pragma unroll
                for (int bj = 0; bj < 2; ++bj)
#pragma unroll
                    for (int n = 0; n < 2; ++n) { const f32x4 x1 = acc[ai][bj][m][n]; *(f32x4*)(out + off + bj * HALF + n * 16) = bad1 ? (f32x4){qnan, qnan, qnan, qnan} : x1;
                        const f32x4 o = (x1 - sr.x) * sr.y; u32x2v w; w.x = cvt_pk_bf16(o[0], o[1]); w.y = cvt_pk_bf16(o[2], o[3]);
                        if (bad) { w.x = 0x7fc07fc0u; w.y = 0x7fc07fc0u; } *(u32x2v*)(xn + off + bj * HALF + n * 16) = w; }
                asm volatile("" ::: "memory"); }
    }
};

template <class Epi, class Sched, bool ALIGN_EPI = false, bool SP2 = false>
__device__ __forceinline__ void gemm_phase(PG8_LAS unsigned char* lds, const Gemm g, const Sched& S, const Epi& E) {
    const int tid = opaque_tid(), wid = __builtin_amdgcn_readfirstlane(tid >> 6), lane = tid & 63, wr = wid >> 2, wc = wid & 3, fr = lane & 15, fq = lane >> 4;
    const int K = g.K, nt = K / BK;
    unsigned voffA[2], voffB[2];
#pragma unroll
    for (int i = 0; i < 2; ++i) { int R, C; stage_rc(tid * 16 + i * 8192, R, C); const int Rb = Epi::PERM ? ((R & ~31) + perm32(R & 31)) : R;
        voffA[i] = (unsigned)(R * K + C) * 2u; voffB[i] = (unsigned)(Rb * K + C) * 2u; }
    const size_t kstep = (size_t)(BK * 2);
    const size_t hstep = (size_t)HALF * K * 2;
    const size_t tstep = 2 * hstep;
    const unsigned ldsw = (unsigned)wid * 1024u;
    const int aoff = lds_byte(wr * 64 + fr, fq * 8), boff = lds_byte(wc * 32 + fr, fq * 8);
#define PG8_SA(b, h) (((b) * 2 + (h)) * HTB)
#define PG8_SB(b, h) ((4 + (b) * 2 + (h)) * HTB)
#define PG8_STAGE(bufoff, gbase, voff) do { _Pragma("unroll") for (int _i = 0; _i < 2; ++_i) \
        __builtin_amdgcn_global_load_lds((const unsigned*)((const char*)(gbase) + (voff)[_i]), (PG8_LAS unsigned*)(lds + (bufoff) + ldsw + _i * 8192), 16, 0, 0); } while (0)
#define PG8_LDA(dst, b, h) do { _Pragma("unroll") for (int m = 0; m < 4; ++m) _Pragma("unroll") for (int k = 0; k < 2; ++k) dst[m][k] = *(const PG8_LAS bf16x8*)(lds + PG8_SA(b, h) + aoff + m * 2048 + k * 1024); } while (0)
#define PG8_LDB(dst, b, h) do { _Pragma("unroll") for (int n = 0; n < 2; ++n) _Pragma("unroll") for (int k = 0; k < 2; ++k) dst[n][k] = *(const PG8_LAS bf16x8*)(lds + PG8_SB(b, h) + boff + n * 2048 + k * 1024); } while (0)
#define PG8_MMA(ai, bj, At, Bt) do { __builtin_amdgcn_s_setprio(1); _Pragma("unroll") for (int m = 0; m < 4; ++m) _Pragma("unroll") for (int n = 0; n < 2; ++n) _Pragma("unroll") for (int k = 0; k < 2; ++k) \
        acc[ai][bj][m][n] = __builtin_amdgcn_mfma_f32_16x16x32_bf16(Bt[n][k], At[m][k], acc[ai][bj][m][n], 0, 0, 0); __builtin_amdgcn_s_setprio(0); } while (0)
#define PG8_WAIT_V(n) asm volatile("s_waitcnt vmcnt(" #n ")" ::: "memory")
#define PG8_WAIT_L(n) asm volatile("s_waitcnt lgkmcnt(" #n ")" ::: "memory")
#define PG8_BAR __builtin_amdgcn_s_barrier()
#define PG8_SCHED __builtin_amdgcn_sched_barrier(0)
    Unit cur, nxt; int ui = 0;
    if (!S.next(0, cur)) return;
    f32x4 acc[2][2][4][2];
#pragma unroll
    for (int a = 0; a < 2; ++a)
#pragma unroll
        for (int b = 0; b < 2; ++b)
#pragma unroll
            for (int m = 0; m < 4; ++m)
#pragma unroll
                for (int n = 0; n < 2; ++n) acc[a][b][m][n] = (f32x4){0.f, 0.f, 0.f, 0.f};
    bf16x8 At[4][2], B0[2][2], B1[2][2];
    const char* cA = (const char*)g.A + (size_t)cur.pm * tstep; const char* cB = (const char*)g.Bt + (size_t)cur.pn * tstep;
    S.a_ready(cur);
    if constexpr (SP2) {
        PG8_STAGE(PG8_SB(0, 0), cB, voffB); PG8_STAGE(PG8_SB(0, 1), cB + hstep, voffB); PG8_STAGE(PG8_SA(0, 0), cA, voffA); PG8_STAGE(PG8_SA(0, 1), cA + hstep, voffA);
        if (wr == 1) PG8_BAR;
        PG8_WAIT_V(2); PG8_BAR;
        PG8_STAGE(PG8_SB(1, 0), cB + kstep, voffB); PG8_STAGE(PG8_SA(1, 0), cA + kstep, voffA); PG8_STAGE(PG8_SB(1, 1), cB + hstep + kstep, voffB);
        PG8_WAIT_V(6); PG8_BAR;
    } else {
        PG8_STAGE(PG8_SB(0, 0), cB, voffB); PG8_STAGE(PG8_SA(0, 0), cA, voffA); PG8_STAGE(PG8_SB(0, 1), cB + hstep, voffB); PG8_STAGE(PG8_SA(0, 1), cA + hstep, voffA);
        if (wr == 1) PG8_BAR;
        PG8_WAIT_V(4); PG8_BAR;
        PG8_STAGE(PG8_SB(1, 0), cB + kstep, voffB); PG8_STAGE(PG8_SA(1, 0), cA + kstep, voffA); PG8_STAGE(PG8_SB(1, 1), cB + hstep + kstep, voffB);
        PG8_WAIT_V(6); PG8_BAR;
    }
    for (;;) {
        const bool has_next = S.next(ui + 1, nxt);
        const char* nA = has_next ? (const char*)g.A + (size_t)nxt.pm * tstep : cA; const char* nB = has_next ? (const char*)g.Bt + (size_t)nxt.pn * tstep : cB;
        for (int t = 0; t < nt; t += 2) {
            const bool last = (t == nt - 2);
            const char* a1 = cA + (size_t)(t + 1) * kstep;
            const char* a2 = last ? nA : cA + (size_t)(t + 2) * kstep; const char* b2 = last ? nB : cB + (size_t)(t + 2) * kstep;
            const char* a3 = a2 + kstep; const char* b3 = b2 + kstep;
            if (last && has_next) S.a_ready(nxt);
            if constexpr (SP2) {
            PG8_LDB(B0, 0, 0); PG8_LDB(B1, 0, 1); PG8_SCHED; PG8_LDA(At, 0, 0); PG8_STAGE(PG8_SA(1, 1), a1 + hstep, voffA);
            PG8_WAIT_V(8); PG8_WAIT_L(0); PG8_BAR; PG8_MMA(0, 0, At, B0); PG8_MMA(0, 1, At, B1); PG8_BAR; PG8_SCHED;
            PG8_LDA(At, 0, 1); PG8_STAGE(PG8_SB(0, 0), b2, voffB); PG8_STAGE(PG8_SB(0, 1), b2 + hstep, voffB); PG8_STAGE(PG8_SA(0, 0), a2, voffA);
            PG8_WAIT_V(8); PG8_WAIT_L(0); PG8_BAR; PG8_MMA(1, 0, At, B0); PG8_MMA(1, 1, At, B1); PG8_BAR; PG8_SCHED;
            PG8_LDB(B0, 1, 0); PG8_LDB(B1, 1, 1); PG8_SCHED; PG8_LDA(At, 1, 0); PG8_STAGE(PG8_SA(0, 1), a2 + hstep, voffA);
            PG8_WAIT_V(8); PG8_WAIT_L(0); PG8_BAR; PG8_MMA(0, 0, At, B0); PG8_MMA(0, 1, At, B1); PG8_BAR; PG8_SCHED;
            PG8_LDA(At, 1, 1); PG8_STAGE(PG8_SB(1, 0), b3, voffB); PG8_STAGE(PG8_SB(1, 1), b3 + hstep, voffB); PG8_STAGE(PG8_SA(1, 0), a3, voffA);
            PG8_WAIT_V(8); PG8_WAIT_L(0); PG8_BAR; PG8_MMA(1, 0, At, B0); PG8_MMA(1, 1, At, B1); PG8_BAR; PG8_SCHED;
            } else {
            PG8_LDB(B0, 0, 0); PG8_SCHED; PG8_LDA(At, 0, 0); PG8_STAGE(PG8_SA(1, 1), a1 + hstep, voffA);
            PG8_WAIT_L(8); PG8_BAR; PG8_WAIT_L(0); PG8_MMA(0, 0, At, B0); PG8_BAR; PG8_SCHED;
            PG8_LDB(B1, 0, 1); PG8_STAGE(PG8_SB(0, 0), b2, voffB);
            PG8_BAR; PG8_WAIT_L(0); PG8_MMA(0, 1, At, B1); PG8_BAR;
            PG8_LDA(At, 0, 1); PG8_STAGE(PG8_SA(0, 0), a2, voffA);
            PG8_BAR; PG8_WAIT_L(0); PG8_MMA(1, 0, At, B0); PG8_BAR; PG8_SCHED;
            PG8_STAGE(PG8_SB(0, 1), b2 + hstep, voffB);
            PG8_WAIT_V(6); PG8_BAR; PG8_MMA(1, 1, At, B1); PG8_BAR;
            PG8_LDB(B0, 1, 0); PG8_SCHED; PG8_LDA(At, 1, 0); PG8_STAGE(PG8_SA(0, 1), a2 + hstep, voffA);
            PG8_WAIT_L(8); PG8_BAR; PG8_WAIT_L(0); PG8_MMA(0, 0, At, B0); PG8_BAR; PG8_SCHED;
            PG8_LDB(B1, 1, 1); PG8_STAGE(PG8_SB(1, 0), b3, voffB);
            PG8_BAR; PG8_WAIT_L(0); PG8_MMA(0, 1, At, B1); PG8_BAR;
            PG8_LDA(At, 1, 1); PG8_STAGE(PG8_SA(1, 0), a3, voffA);
            PG8_BAR; PG8_WAIT_L(0); PG8_MMA(1, 0, At, B0); PG8_BAR; PG8_SCHED;
            PG8_STAGE(PG8_SB(1, 1), b3 + hstep, voffB);
            PG8_WAIT_V(6); PG8_BAR; PG8_MMA(1, 1, At, B1); PG8_BAR;
            }
        }
        if constexpr (ALIGN_EPI) { if (wr == 0) PG8_BAR; }
        if constexpr (!Epi::AFTER_DRAIN) { E(acc, cur, wr, wc, fr, fq); S.done(cur); }
        if (!has_next) break;
#pragma unroll
        for (int a = 0; a < 2; ++a)
#pragma unroll
            for (int b = 0; b < 2; ++b)
#pragma unroll
                for (int m = 0; m < 4; ++m)
#pragma unroll
                    for (int n = 0; n < 2; ++n) acc[a][b][m][n] = (f32x4){0.f, 0.f, 0.f, 0.f};
        cur = nxt; cA = nA; cB = nB; ++ui;
        if constexpr (ALIGN_EPI) { if (wr == 1) PG8_BAR; }
    }
    PG8_WAIT_V(0);
    if constexpr (!ALIGN_EPI) { if (wr == 0) PG8_BAR; }
    PG8_BAR;
    if constexpr (Epi::AFTER_DRAIN) { E.fused(acc, cur, wr, wc, fr, fq, lds, wid, lane); S.done(cur); }
#undef PG8_SA
#undef PG8_SB
#undef PG8_STAGE
#undef PG8_LDA
#undef PG8_LDB
#undef PG8_MMA
#undef PG8_WAIT_V
#undef PG8_WAIT_L
#undef PG8_BAR
#undef PG8_SCHED
}
}
namespace pg8 {
struct EpiSwiGLU {
    static constexpr bool PERM = true, AFTER_DRAIN = false;
    bf16_t* O; int ldc;
    static __device__ __forceinline__ float silu_mul(float g, float u) { const float e = __builtin_amdgcn_exp2f(-1.4426950408889634f * g); return g * __builtin_amdgcn_rcpf(1.0f + e) * u; }
    __device__ __forceinline__ void operator()(const f32x4 (&acc)[2][2][4][2], const Unit& u, int wr, int wc, int fr, int fq) const {
        const int row0 = u.pm * BM + wr * 64 + fr, col0 = u.pn * HALF + wc * 32 + 8 * fq;
#pragma unroll
        for (int ai = 0; ai < 2; ++ai)
#pragma unroll
            for (int m = 0; m < 4; ++m) { bf16_t* rowp = O + (size_t)(row0 + ai * HALF + m * 16) * ldc + col0;
                const f32x4 g0 = acc[ai][0][m][0], g1 = acc[ai][0][m][1], u0 = acc[ai][1][m][0], u1 = acc[ai][1][m][1];
                u32x4 w; w.x = cvt_pk_bf16(silu_mul(g0[0], u0[0]), silu_mul(g0[1], u0[1])); w.y = cvt_pk_bf16(silu_mul(g0[2], u0[2]), silu_mul(g0[3], u0[3]));
                w.z = cvt_pk_bf16(silu_mul(g1[0], u1[0]), silu_mul(g1[1], u1[1])); w.w = cvt_pk_bf16(silu_mul(g1[2], u1[2]), silu_mul(g1[3], u1[3]));
                *(u32x4*)rowp = w; }
    }
};
struct EpiQKV {
    static constexpr bool PERM = true, AFTER_DRAIN = false;
    bf16_t* Q; size_t buf_stride; const float* rope; float scale0;
    __device__ __forceinline__ void operator()(const f32x4 (&acc)[2][2][4][2], const Unit& u, int wr, int wc, int fr, int fq) const {
        const int t = u.pn >> 2; bf16_t* base = Q + (size_t)t * buf_stride; const float sc = (t == 0) ? scale0 : 1.f;
        const int col0 = (u.pn & 3) * BM + wc * 32 + 8 * fq;
        const bool rot = (t < 2) && ((wc & 1) == 0);
        const float sgn = (fq == 0) ? -1.f : 1.f;
#pragma unroll
        for (int ai = 0; ai < 2; ++ai)
#pragma unroll
            for (int m = 0; m < 4; ++m) { const int r = ai * HALF + wr * 64 + m * 16 + fr; int orow, pos; bool valid = true;
                if (u.pm < 64) { orow = (u.pm >> 3) * 2112 + 64 + (u.pm & 7) * 256 + r; pos = 16 + (u.pm & 7) * 256 + r; }
                else { valid = r < 128; orow = (r >> 4) * 2112 + 48 + (r & 15); pos = r & 15; }
                f32x4 cs0 = {1.f, 1.f, 1.f, 1.f}, cs1 = cs0, sn0 = {0.f, 0.f, 0.f, 0.f}, sn1 = sn0;
                if (rot && fq < 2) { const f32x4* rp = (const f32x4*)(rope + (size_t)pos * 16); cs0 = rp[0]; cs1 = rp[1]; sn0 = rp[2]; sn1 = rp[3]; }
#pragma unroll
                for (int bj = 0; bj < 2; ++bj) { f32x4 v0 = acc[ai][bj][m][0], v1 = acc[ai][bj][m][1];
                    if (rot) { f32x4 o0, o1;
#pragma unroll
                        for (int i = 0; i < 4; ++i) { o0[i] = __shfl_xor(v0[i], 16); o1[i] = __shfl_xor(v1[i], 16); }
                        v0 = v0 * cs0 + (o0 * sn0) * sgn; v1 = v1 * cs1 + (o1 * sn1) * sgn; }
                    v0 = v0 * sc; v1 = v1 * sc; u32x4 w; w.x = cvt_pk_bf16(v0[0], v0[1]); w.y = cvt_pk_bf16(v0[2], v0[3]); w.z = cvt_pk_bf16(v1[0], v1[1]); w.w = cvt_pk_bf16(v1[2], v1[3]);
                    if (valid) *(u32x4*)(base + (size_t)orow * 1024 + col0 + bj * HALF) = w; } }
    }
};
}
#include <hip/hip_bf16.h>
#include <cmath>
namespace attn_body {
using bf16=__hip_bfloat16;
using bf16x8=__attribute__((ext_vector_type(8)))short;
using s16x4=__attribute__((ext_vector_type(4)))short;
using f32x16=__attribute__((ext_vector_type(16)))float;
using u32x4=__attribute__((ext_vector_type(4)))unsigned;
constexpr int D=64,DM=1024,OPITCH=2048,BSTRIDE=2112,FRONT=48,RVEND=2112;
constexpr int NW=8,QBLK=32,QB=QBLK*NW,KVBLK=64,NQB=9;
constexpr int ATTN_PITCH=DM, ATTN_UNIT_ROWS=QB;
__device__ __forceinline__ int crow(int r,int hi){return (r&3)+8*(r>>2)+4*hi;}
#define SBAR() __builtin_amdgcn_sched_barrier(0)
__device__ __forceinline__ void cmask(f32x16&p0,f32x16&p1,int jb,int qrel,int hi){
  const float NEG=-INFINITY; int kb=64*jb+4*hi;
  #pragma unroll
  for(int r=0;r<16;++r){int kv=kb+(r&3)+8*(r>>2); if(kv>qrel)p0[r]=NEG; if(kv+32>qrel)p1[r]=NEG;}
}

constexpr int NSLOT=3, SLOTB=8192;
constexpr int LDS_K=0, LDS_V=NSLOT*SLOTB, LDS_WS=3*NSLOT*SLOTB, LDS_OST=LDS_WS+NW*64*4, LDS_BYTES=LDS_OST+NW*4096;
constexpr float C2=0.125f*1.4426950408889634f;
__device__ __forceinline__ void glds16(const void*gsrc,unsigned lds_dst){unsigned keep;
  asm volatile("s_mov_b32 %0, m0\n\ts_mov_b32 m0, %2\n\ts_nop 0\n\tglobal_load_lds_dwordx4 %1, off\n\ts_mov_b32 m0, %0":"=&s"(keep):"v"(gsrc),"s"(lds_dst):"memory");}
__device__ __forceinline__ float max3f(float a,float b,float c){float r;asm("v_max3_f32 %0, %1, %2, %3":"=v"(r):"v"(a),"v"(b),"v"(c));return r;}
__device__ __forceinline__ float max2f(float a,float b){float r;asm("v_max_f32_e32 %0, %1, %2":"=v"(r):"v"(a),"v"(b));return r;}
__device__ __forceinline__ float fadd_s(float a,float b){float r;asm("v_add_f32_e32 %0, %1, %2":"=v"(r):"v"(a),"v"(b));return r;}
__device__ __forceinline__ float fsub_s(float a,float b){float r;asm("v_sub_f32_e32 %0, %1, %2":"=v"(r):"v"(a),"v"(b));return r;}
typedef float f32x2_t __attribute__((ext_vector_type(2))); typedef __bf16 bf16x2_t __attribute__((ext_vector_type(2)));
__device__ __forceinline__ unsigned cvtpk_s(float lo,float hi){f32x2_t v={lo,hi};bf16x2_t b=__builtin_convertvector(v,bf16x2_t);return __builtin_bit_cast(unsigned,b);}
#define WAIT_BAR(N) asm volatile("s_waitcnt vmcnt(" #N ") lgkmcnt(0)\n\ts_barrier":::"memory")

__device__ __forceinline__ void qkt(f32x16&p0,f32x16&p1,const char*Kslot,const bf16x8*qr,const f32x16&negm,int r32,int hi){
  const char*kb=Kslot+hi*1024+r32*16;
  #pragma unroll
  for(int d0=0;d0<4;++d0){
    const bf16x8 b0=*reinterpret_cast<const bf16x8*>(kb+d0*2048);
    const bf16x8 b1=*reinterpret_cast<const bf16x8*>(kb+d0*2048+512);
    if(d0==0){p0=__builtin_amdgcn_mfma_f32_32x32x16_bf16(b0,qr[0],negm,0,0,0);p1=__builtin_amdgcn_mfma_f32_32x32x16_bf16(b1,qr[0],negm,0,0,0);}
    else{p0=__builtin_amdgcn_mfma_f32_32x32x16_bf16(b0,qr[d0],p0,0,0,0);p1=__builtin_amdgcn_mfma_f32_32x32x16_bf16(b1,qr[d0],p1,0,0,0);}}
}
typedef __attribute__((address_space(3))) const char* lds_cptr;
typedef short v4i16_t __attribute__((ext_vector_type(4)));
__device__ __forceinline__ void kload8(bf16x8*kf,lds_cptr kp){
  kf[0]=*(const __attribute__((address_space(3))) bf16x8*)(kp);      kf[1]=*(const __attribute__((address_space(3))) bf16x8*)(kp+512);
  kf[2]=*(const __attribute__((address_space(3))) bf16x8*)(kp+2048); kf[3]=*(const __attribute__((address_space(3))) bf16x8*)(kp+2560);
  kf[4]=*(const __attribute__((address_space(3))) bf16x8*)(kp+4096); kf[5]=*(const __attribute__((address_space(3))) bf16x8*)(kp+4608);
  kf[6]=*(const __attribute__((address_space(3))) bf16x8*)(kp+6144); kf[7]=*(const __attribute__((address_space(3))) bf16x8*)(kp+6656);
}
__device__ __forceinline__ void kload2(bf16x8*kf,lds_cptr kp,int j){ kf[2*j]=*(const __attribute__((address_space(3))) bf16x8*)(kp+j*2048); kf[2*j+1]=*(const __attribute__((address_space(3))) bf16x8*)(kp+j*2048+512); }
__device__ __forceinline__ s16x4 vtr(lds_cptr p){ return __builtin_bit_cast(s16x4,__builtin_amdgcn_ds_read_tr16_b64_v4i16((__attribute__((address_space(3))) v4i16_t*)p)); }
__device__ __forceinline__ float rowmax(const f32x16&p0,const f32x16&p1){
  float a=max3f(p0[0],p0[1],p1[0]),b=max3f(p0[2],p0[3],p1[1]);a=max3f(a,p1[2],p1[3]);
  #pragma unroll
  for(int r=4;r<16;r+=4){a=max3f(a,p0[r],p0[r+1]);b=max3f(b,p0[r+2],p0[r+3]);a=max3f(a,p1[r],p1[r+1]);b=max3f(b,p1[r+2],p1[r+3]);}
  const float m=max2f(a,b);
  auto rr=__builtin_amdgcn_permlane32_swap(__float_as_uint(m),__float_as_uint(m),false,false);
  return max2f(__uint_as_float(rr[0]),__uint_as_float(rr[1]));
}
__device__ __forceinline__ void pv(f32x16*o,int vb,bf16x8 pa0,bf16x8 pa1,bf16x8 pa2,bf16x8 pa3){
  #pragma unroll
  for(int d0=0;d0<2;++d0){s16x4 lo[4],hi[4];
    #pragma unroll
    for(int ks=0;ks<4;++ks){
      asm volatile("ds_read_b64_tr_b16 %0,%1 offset:%c2":"=&v"(lo[ks]):"v"(vb),"i"(d0*4096+ks*1024):"memory");
      asm volatile("ds_read_b64_tr_b16 %0,%1 offset:%c2":"=&v"(hi[ks]):"v"(vb),"i"(d0*4096+ks*1024+512):"memory");}
    asm volatile("s_waitcnt lgkmcnt(0)":::"memory");SBAR();
    #define PK(k) (bf16x8){lo[k][0],lo[k][1],lo[k][2],lo[k][3],hi[k][0],hi[k][1],hi[k][2],hi[k][3]}
    o[d0]=__builtin_amdgcn_mfma_f32_32x32x16_bf16(pa0,PK(0),o[d0],0,0,0);
    o[d0]=__builtin_amdgcn_mfma_f32_32x32x16_bf16(pa1,PK(1),o[d0],0,0,0);
    o[d0]=__builtin_amdgcn_mfma_f32_32x32x16_bf16(pa2,PK(2),o[d0],0,0,0);
    o[d0]=__builtin_amdgcn_mfma_f32_32x32x16_bf16(pa3,PK(3),o[d0],0,0,0);
    #undef PK
  }
}

#ifndef ATTN_STORE16
#define ATTN_STORE16(p,v) (*(u32x4*)(p)=(v))
#endif
template<int THRL,bool ODD> __device__ __forceinline__ void attn_unit(int b,int cq,int cv,int co,int q0,const bf16*Q,const bf16*__restrict__ K,const bf16*__restrict__ V,bf16*O,char*shm){
  const int tid=opaque_tid(),lane=tid&63,r32=lane&31,hi=lane>>5; const int wid=__builtin_amdgcn_readfirstlane(tid>>6);
  const long rowbase=(long)b*BSTRIDE;
  const bf16*Qw=Q+(rowbase+q0+wid*QBLK)*DM+cq;
  const bf16*Kh=K+rowbase*DM+cq,*Vh=V+rowbase*DM+cv;
  const unsigned lds0=(unsigned)(uintptr_t)shm;
  float*wsf=(float*)(shm+LDS_WS)+wid*64;
  const bf16*ksrc=Kh+(long)lane*DM+wid*8;
  const bf16*vsrc=Vh+(long)(16*(wid&3)+(lane>>2))*DM+(wid>>2)*32+(lane&3)*8;
  const unsigned kdst=lds0+LDS_K+wid*1024, vdst=lds0+LDS_V+wid*1024;
  #define DMA_K(t,slot) glds16(ksrc+(long)(t)*KVBLK*DM,(unsigned)__builtin_amdgcn_readfirstlane(kdst+(slot)))
  #define DMA_V(t,slot) do{ glds16(vsrc+(long)(t)*KVBLK*DM,(unsigned)__builtin_amdgcn_readfirstlane(vdst+2*(slot))); glds16(vsrc+(long)(t)*KVBLK*DM+64,(unsigned)__builtin_amdgcn_readfirstlane(vdst+2*(slot)+SLOTB)); }while(0)
  const int vb0=(int)(lds0+LDS_V)+((lane>>4)&1)*32+(lane&3)*8+(4*hi+((lane&15)>>2))*64;
  const char*Kbase=shm+LDS_K; bf16x8 kf[8];
  const lds_cptr shm3=(lds_cptr)shm; const lds_cptr kp0=shm3+LDS_K+hi*1024+r32*16; const lds_cptr vp0=shm3+LDS_V+((lane>>4)&1)*32+(lane&3)*8+(4*hi+((lane&15)>>2))*64;
  const int NT=(q0+QB)/KVBLK;
  DMA_K(0,0);DMA_V(0,0);DMA_K(1,SLOTB);
  bf16x8 qr[4];
  #pragma unroll
  for(int d0=0;d0<4;++d0)qr[d0]=*reinterpret_cast<const bf16x8*>(&Qw[(long)r32*DM+d0*16+hi*8]);
  float mhat=0.f,l_reg=0.f;f32x16 o[4];o[0]=f32x16{};o[1]=f32x16{};o[2]=f32x16{};o[3]=f32x16{};const f32x16 zero16=f32x16{};
  const int qrel=wid*QBLK+r32;
  #define CMASK(P0,P1,t) do{int jb_=(t)-(NT-4); if(jb_>=0)cmask(P0,P1,jb_,qrel,hi);}while(0)
  #define CM1(P0,P1,t,r) do{int jb_=(t)-(NT-4); if(jb_>=0){ const int kv_=64*jb_+4*hi+((r)&3)+8*((r)>>2); if(kv_>qrel)P0[r]=-INFINITY; if(kv_+32>qrel)P1[r]=-INFINITY; } }while(0)
  bool resc=false;
  #define START(P0,P1) do{ const float rm=rowmax(P0,P1); resc=false; \
    { const float dl=rm; mhat=fadd_s(mhat,dl); \
      _Pragma("unroll") for(int r=0;r<16;++r){P0[r]=fsub_s(P0[r],dl);P1[r]=fsub_s(P1[r],dl);} \
      } \
    _Pragma("unroll") for(int r=0;r<16;++r)P0[r]=__builtin_amdgcn_exp2f(P0[r]); }while(0)
  #define RESC() do{ if(resc){ asm volatile("s_waitcnt lgkmcnt(0)":::"memory"); \
      _Pragma("unroll") for(int d_=0;d_<4;++d_) _Pragma("unroll") for(int r=0;r<16;++r)o[d_][r]*=wsf[crow(r,hi)]; } }while(0)
  f32x16 pA0,pA1,pB0,pB1;
  int sl_prev=0,sl_cur=0,sl_next=SLOTB;
  #define ROT() do{sl_prev=sl_cur;sl_cur=sl_next;sl_next=(sl_next==(NSLOT-1)*SLOTB)?0:sl_next+SLOTB;}while(0)
  DMA_K(2,2*SLOTB);
  WAIT_BAR(3);
  qkt(pA0,pA1,Kbase,qr,zero16,r32,hi);asm volatile("s_nop 15\n\ts_nop 7":"+v"(pA0),"+v"(pA1));CMASK(pA0,pA1,0);
  if(q0+qrel>=FRONT){ _Pragma("unroll") for(int r=0;r<16;++r)pA0[r]=-INFINITY; _Pragma("unroll") for(int r=0;r<8;++r)pA1[r]=-INFINITY; }
  START(pA0,pA1);
  _Pragma("unroll") for(int r=0;r<16;++r)pA1[r]=__builtin_amdgcn_exp2f(pA1[r]);
  WAIT_BAR(0);
  DMA_K(3,0);DMA_V(1,SLOTB);
  ROT();
  kload8(kf,kp0+sl_cur);
  WAIT_BAR(3);
  s16x4 vlo[8],vhi[8]; u32x4 pw0,pw1,pw2,pw3;
  #define PKW(P,B) cvtpk_s(P[B],P[B+1])
  #define PAF(k) __builtin_bit_cast(bf16x8,pw##k)
  #define PIN(x) asm volatile("":"+v"(x))
  #define MX3(a,b,c) __builtin_fmaxf(__builtin_fmaxf((a),(b)),(c))
  #define GAPA(MF,A0,A1,A2,A3,W0,W1,PW) do{ MF; sacc+=A0; sacc+=A1; sacc+=A2; sacc+=A3; PIN(sacc); W0; W1; PIN(PW); SBAR(); }while(0)
  #define EX(v) __builtin_amdgcn_exp2f(v)
  #define GAPS(MF,X0,X1,t,R) do{ MF; X0[R]-=mhat; X0[(R)+1]-=mhat; X1[R]-=mhat; X1[(R)+1]-=mhat; CM1(X0,X1,t,R); CM1(X0,X1,t,(R)+1); mxa=MX3(mxa,X0[R],X0[(R)+1]); mxb=MX3(mxb,X1[R],X1[(R)+1]); PIN(mxa); PIN(mxb); SBAR(); }while(0)
  #define GAPB(MF,X,B) do{ MF; X[B]=EX(X[B]); X[B+1]=EX(X[B+1]); X[B+2]=EX(X[B+2]); X[B+3]=EX(X[B+3]); PIN(X); SBAR(); }while(0)
  #define VRD(i,hf) do{ vlo[(i)&7]=vtr(vp_+((hf)*8192+((i)>>2)*4096+((i)&3)*1024)); vhi[(i)&7]=vtr(vp_+((hf)*8192+((i)>>2)*4096+((i)&3)*1024+512)); }while(0)
  #define KRD(G,j) do{ if(G){ kload2(kf,kp0+sl_next,j); SBAR(); } }while(0)
  #define VF4(i) (bf16x8){vlo[i][0],vlo[i][1],vlo[i][2],vlo[i][3],vhi[i][0],vhi[i][1],vhi[i][2],vhi[i][3]}
  #define STEP(C0,C1,P0,P1,t,GK,GV,GL) do{ SBAR(); \
      \
    if(GV){DMA_V((t)+1,sl_next);} if(GK){DMA_K((t)+3,sl_cur);} \
    const lds_cptr vp_=vp0+2*sl_prev; \
    float sacc=(P0[0]+P0[1]); \
    GAPA(C0=__builtin_amdgcn_mfma_f32_32x32x16_bf16(kf[0],qr[0],zero16,0,0,0), P0[2],P0[3],P0[4],P0[5],     pw0[0]=PKW(P0,0), pw0[1]=PKW(P0,2), pw0); \
    GAPA(C1=__builtin_amdgcn_mfma_f32_32x32x16_bf16(kf[1],qr[0],zero16,0,0,0), P0[6],P0[7],P0[8],P0[9],     pw0[2]=PKW(P0,4), pw0[3]=PKW(P0,6), pw0); \
    GAPA(C0=__builtin_amdgcn_mfma_f32_32x32x16_bf16(kf[2],qr[1],C0,0,0,0),   P0[10],P0[11],P0[12],P0[13], pw1[0]=PKW(P0,8), pw1[1]=PKW(P0,10), pw1); \
    GAPA(C1=__builtin_amdgcn_mfma_f32_32x32x16_bf16(kf[3],qr[1],C1,0,0,0),   P0[14],P0[15],P1[0],P1[1],   pw1[2]=PKW(P0,12),pw1[3]=PKW(P0,14), pw1); \
    GAPA(C0=__builtin_amdgcn_mfma_f32_32x32x16_bf16(kf[4],qr[2],C0,0,0,0),   P1[2],P1[3],P1[4],P1[5],     pw2[0]=PKW(P1,0), pw2[1]=PKW(P1,2), pw2); \
    GAPA(C1=__builtin_amdgcn_mfma_f32_32x32x16_bf16(kf[5],qr[2],C1,0,0,0),   P1[6],P1[7],P1[8],P1[9],     pw2[2]=PKW(P1,4), pw2[3]=PKW(P1,6), pw2); \
    GAPA(C0=__builtin_amdgcn_mfma_f32_32x32x16_bf16(kf[6],qr[3],C0,0,0,0),   P1[10],P1[11],P1[12],P1[13], pw3[0]=PKW(P1,8), pw3[1]=PKW(P1,10), pw3); \
    VRD(0,0); VRD(1,0); VRD(2,0); VRD(3,0); SBAR(); \
    GAPA(C1=__builtin_amdgcn_mfma_f32_32x32x16_bf16(kf[7],qr[3],C1,0,0,0),   P1[14],P1[15],0.f,0.f,       pw3[2]=PKW(P1,12),pw3[3]=PKW(P1,14), pw3); \
    l_reg+=sacc; \
      \
      \
    VRD(4,0); VRD(5,0); VRD(6,0); VRD(7,0); SBAR(); \
    float mxa=-INFINITY,mxb=-INFINITY; \
    GAPS(o[0]=__builtin_amdgcn_mfma_f32_32x32x16_bf16(PAF(0),VF4(0),o[0],0,0,0), C0,C1,t,0); \
    GAPS(o[0]=__builtin_amdgcn_mfma_f32_32x32x16_bf16(PAF(1),VF4(1),o[0],0,0,0), C0,C1,t,2); \
    GAPS(o[0]=__builtin_amdgcn_mfma_f32_32x32x16_bf16(PAF(2),VF4(2),o[0],0,0,0), C0,C1,t,4); \
    GAPS(o[0]=__builtin_amdgcn_mfma_f32_32x32x16_bf16(PAF(3),VF4(3),o[0],0,0,0), C0,C1,t,6); \
    VRD(0,1); VRD(1,1); VRD(2,1); VRD(3,1); KRD(GL,0); SBAR(); \
    GAPS(o[1]=__builtin_amdgcn_mfma_f32_32x32x16_bf16(PAF(0),VF4(4),o[1],0,0,0), C0,C1,t,8); \
    GAPS(o[1]=__builtin_amdgcn_mfma_f32_32x32x16_bf16(PAF(1),VF4(5),o[1],0,0,0), C0,C1,t,10); \
    GAPS(o[1]=__builtin_amdgcn_mfma_f32_32x32x16_bf16(PAF(2),VF4(6),o[1],0,0,0), C0,C1,t,12); \
    GAPS(o[1]=__builtin_amdgcn_mfma_f32_32x32x16_bf16(PAF(3),VF4(7),o[1],0,0,0), C0,C1,t,14); \
    { float rm=__builtin_fmaxf(mxa,mxb); { auto rr=__builtin_amdgcn_permlane32_swap(__float_as_uint(rm),__float_as_uint(rm),false,false); rm=__builtin_fmaxf(__uint_as_float(rr[0]),__uint_as_float(rr[1])); } \
      resc=false; \
      if(__builtin_expect(__any(rm>(float)THRL),0)){ const float dl=__builtin_fmaxf(rm,0.f); mhat+=dl; \
        _Pragma("unroll") for(int r=0;r<16;++r){C0[r]-=dl;C1[r]-=dl;} \
        const float f=__builtin_amdgcn_exp2f(-dl); l_reg*=f; if(hi==0)wsf[r32]=f; resc=true; } } \
    SBAR(); \
    VRD(4,1); VRD(5,1); VRD(6,1); VRD(7,1); KRD(GL,1); SBAR(); \
    GAPB(o[2]=__builtin_amdgcn_mfma_f32_32x32x16_bf16(PAF(0),VF4(0),o[2],0,0,0), C0,0); \
    GAPB(o[2]=__builtin_amdgcn_mfma_f32_32x32x16_bf16(PAF(1),VF4(1),o[2],0,0,0), C0,4); \
    GAPB(o[2]=__builtin_amdgcn_mfma_f32_32x32x16_bf16(PAF(2),VF4(2),o[2],0,0,0), C0,8); \
    GAPB(o[2]=__builtin_amdgcn_mfma_f32_32x32x16_bf16(PAF(3),VF4(3),o[2],0,0,0), C0,12); \
    KRD(GL,2); \
    GAPB(o[3]=__builtin_amdgcn_mfma_f32_32x32x16_bf16(PAF(0),VF4(4),o[3],0,0,0), C1,0); \
    GAPB(o[3]=__builtin_amdgcn_mfma_f32_32x32x16_bf16(PAF(1),VF4(5),o[3],0,0,0), C1,4); \
    KRD(GL,3); \
    GAPB(o[3]=__builtin_amdgcn_mfma_f32_32x32x16_bf16(PAF(2),VF4(6),o[3],0,0,0), C1,8); \
    GAPB(o[3]=__builtin_amdgcn_mfma_f32_32x32x16_bf16(PAF(3),VF4(7),o[3],0,0,0), C1,12); \
    }while(0)
  int t=1;
  #undef CMASK
  #define CMASK(P0,P1,t) do{}while(0)
  #undef CM1
  #define CM1(P0,P1,t,r) do{}while(0)
  for(;t+5<NT;t+=2){
    STEP(pB0,pB1,pA0,pA1,t,true,true,true);     WAIT_BAR(3); RESC(); ROT();
    STEP(pA0,pA1,pB0,pB1,t+1,true,true,true);   WAIT_BAR(3); RESC(); ROT();
  }
  #undef CMASK
  #define CMASK(P0,P1,t) do{int jb_=(t)-(NT-4); if(jb_>=0)cmask(P0,P1,jb_,qrel,hi);}while(0)
  #undef CM1
  #define CM1(P0,P1,t,r) do{int jb_=(t)-(NT-4); if(jb_>=0){ const int kv_=64*jb_+4*hi+((r)&3)+8*((r)>>2); if(kv_>qrel)P0[r]=-INFINITY; if(kv_+32>qrel)P1[r]=-INFINITY; } }while(0)
  #define ENDW(tt) do{ if((tt)+3<NT){WAIT_BAR(3);} else if((tt)+2<NT){WAIT_BAR(2);} else {WAIT_BAR(0);} }while(0)
  for(;t+1<NT;t+=2){
    STEP(pB0,pB1,pA0,pA1,t,(t+3<NT),(t+1<NT),(t+1<NT));       ENDW(t);   RESC(); ROT();
    STEP(pA0,pA1,pB0,pB1,t+1,(t+4<NT),(t+2<NT),(t+2<NT));     ENDW(t+1); RESC(); ROT();
  }
  #define DRAIN(Q0,Q1,SL) do{ float sacc=Q0[0]+Q0[1]; _Pragma("unroll") for(int r=2;r<16;++r)sacc+=Q0[r]; _Pragma("unroll") for(int r=0;r<16;++r)sacc+=Q1[r]; l_reg+=sacc; \
    pw0=(u32x4){PKW(Q0,0),PKW(Q0,2),PKW(Q0,4),PKW(Q0,6)};pw1=(u32x4){PKW(Q0,8),PKW(Q0,10),PKW(Q0,12),PKW(Q0,14)};pw2=(u32x4){PKW(Q1,0),PKW(Q1,2),PKW(Q1,4),PKW(Q1,6)};pw3=(u32x4){PKW(Q1,8),PKW(Q1,10),PKW(Q1,12),PKW(Q1,14)}; \
    SBAR(); pv(o,vb0+2*(SL),PAF(0),PAF(1),PAF(2),PAF(3)); pv(o+2,vb0+2*(SL)+SLOTB,PAF(0),PAF(1),PAF(2),PAF(3)); }while(0)
  if constexpr(ODD){ DRAIN(pA0,pA1,sl_prev); }
  else{ STEP(pB0,pB1,pA0,pA1,NT-1,false,false,false); RESC(); DRAIN(pB0,pB1,sl_cur); }
  #undef DRAIN
  #undef PKW
  #undef PAF
  #undef VF4
  #undef PIN
  #undef MX3
  #undef GAPA
  #undef GAPB
  #undef GAPS
  #undef EX
  #undef VRD
  #undef KRD
  #undef STEP
  #undef ENDW
  {auto rr=__builtin_amdgcn_permlane32_swap(__float_as_uint(l_reg),__float_as_uint(l_reg),false,false);l_reg=__uint_as_float(rr[0])+__uint_as_float(rr[1]);}
  if(hi==0)wsf[32+r32]=l_reg;asm volatile("s_waitcnt lgkmcnt(0)":::"memory");
  float rli[16];
  #pragma unroll
  for(int r=0;r<16;++r)rli[r]=__builtin_amdgcn_rcpf(wsf[32+crow(r,hi)]);
  bf16*Ow=O+co;
  { bf16*stg=(bf16*)(shm+LDS_OST)+wid*2048;
    #pragma unroll
    for(int hf=0;hf<2;++hf){
    #pragma unroll
    for(int r=0;r<16;++r){const int orow=crow(r,hi);
      #pragma unroll
      for(int d0=0;d0<2;++d0)stg[orow*64+d0*32+r32]=__float2bfloat16(o[2*hf+d0][r]*rli[r]);}
    asm volatile("s_waitcnt lgkmcnt(0)":::"memory");
    #pragma unroll
    for(int i=0;i<4;++i){const int row=i*8+(lane>>3),ch=lane&7; const u32x4 v=*(const u32x4*)(stg+row*64+ch*8); const int rel=q0+wid*QBLK+row; const long m=(rel>=64)?(long)b*2048+(rel-64):16384L+16*b+(rel-FRONT); if(rel>=FRONT&&rel<RVEND&&(q0!=0||rel<64))ATTN_STORE16(Ow+m*DM+hf*64+ch*8,v);}
    asm volatile("s_waitcnt lgkmcnt(0)":::"memory"); } }
  asm volatile("s_waitcnt lgkmcnt(0)\n\ts_barrier":::"memory");
  #undef DMA_K
  #undef DMA_V
  #undef CMASK
  #undef CM1
  #undef START
  #undef RESC
  #undef ROT
}
constexpr int ATTN_LDS_BYTES=LDS_BYTES;
struct AttnTensors { const bf16* Q; const bf16* K; const bf16* V; bf16* O; bf16* O1; };
template<int THRL=8> __device__ __forceinline__ void attn_phase(char*lds,const AttnTensors&T,int vcu,int G){
  for(int w=vcu;w<256;w+=G){ const int item=w>>1,half=w&1,b=item>>4,hc=item&15,h=hc>>1,c=hc&1;
    const int n=half?4:5;
    for(int i=0;i<n;++i){ const int j=half?((i==0)?6:(i==1)?5:(i==2)?3:1):((i==0)?7:(i==1)?4:(i==2)?2:(i==3)?0:-1);
      if(j<0) attn_unit<THRL,false>(b,(2*h+c)*64,h*128,h*128,0,T.Q,T.K,T.V,c?T.O1:T.O,lds);
      else attn_unit<THRL,true>(b,(2*h+c)*64,h*128,h*128,64+256*j,T.Q,T.K,T.V,c?T.O1:T.O,lds); } }
}
#undef SBAR
#undef WAIT_BAR
}
#include <hip/hip_cooperative_groups.h>
namespace cg = cooperative_groups;
constexpr int NWAVES = 8;
constexpr int DM_ = 1024, DFF = 2816, NGU = 2 * DFF, NB = 8, SEQL = 2048, NMETA = 16, DEPTH_ = 4;
constexpr int MREAL = NB * SEQL;
constexpr int MVALID = MREAL + NB * NMETA;
constexpr int MPAD = 16640;
constexpr int QROWS = NB * 2112 + 256;
constexpr size_t MiB = 1u << 20;
constexpr size_t WS_ROPE = 1 * MiB;
constexpr size_t WS_HMETA = 1 * MiB + 512 * 1024;
constexpr size_t WS_W = 2 * MiB;
constexpr size_t W_GU_E = (size_t)NGU * DM_, W_DN_E = (size_t)DM_ * DFF, W_FFN_E = W_GU_E + W_DN_E;
constexpr size_t W_IN_E = (size_t)3 * DM_ * DM_, W_OUT_E = (size_t)DM_ * DM_, W_MIX_E = W_IN_E + W_OUT_E;
constexpr size_t W_TOTAL_E = 8 * W_FFN_E + 4 * W_MIX_E;
constexpr size_t WS_XN = 168 * MiB;
constexpr size_t WS_F = 201 * MiB;
constexpr size_t WS_BIG = 236 * MiB;
constexpr size_t WS_END = 338 * MiB;
static_assert(WS_W + W_TOTAL_E * 2 <= WS_XN && WS_XN + (size_t)MPAD * 1024 * 2 <= WS_F && WS_F + (size_t)MPAD * 1024 * 2 <= WS_BIG, "ws map");
static_assert(WS_XN + (size_t)QROWS * 2048 * 2 <= WS_BIG && WS_BIG + (size_t)MPAD * 3072 * 2 <= WS_END && WS_BIG + (size_t)3 * QROWS * 1024 * 2 <= WS_END, "ws map 2");
constexpr int RING_BYTES = 131072, LDS_BYTES = 147456;

#define GAS __attribute__((address_space(1)))
#define LAS __attribute__((address_space(3)))
typedef unsigned short bf16;
typedef unsigned v4u __attribute__((ext_vector_type(4)));
typedef float f32x4 __attribute__((ext_vector_type(4)));
#define LDS_WAIT() asm volatile("s_waitcnt lgkmcnt(0)" ::: "memory")
__device__ __forceinline__ unsigned f2bf(float f) { unsigned u = __builtin_bit_cast(unsigned, f); return (u + 0x7fffu + ((u >> 16) & 1u)) >> 16; }
__device__ __forceinline__ unsigned pk2(float lo, float hi) { typedef float f32x2p __attribute__((ext_vector_type(2))); typedef __bf16 bf16x2p __attribute__((ext_vector_type(2))); f32x2p v = {lo, hi}; bf16x2p b = __builtin_convertvector(v, bf16x2p); return __builtin_bit_cast(unsigned, b); }
__device__ __forceinline__ float bflo(unsigned w) { return __builtin_bit_cast(float, w << 16); }
__device__ __forceinline__ float bfhi(unsigned w) { return __builtin_bit_cast(float, w & 0xffff0000u); }
__device__ __forceinline__ float wave_sum(float v) {
#define WS_DPP(x, ctrl) __builtin_bit_cast(float, __builtin_amdgcn_update_dpp(0, __builtin_bit_cast(int, (x)), (ctrl), 0xF, 0xF, true))
    v += WS_DPP(v, 0xB1);
    v += WS_DPP(v, 0x4E);
    v += WS_DPP(v, 0x141);
    v += WS_DPP(v, 0x140);
#undef WS_DPP
    const int b_ = __builtin_bit_cast(int, v);
    const float r0 = __builtin_bit_cast(float, __builtin_amdgcn_readlane(b_, 0)), r1 = __builtin_bit_cast(float, __builtin_amdgcn_readlane(b_, 16));
    const float r2 = __builtin_bit_cast(float, __builtin_amdgcn_readlane(b_, 32)), r3 = __builtin_bit_cast(float, __builtin_amdgcn_readlane(b_, 48));
    return (r0 + r1) + (r2 + r3);
}
#define RLX_AGENT __ATOMIC_RELAXED, __HIP_MEMORY_SCOPE_AGENT
#define XB_TMO      128
#define XB_XCNT(j)  (256  + 64 * (j))
#define XB_XSUB(j)  (1280 + 64 * (j))
#define XB_XGEN(j)  (2304 + 64 * (j))
#define XB_TOP      3328
#define XB_TOPGEN   3392
#define XCD_BAR_WORDS 3456
#define XB_SPIN_CAP (1u << 18)

__device__ __forceinline__ unsigned xb_ld(unsigned* p)              { return __hip_atomic_load(p, __ATOMIC_RELAXED, __HIP_MEMORY_SCOPE_AGENT); }
__device__ __forceinline__ unsigned xb_add(unsigned* p, unsigned v) { return __hip_atomic_fetch_add(p, v, __ATOMIC_RELAXED, __HIP_MEMORY_SCOPE_AGENT); }
__device__ __forceinline__ unsigned xb_xcc_id() { return (unsigned)__builtin_amdgcn_s_getreg((3 << 11) | 20) & 0xFu; }
#define XB_SPIN(cond, bar) do { unsigned _sp = 0; while (cond) { __builtin_amdgcn_s_sleep(1); \
    if ((++_sp & 255u) == 0u) { if (xb_ld(&(bar)[XB_TMO])) break; if (_sp > XB_SPIN_CAP) { atomicAdd(&(bar)[XB_TMO], 1u); break; } } } } while (0)

struct XcdBarrier {
    unsigned* bar; unsigned x;
    volatile LAS unsigned* st;
};

__device__ __forceinline__ XcdBarrier xcd_barrier_post(unsigned* bar, volatile LAS unsigned* st) {
    XcdBarrier b; b.bar = bar; b.x = xb_xcc_id(); b.st = st;
    if (threadIdx.x == 0) (void)xb_add(&bar[XB_XCNT(b.x)], 1u);
    return b;
}
__device__ __forceinline__ void xcd_barrier_complete(unsigned* bar, unsigned x, unsigned& nloc, unsigned& nx) {
    const unsigned G = gridDim.x * gridDim.y * gridDim.z;
    unsigned sum, cnt, mine, sp = 0u;
    for (;;) {
        sum = 0u; cnt = 0u; mine = 0u;
#pragma unroll
        for (unsigned j = 0; j < 16; ++j) { const unsigned c = xb_ld(&bar[XB_XCNT(j)]); sum += c; cnt += (c > 0u) ? 1u : 0u; mine = (j == x) ? c : mine; }
        if (sum == G) break;
        __builtin_amdgcn_s_sleep(1);
        if ((++sp & 255u) == 0u) { if (xb_ld(&bar[XB_TMO])) break; if (sp > XB_SPIN_CAP) { atomicAdd(&bar[XB_TMO], 1u); break; } }
    }
    nloc = mine > 0u ? mine : 1u; nx = cnt > 0u ? cnt : 1u;
}

template <bool LOCAL> __device__ __forceinline__ void xcd_barrier(const XcdBarrier& b) {
    asm volatile("s_waitcnt vmcnt(0)" ::: "memory");
    __syncthreads();
    if (threadIdx.x == 0) {
        unsigned* bar = b.bar;
        __builtin_amdgcn_s_waitcnt(0);
        unsigned nloc = b.st[0], nx = b.st[1];
        if (nloc == 0u) { xcd_barrier_complete(bar, b.x, nloc, nx); b.st[0] = nloc; b.st[1] = nx; }
        const unsigned old = xb_add(&bar[XB_XSUB(b.x)], 1u);
        const unsigned gen = old / nloc;
        if (old + 1u == (gen + 1u) * nloc) {
            __builtin_amdgcn_fence(__ATOMIC_RELEASE, "agent");
            asm volatile("s_waitcnt vmcnt(0)" ::: "memory");
            if (!LOCAL) {
            const unsigned og = xb_add(&bar[XB_TOP], 1u);
            const unsigned tg = og / nx;
            if (og + 1u == (tg + 1u) * nx) xb_add(&bar[XB_TOPGEN], 1u);
            else XB_SPIN(xb_ld(&bar[XB_TOPGEN]) == tg, bar);
            }
            __builtin_amdgcn_fence(__ATOMIC_ACQUIRE, "agent");
            xb_add(&bar[XB_XGEN(b.x)], 1u);
            asm volatile("s_waitcnt vmcnt(0)" ::: "memory");
        } else {
            XB_SPIN(xb_ld(&bar[XB_XGEN(b.x)]) == gen, bar);
            __builtin_amdgcn_fence(__ATOMIC_ACQUIRE, "agent");
            asm volatile("s_waitcnt vmcnt(0)" ::: "memory");
        }
    }
    __syncthreads();
}

struct Args { const float* in[16]; float* out; unsigned char* ws; };
__device__ __forceinline__ const float* in_ptr(int i) { const char __attribute__((address_space(4)))* ka = (const char __attribute__((address_space(4)))*)__builtin_amdgcn_kernarg_segment_ptr(); int off = i * 8; asm volatile("" : "+s"(off)); return *(const float* const __attribute__((address_space(4)))*)(ka + off); }
__device__ __forceinline__ float* out_ptr() { return (float*)in_ptr(16); }
__device__ __forceinline__ unsigned char* ws_ptr() { return (unsigned char*)in_ptr(17); }

__device__ __forceinline__ void p0_transpose_item(const float* W, int K, int N, bf16* WT, int k0, int n0, int drow0, LAS float* scr, int lane) {
#pragma unroll 8
    for (int i = 0; i < 32; ++i) { const int kk = 2 * i + (lane >> 5); scr[kk * 33 + (lane & 31)] = __builtin_nontemporal_load(&W[(size_t)(k0 + kk) * N + n0 + (lane & 31)]); }
    LDS_WAIT(); asm volatile("" ::: "memory");
    const int c = lane & 7;
#pragma unroll
    for (int j = 0; j < 4; ++j) { const int n = (lane >> 3) + 8 * j; const LAS float* s = scr + (8 * c) * 33 + n;
        v4u o; o.x = pk2(s[0 * 33], s[1 * 33]); o.y = pk2(s[2 * 33], s[3 * 33]); o.z = pk2(s[4 * 33], s[5 * 33]); o.w = pk2(s[6 * 33], s[7 * 33]);
        *(GAS v4u*)(WT + (size_t)(drow0 + n) * K + k0 + 8 * c) = o; }
    LDS_WAIT(); asm volatile("" ::: "memory");
}
__device__ __forceinline__ float* hrow_ptr(float* out, float* hmeta, int m) { return m < MREAL ? out + (size_t)m * DM_ : hmeta + (size_t)(m - MREAL) * DM_; }
__device__ __forceinline__ int qkv_row(int m) { return m < MREAL ? (m >> 11) * 2112 + 64 + (m & 2047) : ((m - MREAL) >> 4) * 2112 + 48 + ((m - MREAL) & 15); }
__device__ __forceinline__ int prev_row(int m, int k) {
    if (m < MREAL) { const int t = m & 2047, b = m >> 11; return (t >= k) ? m - k : MREAL + b * 16 + (16 + t - k); }
    const int i = (m - MREAL) & 15; return (i >= k) ? m - k : -1;
}


typedef short tg_bf16x8 __attribute__((ext_vector_type(8)));
template <int MODE, int KW  , int TR  , int TC  >
__device__ __forceinline__ void tail_gemm(LAS unsigned char* lds, const bf16* A, const bf16* Bt, int N, bf16* O, int ldc, const float* rope, float scale0, size_t buf_stride, int cu, int ncu) {
    constexpr int K = KW * 8, NS = KW / 32, NCP = 16 * TC, NRW = 16 * TR, NCO = (MODE == 1) ? NCP / 2 : NCP, NRB = 128 / NRW, WSZ = NRW * NCP;
    const int tid = opaque_tid(), lane = tid & 63, wid = __builtin_amdgcn_readfirstlane(tid >> 6), fr = lane & 15, fq = lane >> 4;
    const int ncolt = ((MODE == 1) ? N / 2 : N) / NCO, ntiles = NRB * ncolt;
    LAS float* red = (LAS float*)lds;
    if (cu < 0) return;
    for (int tile = cu; tile < ntiles; tile += ncu) {
        const int rb = tile % NRB, ct = tile / NRB;
        tg_bf16x8 fa[TR][NS], fb[TC][NS];
#pragma unroll
        for (int ci = 0; ci < TC; ++ci) { int brow;
            if (MODE == 1) { const int oc = ct * NCO, base = 256 * (oc >> 7) + (oc & 127); brow = (ci < TC / 2) ? base + 16 * ci : base + 128 + 16 * (ci - TC / 2); } else brow = ct * NCP + 16 * ci;
            const bf16* bp = Bt + (size_t)(brow + fr) * K + wid * KW + 8 * fq;
#pragma unroll
            for (int i = 0; i < NS; ++i) fb[ci][i] = *(const tg_bf16x8*)(bp + i * 32); }
#pragma unroll
        for (int ri = 0; ri < TR; ++ri) { const bf16* ap = A + (size_t)(rb * NRW + ri * 16 + fr) * K + wid * KW + 8 * fq;
#pragma unroll
            for (int i = 0; i < NS; ++i) fa[ri][i] = *(const tg_bf16x8*)(ap + i * 32); }
        f32x4 c[TR][TC];
#pragma unroll
        for (int ri = 0; ri < TR; ++ri)
#pragma unroll
            for (int ci = 0; ci < TC; ++ci) c[ri][ci] = (f32x4){0.f, 0.f, 0.f, 0.f};
#pragma unroll
        for (int i = 0; i < NS; ++i)
#pragma unroll
            for (int ri = 0; ri < TR; ++ri)
#pragma unroll
                for (int ci = 0; ci < TC; ++ci) c[ri][ci] = __builtin_amdgcn_mfma_f32_16x16x32_bf16(fb[ci][i], fa[ri][i], c[ri][ci], 0, 0, 0);
        LAS float* rw = red + wid * WSZ;
#pragma unroll
        for (int ri = 0; ri < TR; ++ri)
#pragma unroll
            for (int ci = 0; ci < TC; ++ci) *(LAS f32x4*)(rw + (ri * 16 + fr) * NCP + ci * 16 + 4 * fq) = c[ri][ci];
        __syncthreads();
#define TG_RED(rr_, cc_) (((red[0 * WSZ + (rr_) * NCP + (cc_)] + red[1 * WSZ + (rr_) * NCP + (cc_)]) + (red[2 * WSZ + (rr_) * NCP + (cc_)] + red[3 * WSZ + (rr_) * NCP + (cc_)])) + ((red[4 * WSZ + (rr_) * NCP + (cc_)] + red[5 * WSZ + (rr_) * NCP + (cc_)]) + (red[6 * WSZ + (rr_) * NCP + (cc_)] + red[7 * WSZ + (rr_) * NCP + (cc_)])))
#pragma unroll
        for (int e = tid; e < NRW * NCO; e += NWAVES * 64) { const int row = e / NCO, cc = e % NCO, r = rb * NRW + row;
            if (MODE == 0) { O[(size_t)(MREAL + r) * ldc + ct * NCO + cc] = (bf16)f2bf(TG_RED(row, cc)); }
            else if (MODE == 1) { const float g = TG_RED(row, cc), u = TG_RED(row, NCO + cc); O[(size_t)(MREAL + r) * ldc + ct * NCO + cc] = (bf16)f2bf(pg8::EpiSwiGLU::silu_mul(g, u)); }
            else { const int gcol = ct * NCO + cc, t = gcol >> 10, d = gcol & 63; float v0 = TG_RED(row, cc);
                const int orow = (r >> 4) * 2112 + 48 + (r & 15), pos = r & 15;
                if (t < 2 && d < 16) { const int pc = cc + ((gcol ^ 8) - gcol); const float o0 = TG_RED(row, pc); const int j = d & 7; const float sgn = (d < 8) ? -1.f : 1.f;
                    v0 = v0 * rope[pos * 16 + j] + sgn * o0 * rope[pos * 16 + 8 + j]; }
                if (t == 0) v0 *= scale0;
                O[(size_t)t * buf_stride + (size_t)orow * 1024 + (gcol & 1023)] = (bf16)f2bf(v0); } }
#undef TG_RED
        __syncthreads();
    }
}

__device__ __forceinline__ int batch_row(int b, int i) { return i < SEQL ? b * SEQL + i : MREAL + b * NMETA + ((i - SEQL) >> 4); }
__global__ void __launch_bounds__(NWAVES * 64, 2) trunk_fwd(Args args) {
    extern __shared__ __attribute__((aligned(16))) unsigned char lds[];
    cg::grid_group grid = cg::this_grid();
    const int tid = threadIdx.x, lane = tid & 63, wave = __builtin_amdgcn_readfirstlane(tid >> 6);
    const int G = gridDim.x; const int bx = blockIdx.x; const int vcu = (G % 8 == 0) ? (bx % 8) * (G / 8) + bx / 8 : bx;
    const int gw = vcu * NWAVES + wave, NGW = G * NWAVES;
    LAS unsigned char* ldsl = (LAS unsigned char*)lds;
#define WSB(off) (ws_ptr() + (off))
#define P_HMETA ((float*)WSB(WS_HMETA))
#define P_ROPE ((float*)WSB(WS_ROPE))
#define P_WB ((bf16*)WSB(WS_W))
#define P_XN ((bf16*)WSB(WS_XN))
#define P_FB ((bf16*)WSB(WS_F))
#define P_BIG ((bf16*)WSB(WS_BIG))
    for (int u = tid; u < (LDS_BYTES - RING_BYTES) / 4; u += NWAVES * 64) ((LAS unsigned*)(ldsl + RING_BYTES))[u] = 0u;
    __syncthreads();
    XcdBarrier xbar = xcd_barrier_post((unsigned*)ws_ptr(), (volatile LAS unsigned*)(ldsl + RING_BYTES + 352));
#define GSYNC() xcd_barrier<false>(xbar)
#define LSYNC() xcd_barrier<true>(xbar)
#define GSYNC_CG() do { asm volatile("s_waitcnt vmcnt(0) lgkmcnt(0)" ::: "memory"); __builtin_amdgcn_fence(__ATOMIC_RELEASE, "agent"); grid.sync(); __builtin_amdgcn_fence(__ATOMIC_ACQUIRE, "agent"); } while (0)

    if (tid == 0) ((unsigned*)(ws_ptr() + 32768))[bx] = xbar.x + 1u;
    {
        LAS float* scr = (LAS float*)(ldsl + wave * 16384); bf16* const Wb0 = P_WB;
        constexpr int I_GU = (DM_ / 64) * (NGU / 32), I_DN = (DFF / 64) * (DM_ / 32), I_FFN = I_GU + I_DN;
        constexpr int I_IN = (DM_ / 64) * (3 * DM_ / 32), I_OUT = (DM_ / 64) * (DM_ / 32), I_MIX = I_IN + I_OUT;
        constexpr int NITEMS = 8 * I_FFN + 4 * I_MIX;
        for (int it = gw; it < NITEMS; it += NGW) {
            if (it < 8 * I_FFN) { const int fi = it / I_FFN, r = it % I_FFN, l = fi >> 1, which = fi & 1; bf16* dst = Wb0 + (size_t)fi * W_FFN_E;
                if (r < I_GU) { const float* W = (which ? in_ptr(14) : in_ptr(3)) + (size_t)l * DM_ * NGU; const int nblk = NGU / 32, kb = r / nblk, nb = r % nblk, n0 = 32 * nb;
                    const int half = n0 / DFF, within = n0 % DFF, drow0 = 256 * (within / 128) + 128 * half + (within % 128);
                    p0_transpose_item(W, DM_, NGU, dst, 64 * kb, n0, drow0, scr, lane); }
                else { const int r2 = r - I_GU; const float* W = (which ? in_ptr(15) : in_ptr(4)) + (size_t)l * DFF * DM_; const int nblk = DM_ / 32, kb = r2 / nblk, nb = r2 % nblk;
                    p0_transpose_item(W, DFF, DM_, dst + W_GU_E, 64 * kb, 32 * nb, 32 * nb, scr, lane); }
            } else { const int it2 = it - 8 * I_FFN, l = it2 / I_MIX, r = it2 % I_MIX, j = l >> 1, isattn = l & 1; bf16* dst = Wb0 + 8 * W_FFN_E + (size_t)l * W_MIX_E;
                if (r < I_IN) { const float* W = (isattn ? in_ptr(9) : in_ptr(6)) + (size_t)j * DM_ * 3 * DM_; const int nblk = 3 * DM_ / 32, kb = r / nblk, nb = r % nblk;
                    p0_transpose_item(W, DM_, 3 * DM_, dst, 64 * kb, 32 * nb, 32 * nb, scr, lane); }
                else { const int r2 = r - I_IN; const float* W = (isattn ? in_ptr(12) : in_ptr(8)) + (size_t)j * DM_ * DM_; const int nblk = DM_ / 32, kb = r2 / nblk, nb = r2 % nblk;
                    p0_transpose_item(W, DM_, DM_, dst + W_IN_E, 64 * kb, 32 * nb, 32 * nb, scr, lane); }
            }
        }
        float* const rope0 = P_ROPE;
        for (int e = gw * 64 + lane; e < 2064 * 8; e += NGW * 64) { const int pos = e >> 3, j = e & 7;
            const float inv = (float)exp2(-(double)j * (18.931568569324174 / 8.0));
            const float ang = (float)pos * inv; const double rev = (double)ang * 0.15915494309189535; const float fr = (float)(rev - floor(rev));
            rope0[pos * 16 + j] = __builtin_amdgcn_cosf(fr); rope0[pos * 16 + 8 + j] = __builtin_amdgcn_sinf(fr); }
        { const v4u z = {0u, 0u, 0u, 0u}; bf16* const xn0 = P_XN; bf16* const big0 = P_BIG;
          for (int e = gw * 64 + lane; e < (MPAD - MVALID) * 128; e += NGW * 64) *(v4u*)(xn0 + (size_t)MVALID * 1024 + (size_t)e * 8) = z;
          for (int e = gw * 64 + lane; e < 3 * (8 * 48 + 256) * 128; e += NGW * 64) { const int bufi = e / ((8 * 48 + 256) * 128), r = (e / 128) % (8 * 48 + 256), c = e % 128;
              const int row = r < 384 ? (r / 48) * 2112 + (r % 48) : 8 * 2112 + (r - 384);
              *(v4u*)(big0 + (size_t)bufi * QROWS * 1024 + (size_t)row * 1024 + c * 8) = z; } }
    }
    { float* const hp_out = out_ptr(); float* const hp_meta = P_HMETA; const float* const xin = in_ptr(0); const float* const min_ = in_ptr(1); const float* const g = in_ptr(2); bf16* const xn0 = P_XN;
    f32x4 g0v[4];
#pragma unroll
    for (int q = 0; q < 4; ++q) g0v[q] = *(const f32x4*)(g + (q >> 1) * 512 + lane * 8 + (q & 1) * 4);
    for (int m = gw; m < MVALID; m += NGW) {
        const float* src = m < MREAL ? xin + (size_t)m * DM_ : min_ + (size_t)((m - MREAL) & 15) * DM_;
        float* hr = hrow_ptr(hp_out, hp_meta, m);
        f32x4 v[4]; float s = 0.f;
#pragma unroll
        for (int q = 0; q < 4; ++q) { v[q] = *(const f32x4*)(src + (q >> 1) * 512 + lane * 8 + (q & 1) * 4); s += (v[q][0] * v[q][0] + v[q][1] * v[q][1]) + (v[q][2] * v[q][2] + v[q][3] * v[q][3]); }
        const float r2 = __builtin_amdgcn_rsqf(wave_sum(s) * (1.f / DM_) + 1e-6f);
        if (m >= MREAL) {
#pragma unroll
        for (int q = 0; q < 4; ++q) *(f32x4*)(hr + (q >> 1) * 512 + lane * 8 + (q & 1) * 4) = v[q]; }
#pragma unroll
        for (int hh = 0; hh < 2; ++hh) { const f32x4 g0 = g0v[2 * hh], g1 = g0v[2 * hh + 1]; const f32x4 a = v[2 * hh] * r2 * g0, b = v[2 * hh + 1] * r2 * g1;
            v4u o; o.x = pk2(a[0], a[1]); o.y = pk2(a[2], a[3]); o.z = pk2(b[0], b[1]); o.w = pk2(b[2], b[3]); *(v4u*)(xn0 + (size_t)m * 1024 + hh * 512 + lane * 8) = o; }
    } }
    GSYNC();
    if (G == 0x7fffff) GSYNC_CG();
    int fastsync;
    { int ok = 1; const unsigned* xt = (const unsigned*)(ws_ptr() + 32768);
      if (G != 256) ok = 0; else if (tid < 256) ok = (xt[tid] != 0u) && (xt[tid] == xt[tid & 7]);
      fastsync = __syncthreads_and(ok); }

    enum { K_GU = 0, K_PLAIN = 1, K_NORM = 2, K_CONV = 3, K_QKV = 4, K_ATTN = 5, K_COMB = 6 };
    for (int l = 0; l < DEPTH_; ++l) {
        const int nsteps = (l & 1) ? 11 : 10;
        for (int s = 0; s < nsteps; ++s) {
            int lq = l; asm volatile("" : "+s"(lq));
            const int isattn = lq & 1, jm = lq >> 1;
            const bf16* Wmix = P_WB + 8 * W_FFN_E + (size_t)lq * W_MIX_E;
            int kind; const bf16* gA = P_XN; const bf16* gB = P_WB; int gN = 1024, gK = 1024; bf16* gO = P_FB;
            float coef = 0.5f; const float* gpost = in_ptr(2); const float* gnext = in_ptr(2); int wnext = 1;
            int ffn_i = 0;
            const int sm = (isattn && s >= 5) ? s - 1 : s;
            if (s == 0 || sm == 7) { kind = K_GU; ffn_i = (s == 0) ? 0 : 1; }
            else if (s == 1 || sm == 8) { kind = K_PLAIN; ffn_i = (s == 1) ? 0 : 1; gA = P_BIG; gB = P_WB + (size_t)(2 * lq + ffn_i) * W_FFN_E + W_GU_E; gN = 1024; gK = DFF; gO = P_FB; }
            else if (s == 2) { kind = K_NORM; coef = 0.5f; gpost = in_ptr(2) + (size_t)(lq * 2 + 1) * DM_; gnext = in_ptr(5) + (size_t)(lq * 2) * DM_; }
            else if (s == 3) { if (isattn) kind = K_QKV; else { kind = K_PLAIN; gA = P_XN; gB = Wmix; gN = 3 * DM_; gK = DM_; gO = P_BIG; } }
            else if (s == 4) { kind = isattn ? K_ATTN : K_CONV; }
            else if (isattn && s == 5) { kind = K_COMB; }
            else if (sm == 5) { kind = K_PLAIN; gA = P_XN; gB = Wmix + W_IN_E; gN = 1024; gK = 1024; gO = P_FB; }
            else if (sm == 6) { kind = K_NORM; coef = 1.0f; gpost = in_ptr(5) + (size_t)(lq * 2 + 1) * DM_; gnext = in_ptr(13) + (size_t)(lq * 2) * DM_; }
            else { kind = K_NORM; coef = 0.5f; gpost = in_ptr(13) + (size_t)(lq * 2 + 1) * DM_; wnext = (lq < DEPTH_ - 1); gnext = in_ptr(2) + (size_t)((lq < DEPTH_ - 1 ? lq + 1 : lq) * 2) * DM_; }

            const bool meta_live = !(lq == DEPTH_ - 1 && s >= 5);
            const int lane = opaque_tid() & 63;
            const bool ral = (G == 256); const int ri0 = ral ? (gw & 255) : gw, rin = ral ? ((meta_live && (gw & 15) == 0) ? SEQL + 256 : SEQL) : (meta_live ? MVALID : MREAL),        ris = ral ? 256 : NGW, rbt = gw >> 8;
#define ROWMAP(i_) (ral ? batch_row(rbt, (i_)) : (i_))
            if (kind == K_GU) {
                pg8::Gemm g{P_XN, P_WB + (size_t)(2 * lq + ffn_i) * W_FFN_E, MREAL, NGU, DM_}; pg8::StaticOrder S; S.init(MREAL, NGU, G, bx);
                pg8::EpiSwiGLU E{P_BIG, DFF};
                pg8::gemm_phase<pg8::EpiSwiGLU, pg8::StaticOrder, true, true>(ldsl, g, S, E);
                { const int lo = (G == 256) ? 128 : 0;
                  tail_gemm<1, 128, 1, 8>(ldsl, P_XN + (size_t)MREAL * DM_, P_WB + (size_t)(2 * lq + ffn_i) * W_FFN_E, NGU, P_BIG, DFF, nullptr, 1.f, 0, meta_live ? bx - lo : -1, G - lo); }
            } else if (kind == K_PLAIN) {
                pg8::Gemm g{gA, gB, MREAL, gN, gK}; pg8::StaticOrder S; S.init(MREAL, gN, G, bx);
                pg8::EpiBf16<0> E{gO, gN, nullptr, 0, 0, 1.f};
                pg8::gemm_phase<pg8::EpiBf16<0>, pg8::StaticOrder, true, true>(ldsl, g, S, E);
                if (gK == DM_) { if (gN == DM_) tail_gemm<0, 128, 1, 2>(ldsl, gA + (size_t)MREAL * DM_, gB, gN, gO, gN, nullptr, 1.f, 0, meta_live ? bx : -1, G); else tail_gemm<0, 128, 1, 6>(ldsl, gA + (size_t)MREAL * DM_, gB, gN, gO, gN, nullptr, 1.f, 0, bx, G); }
                else tail_gemm<0, 352, 1, 2>(ldsl, gA + (size_t)MREAL * DFF, gB, gN, gO, gN, nullptr, 1.f, 0, meta_live ? bx : -1, G);
            } else if (kind == K_QKV) {
                pg8::Gemm g{P_XN, Wmix, MREAL, 3 * DM_, DM_}; pg8::StaticOrder S; S.init(MREAL, 3 * DM_, G, bx);
                pg8::EpiQKV E{P_BIG, (size_t)QROWS * 1024, P_ROPE, attn_body::C2};
                pg8::gemm_phase<pg8::EpiQKV, pg8::StaticOrder, true, true>(ldsl, g, S, E);
                tail_gemm<2, 128, 1, 6>(ldsl, P_XN + (size_t)MREAL * DM_, Wmix, 3 * DM_, P_BIG, 1024, P_ROPE, attn_body::C2, (size_t)QROWS * 1024, bx, G);
            } else if (kind == K_NORM) {
                float* const hp_out = out_ptr(); float* const hp_meta = P_HMETA; const bf16* const fb0 = P_FB; bf16* const xn0 = P_XN;
                f32x4 nv[4]; v4u nw[2];
#define NORM_LOAD(mm) do { const float* hq_ = hrow_ptr(hsrc0, hp_meta, (mm)); const bf16* fq_ = fb0 + (size_t)(mm) * 1024; \
                    nw[0] = __builtin_nontemporal_load((const v4u*)(fq_ + lane * 8)); nw[1] = __builtin_nontemporal_load((const v4u*)(fq_ + 512 + lane * 8)); \
                    _Pragma("unroll") for (int q = 0; q < 4; ++q) nv[q] = *(const f32x4*)(hq_ + (q >> 1) * 512 + lane * 8 + (q & 1) * 4); } while (0)
                float* const hsrc0 = (lq == 0 && s == 2) ? (float*)in_ptr(0) : hp_out;
                f32x4 gpv[4], gnv[4];
#pragma unroll
                for (int q = 0; q < 4; ++q) { gpv[q] = *(const f32x4*)(gpost + (q >> 1) * 512 + lane * 8 + (q & 1) * 4); gnv[q] = *(const f32x4*)(gnext + (q >> 1) * 512 + lane * 8 + (q & 1) * 4); }
                NORM_LOAD(ROWMAP(ri0 < rin ? ri0 : 0));
                for (int ri = ri0; ri < rin; ri += ris) { const int m = ROWMAP(ri);
                    float* hr = hrow_ptr(hp_out, hp_meta, m);
                    f32x4 v[4]; float fv[16]; float s1 = 0.f;
#pragma unroll
                    for (int hh = 0; hh < 2; ++hh) { const v4u w = nw[hh];
                        fv[hh * 8 + 0] = bflo(w.x); fv[hh * 8 + 1] = bfhi(w.x); fv[hh * 8 + 2] = bflo(w.y); fv[hh * 8 + 3] = bfhi(w.y); fv[hh * 8 + 4] = bflo(w.z); fv[hh * 8 + 5] = bfhi(w.z); fv[hh * 8 + 6] = bflo(w.w); fv[hh * 8 + 7] = bfhi(w.w); }
#pragma unroll
                    for (int q = 0; q < 4; ++q) v[q] = nv[q];
                    if (ri + ris < rin) NORM_LOAD(ROWMAP(ri + ris));
#pragma unroll
                    for (int e = 0; e < 16; ++e) s1 += fv[e] * fv[e];
                    const float r1 = coef * __builtin_amdgcn_rsqf(wave_sum(s1) * (1.f / DM_) + 1e-6f); float s2 = 0.f;
#pragma unroll
                    for (int q = 0; q < 4; ++q) { const f32x4 gp = gpv[q];
#pragma unroll
                        for (int i = 0; i < 4; ++i) { v[q][i] += fv[q * 4 + i] * r1 * gp[i]; s2 += v[q][i] * v[q][i]; } }
                    const float r2 = __builtin_amdgcn_rsqf(wave_sum(s2) * (1.f / DM_) + 1e-6f);
#pragma unroll
                    for (int q = 0; q < 4; ++q) *(f32x4*)(hr + (q >> 1) * 512 + lane * 8 + (q & 1) * 4) = v[q];
                    if (wnext) {
#pragma unroll
                        for (int hh = 0; hh < 2; ++hh) { const f32x4 g0 = gnv[2 * hh], g1 = gnv[2 * hh + 1]; const f32x4 a = v[2 * hh] * r2 * g0, b = v[2 * hh + 1] * r2 * g1;
                            v4u o; o.x = pk2(a[0], a[1]); o.y = pk2(a[2], a[3]); o.z = pk2(b[0], b[1]); o.w = pk2(b[2], b[3]); *(v4u*)(xn0 + (size_t)m * 1024 + hh * 512 + lane * 8) = o; }
                    }
                }
#undef NORM_LOAD
            } else if (kind == K_CONV) {
                const float* cw = in_ptr(7) + (size_t)jm * 3 * DM_; const bf16* const big0 = P_BIG; bf16* const xn0 = P_XN;
                f32x4 wk[3][2][2];
#pragma unroll
                for (int k = 0; k < 3; ++k)
#pragma unroll
                    for (int hh = 0; hh < 2; ++hh) { wk[k][hh][0] = *(const f32x4*)(cw + k * DM_ + hh * 512 + lane * 8); wk[k][hh][1] = *(const f32x4*)(cw + k * DM_ + hh * 512 + lane * 8 + 4); }
                v4u ncc[3][2], nxx[3][2], nbb[2];
#define CONV_LOAD(mm) do { const int m0_ = (mm), m1_ = prev_row(m0_, 1), m2_ = prev_row(m0_, 2); \
                    _Pragma("unroll") for (int hh = 0; hh < 2; ++hh) { const int d0 = hh * 512 + lane * 8; \
                        _Pragma("unroll") for (int k = 0; k < 3; ++k) { const int mr = (k == 2) ? m0_ : (k == 1 ? m1_ : m2_); ncc[k][hh] = (v4u){0u, 0u, 0u, 0u}; nxx[k][hh] = (v4u){0u, 0u, 0u, 0u}; \
                            if (mr >= 0) { ncc[k][hh] = *(const v4u*)(big0 + (size_t)mr * 3072 + 1024 + d0); nxx[k][hh] = *(const v4u*)(big0 + (size_t)mr * 3072 + 2048 + d0); } } \
                        nbb[hh] = __builtin_nontemporal_load((const v4u*)(big0 + (size_t)m0_ * 3072 + d0)); } } while (0)
                CONV_LOAD(ROWMAP(ri0 < rin ? ri0 : 0));
                for (int ri = ri0; ri < rin; ri += ris) { const int m = ROWMAP(ri);
                    v4u ccs[3][2], xxs[3][2], bbs[2];
#pragma unroll
                    for (int hh = 0; hh < 2; ++hh) { bbs[hh] = nbb[hh];
#pragma unroll
                        for (int k = 0; k < 3; ++k) { ccs[k][hh] = ncc[k][hh]; xxs[k][hh] = nxx[k][hh]; } }
                    if (ri + ris < rin) CONV_LOAD(ROWMAP(ri + ris));
#pragma unroll
                    for (int hh = 0; hh < 2; ++hh) { const int d0 = hh * 512 + lane * 8; float acc8[8];
#pragma unroll
                        for (int k = 0; k < 3; ++k) { const v4u cc = ccs[k][hh], xx = xxs[k][hh]; const f32x4 w0 = wk[k][hh][0], w1 = wk[k][hh][1];
                            const float u0 = bflo(cc.x) * bflo(xx.x), u1 = bfhi(cc.x) * bfhi(xx.x), u2 = bflo(cc.y) * bflo(xx.y), u3 = bfhi(cc.y) * bfhi(xx.y);
                            const float u4 = bflo(cc.z) * bflo(xx.z), u5 = bfhi(cc.z) * bfhi(xx.z), u6 = bflo(cc.w) * bflo(xx.w), u7 = bfhi(cc.w) * bfhi(xx.w);
                            if (k == 0) { acc8[0] = w0[0] * u0; acc8[1] = w0[1] * u1; acc8[2] = w0[2] * u2; acc8[3] = w0[3] * u3; acc8[4] = w1[0] * u4; acc8[5] = w1[1] * u5; acc8[6] = w1[2] * u6; acc8[7] = w1[3] * u7; }
                            else { acc8[0] += w0[0] * u0; acc8[1] += w0[1] * u1; acc8[2] += w0[2] * u2; acc8[3] += w0[3] * u3; acc8[4] += w1[0] * u4; acc8[5] += w1[1] * u5; acc8[6] += w1[2] * u6; acc8[7] += w1[3] * u7; } }
                        const v4u bb = bbs[hh];
                        v4u o; o.x = pk2(bflo(bb.x) * acc8[0], bfhi(bb.x) * acc8[1]); o.y = pk2(bflo(bb.y) * acc8[2], bfhi(bb.y) * acc8[3]); o.z = pk2(bflo(bb.z) * acc8[4], bfhi(bb.z) * acc8[5]); o.w = pk2(bflo(bb.w) * acc8[6], bfhi(bb.w) * acc8[7]);
                        *(v4u*)(xn0 + (size_t)m * 1024 + d0) = o; }
                }
#undef CONV_LOAD
            } else if (kind == K_ATTN) {
                bf16* const big0 = P_BIG; const attn_body::AttnTensors AT{(const attn_body::bf16*)big0, (const attn_body::bf16*)(big0 + (size_t)QROWS * 1024), (const attn_body::bf16*)(big0 + (size_t)2 * QROWS * 1024), (attn_body::bf16*)P_XN, (attn_body::bf16*)P_FB};
                attn_body::attn_phase<8>((char*)lds, AT, vcu, G);
            } else {
                const float linit = 0.8f - 0.6f * expf(-0.3f * (float)lq);
                const float* lp = in_ptr(10) + (size_t)jm * 4 * 64;
                const float lam = expf(wave_sum(lp[lane] * lp[64 + lane])) - expf(wave_sum(lp[128 + lane] * lp[192 + lane])) + linit;
                const float* sg = in_ptr(11) + (size_t)jm * 128; const int hd = lane >> 3, dv0 = (lane & 7) * 16;
                float gs[16];
#pragma unroll
                for (int q = 0; q < 4; ++q) { const f32x4 t4 = *(const f32x4*)(sg + dv0 + q * 4); gs[q * 4 + 0] = t4[0] * (1.f - linit); gs[q * 4 + 1] = t4[1] * (1.f - linit); gs[q * 4 + 2] = t4[2] * (1.f - linit); gs[q * 4 + 3] = t4[3] * (1.f - linit); }
                bf16* const ob0 = P_XN; const bf16* const ob1 = P_FB;
                for (int ri = ri0; ri < rin; ri += ris) { const int m = ROWMAP(ri);
                    bf16* orow = ob0 + (size_t)m * 1024 + hd * 128 + dv0; const bf16* orow1 = ob1 + (size_t)m * 1024 + hd * 128 + dv0;
                    const v4u a0 = *(const v4u*)(orow), a1 = *(const v4u*)(orow + 8), b0 = __builtin_nontemporal_load((const v4u*)(orow1)), b1 = __builtin_nontemporal_load((const v4u*)(orow1 + 8));
                    float d[16];
                    d[0] = bflo(a0.x) - lam * bflo(b0.x); d[1] = bfhi(a0.x) - lam * bfhi(b0.x); d[2] = bflo(a0.y) - lam * bflo(b0.y); d[3] = bfhi(a0.y) - lam * bfhi(b0.y);
                    d[4] = bflo(a0.z) - lam * bflo(b0.z); d[5] = bfhi(a0.z) - lam * bfhi(b0.z); d[6] = bflo(a0.w) - lam * bflo(b0.w); d[7] = bfhi(a0.w) - lam * bfhi(b0.w);
                    d[8] = bflo(a1.x) - lam * bflo(b1.x); d[9] = bfhi(a1.x) - lam * bfhi(b1.x); d[10] = bflo(a1.y) - lam * bflo(b1.y); d[11] = bfhi(a1.y) - lam * bfhi(b1.y);
                    d[12] = bflo(a1.z) - lam * bflo(b1.z); d[13] = bfhi(a1.z) - lam * bfhi(b1.z); d[14] = bflo(a1.w) - lam * bflo(b1.w); d[15] = bfhi(a1.w) - lam * bfhi(b1.w);
                    float ss = 0.f;
#pragma unroll
                    for (int e = 0; e < 16; ++e) ss += d[e] * d[e];
                    ss += __builtin_bit_cast(float, __builtin_amdgcn_update_dpp(0, __builtin_bit_cast(int, ss), 0xB1, 0xF, 0xF, true)); ss += __builtin_bit_cast(float, __builtin_amdgcn_update_dpp(0, __builtin_bit_cast(int, ss), 0x4E, 0xF, 0xF, true)); ss += __builtin_bit_cast(float, __builtin_amdgcn_update_dpp(0, __builtin_bit_cast(int, ss), 0x141, 0xF, 0xF, true));
                    const float rr = __builtin_amdgcn_rsqf(ss * (1.f / 128.f) + 1e-5f);
                    v4u o0, o1;
                    o0.x = pk2(d[0] * rr * gs[0], d[1] * rr * gs[1]); o0.y = pk2(d[2] * rr * gs[2], d[3] * rr * gs[3]); o0.z = pk2(d[4] * rr * gs[4], d[5] * rr * gs[5]); o0.w = pk2(d[6] * rr * gs[6], d[7] * rr * gs[7]);
                    o1.x = pk2(d[8] * rr * gs[8], d[9] * rr * gs[9]); o1.y = pk2(d[10] * rr * gs[10], d[11] * rr * gs[11]); o1.z = pk2(d[12] * rr * gs[12], d[13] * rr * gs[13]); o1.w = pk2(d[14] * rr * gs[14], d[15] * rr * gs[15]);
                    *(v4u*)orow = o0; *(v4u*)(orow + 8) = o1;
                }
            }
#undef ROWMAP
            {
              const int arrive_s = (s == 1) ? 0 : (s == 4) ? 1 : -1;
              const int wait_s = isattn ? ((s == 2) ? 0 : (s == 7) ? 1 : -1) : ((s == 2) ? 0 : (s == 6) ? 1 : -1);
              const bool full = false;
              unsigned* const splitc = (unsigned*)(ws_ptr() + 40960) + 64 * (2 * lq + (arrive_s >= 0 ? arrive_s : (wait_s >= 0 ? wait_s : 0)));
              if (lq == DEPTH_ - 1 && s == nsteps - 1) {   }
              else if (!fastsync || full) GSYNC();
              else { LSYNC();
                     if (arrive_s >= 0) { if (opaque_tid() == 0) __hip_atomic_fetch_add(splitc, 1u, __ATOMIC_RELAXED, __HIP_MEMORY_SCOPE_AGENT); }
                     if (wait_s >= 0) { if (opaque_tid() == 0) { unsigned sp_ = 0; while (__hip_atomic_load(splitc, __ATOMIC_RELAXED, __HIP_MEMORY_SCOPE_AGENT) < (unsigned)G && ++sp_ < (1u << 22)) __builtin_amdgcn_s_sleep(1); }
                                        __syncthreads(); } } }
        }
    }
}

extern "C" void kernel_launch(void* const* d_in, const int* in_sizes, int n_in, void* d_out, int out_size, void* d_ws, size_t ws_size, hipStream_t stream) {
    static int grid = 0;
    if (grid == 0) {
        if (n_in != 16 || out_size != MREAL * DM_ || ws_size < WS_END) { fprintf(stderr, "kernel_launch: unexpected shapes: n_in %d out %d ws %zu (need %zu)\n", n_in, out_size, ws_size, (size_t)WS_END); grid = -1; return; }
        int dev = 0, cus = 0, per_cu = 0;
        if (hipGetDevice(&dev) != hipSuccess || hipDeviceGetAttribute(&cus, hipDeviceAttributeMultiprocessorCount, dev) != hipSuccess) { grid = -1; return; }
        if (hipFuncSetAttribute((const void*)trunk_fwd, hipFuncAttributeMaxDynamicSharedMemorySize, LDS_BYTES) != hipSuccess) { fprintf(stderr, "kernel_launch: hipFuncSetAttribute failed\n"); grid = -1; return; }
        if (hipOccupancyMaxActiveBlocksPerMultiprocessor(&per_cu, (const void*)trunk_fwd, NWAVES * 64, LDS_BYTES) != hipSuccess || per_cu < 1) { fprintf(stderr, "kernel_launch: occupancy query says %d\n", per_cu); per_cu = 1; }
        (void)hipGetLastError();
        grid = cus * per_cu;
    }
    if (grid < 0) return;
    if (hipMemsetAsync(d_ws, 0, 65536, stream) != hipSuccess) { fprintf(stderr, "kernel_launch: memset failed\n"); return; }
    Args a{};
    for (int i = 0; i < 16; ++i) a.in[i] = (const float*)d_in[i];
    a.out = (float*)d_out; a.ws = (unsigned char*)d_ws;
    void* kargs[] = {&a};
    hipError_t e = hipLaunchCooperativeKernel((const void*)trunk_fwd, dim3(grid), dim3(NWAVES * 64), kargs, LDS_BYTES, stream);
    if (e != hipSuccess) fprintf(stderr, "kernel_launch: cooperative launch failed: %s (grid %d)\n", hipGetErrorString(e), grid);
}
```
